# Optimizing an MI355X kernel written in HIP

```python
import math
import jax, jax.numpy as jnp
from jax import lax
import numpy as np

D_MODEL = 2048
BATCH = 8
SEQ = 4096
DEPTH = 1
DEC_BATCH = 8
DEC_SEQ = 16
PAST_LEN = 1024

CHUNK = 64
SSM_WIDTH = D_MODEL // 2
SSM_GROUP = 16
SSM_GROUPS = SSM_WIDTH // SSM_GROUP
SSM_STATE = 64
HEAD_DIM = 64
N_HEADS = (D_MODEL // 2) // HEAD_DIM
N_KV_HEADS = max(1, N_HEADS // 8)
GQA_GROUP = N_HEADS // N_KV_HEADS
ATTN_WIDTH = N_HEADS * HEAD_DIM
KV_WIDTH = N_KV_HEADS * HEAD_DIM
WINDOW = 128
BAND_CHUNKS = -(-WINDOW // CHUNK)
SCALE = HEAD_DIM ** -0.5
N_BUCKETS = 32
MAX_DISTANCE = 128
EPS = 1e-6
IN_WIDTH = 2 * SSM_WIDTH + 2 * ATTN_WIDTH + 2 * KV_WIDTH + 2 * D_MODEL
SPLITS = (SSM_WIDTH,
          2 * SSM_WIDTH,
          2 * SSM_WIDTH + ATTN_WIDTH,
          2 * SSM_WIDTH + ATTN_WIDTH + KV_WIDTH,
          2 * SSM_WIDTH + ATTN_WIDTH + 2 * KV_WIDTH,
          2 * SSM_WIDTH + 2 * ATTN_WIDTH + 2 * KV_WIDTH,
          2 * SSM_WIDTH + 2 * ATTN_WIDTH + 2 * KV_WIDTH + D_MODEL)

kernel_name = "hybrid_s5_swa_sink_stream_step"


def _rmsnorm(x, g):
    xf = x.astype(jnp.float32)
    y = xf * lax.rsqrt(jnp.mean(xf * xf, axis=-1, keepdims=True) + EPS) * g.astype(jnp.float32)
    return y.astype(x.dtype)


def _t5_bucket(rel):
    half = N_BUCKETS // 2
    n = -rel
    ret = jnp.where(n < 0, half, 0)
    n = jnp.abs(n)
    max_exact = half // 2
    nf = jnp.maximum(n, 1).astype(jnp.float32)
    large = max_exact + (jnp.log(nf / max_exact) / math.log(MAX_DISTANCE / max_exact)
                         * (half - max_exact)).astype(jnp.int32)
    large = jnp.minimum(large, half - 1)
    return ret + jnp.where(n < max_exact, n, large)


def _rel_bias(rel, table):
    b = table.astype(jnp.float32)[_t5_bucket(rel)]
    b = jnp.moveaxis(b, -1, 0)
    return b.reshape(N_KV_HEADS, GQA_GROUP, rel.shape[0], rel.shape[1])


def _sink_softmax(s, sinks):
    sk = sinks.astype(jnp.float32).reshape(N_KV_HEADS, GQA_GROUP, 1, 1)
    m = jnp.maximum(jnp.max(s, axis=-1, keepdims=True), sk)
    e = jnp.exp(s - m)
    return e / (jnp.sum(e, axis=-1, keepdims=True) + jnp.exp(sk - m))


def _mixer_inputs(x, norm_gain, w_in, q_gain, k_gain):
    B, L = x.shape[0], x.shape[1]
    h = _rmsnorm(x, norm_gain) @ w_in
    u, z_a, q, k, v, z_b, g_a, g_b = jnp.split(h, SPLITS, axis=-1)
    q = _rmsnorm(q.reshape(B, L, N_HEADS, HEAD_DIM), q_gain)
    k = _rmsnorm(k.reshape(B, L, N_KV_HEADS, HEAD_DIM), k_gain)
    v = v.reshape(B, L, N_KV_HEADS, HEAD_DIM)
    return u, z_a, q, k, v, z_b, g_a, g_b


def _discretize(a_re, a_im, log_dt, b_re, b_im):
    a_re = a_re.astype(jnp.float32)
    a_im = a_im.astype(jnp.float32)
    b_re = b_re.astype(jnp.float32)
    b_im = b_im.astype(jnp.float32)
    dt = jnp.exp(log_dt.astype(jnp.float32))[:, None]
    mag = jnp.exp(a_re * dt)
    ang = a_im * dt
    lam_re = mag * jnp.cos(ang)
    lam_im = mag * jnp.sin(ang)
    den = a_re * a_re + a_im * a_im
    cr = ((lam_re - 1.0) * a_re + lam_im * a_im) / den
    ci = (lam_im * a_re - (lam_re - 1.0) * a_im) / den
    bb_re = cr[..., None] * b_re - ci[..., None] * b_im
    bb_im = cr[..., None] * b_im + ci[..., None] * b_re
    return lam_re, lam_im, bb_re, bb_im


def _combine(e1, e2):
    a1r, a1i, b1r, b1i = e1
    a2r, a2i, b2r, b2i = e2
    return (a2r * a1r - a2i * a1i,
            a2r * a1i + a2i * a1r,
            a2r * b1r - a2i * b1i + b2r,
            a2r * b1i + a2i * b1r + b2i)


def _s5(u, h0_re, h0_im, lam_re, lam_im, bb_re, bb_im, c_re, c_im, d_skip):
    B, L = u.shape[0], u.shape[1]
    uf = u.astype(jnp.float32).reshape(B, L, SSM_GROUPS, SSM_GROUP)
    bu_re = jnp.einsum('blgc,gpc->blgp', uf, bb_re)
    bu_im = jnp.einsum('blgc,gpc->blgp', uf, bb_im)
    a_re = jnp.broadcast_to(lam_re, (1, L, SSM_GROUPS, SSM_STATE))
    a_im = jnp.broadcast_to(lam_im, (1, L, SSM_GROUPS, SSM_STATE))
    acum_re, acum_im, h_re, h_im = lax.associative_scan(_combine, (a_re, a_im, bu_re, bu_im), axis=1)
    if h0_re is not None:
        h0r = h0_re.astype(jnp.float32)[:, None]
        h0i = h0_im.astype(jnp.float32)[:, None]
        h_re, h_im = (h_re + acum_re * h0r - acum_im * h0i,
                      h_im + acum_re * h0i + acum_im * h0r)
    y = (jnp.einsum('blgp,gcp->blgc', h_re, c_re.astype(jnp.float32))
         - jnp.einsum('blgp,gcp->blgc', h_im, c_im.astype(jnp.float32)))
    y = y.reshape(B, L, SSM_WIDTH) + d_skip.astype(jnp.float32) * u.astype(jnp.float32)
    return y.astype(u.dtype), h_re[:, -1], h_im[:, -1]


def _band_attention(q, k, v, rel_table, sinks):
    B, L = q.shape[0], q.shape[1]
    nc = L // CHUNK
    span = (BAND_CHUNKS + 1) * CHUNK
    qb = q.reshape(B, nc, CHUNK, N_KV_HEADS, GQA_GROUP, HEAD_DIM)

    def band(t):
        tc = t.reshape(B, nc, CHUNK, N_KV_HEADS, HEAD_DIM)
        tp = jnp.concatenate([jnp.zeros((B, BAND_CHUNKS) + tc.shape[2:], t.dtype), tc], axis=1)
        return jnp.concatenate([tp[:, j:j + nc] for j in range(BAND_CHUNKS + 1)], axis=2)

    kb, vb = band(k), band(v)
    s = jnp.einsum('bnqhgd,bnshd->bnhgqs', qb, kb).astype(jnp.float32) * SCALE
    q_off = jnp.arange(CHUNK)
    s_off = jnp.arange(span)
    rel = s_off[None, :] - BAND_CHUNKS * CHUNK - q_off[:, None]
    s = s + _rel_bias(rel, rel_table)
    key_chunk = jnp.arange(nc)[:, None] - BAND_CHUNKS + s_off[None, :] // CHUNK
    s = jnp.where((key_chunk >= 0)[None, :, None, None, None, :], s, -jnp.inf)
    p = _sink_softmax(s, sinks)
    o = jnp.einsum('bnhgqs,bnshd->bnqhgd', p.astype(vb.dtype), vb)
    return o.reshape(B, L, ATTN_WIDTH)


def _cached_attention(q, k, v, cache_k, cache_v, rel_table, sinks):
    Bd, T = q.shape[0], q.shape[1]
    R = cache_k.shape[1]
    kk = jnp.concatenate([cache_k.astype(k.dtype), k], axis=1)
    vv = jnp.concatenate([cache_v.astype(v.dtype), v], axis=1)
    qg = q.reshape(Bd, T, N_KV_HEADS, GQA_GROUP, HEAD_DIM)
    s = jnp.einsum('bqhgd,bshd->bhgqs', qg, kk).astype(jnp.float32) * SCALE
    rel = jnp.arange(R + T)[None, :] - R - jnp.arange(T)[:, None]
    s = s + _rel_bias(rel, rel_table)
    p = _sink_softmax(s, sinks)
    o = jnp.einsum('bhgqs,bshd->bqhgd', p.astype(vv.dtype), vv)
    return o.reshape(Bd, T, ATTN_WIDTH)


def _merge(x, y_ssm, z_a, o_attn, z_b, g_a, g_b, w_glu, b_glu, w_out_a, w_out_b, w_o):
    g = jax.nn.gelu(y_ssm, approximate=False)
    br_a = g * jax.nn.sigmoid(g @ w_glu + b_glu) * jax.nn.silu(z_a)
    br_b = o_attn * jax.nn.silu(z_b)
    mixed = jax.nn.sigmoid(g_a) * (br_a @ w_out_a) + jax.nn.sigmoid(g_b) * (br_b @ w_out_b)
    return x + mixed @ w_o


def setup_inputs(seed: int = 0) -> dict:
    key = jax.random.key(seed)
    ks = jax.random.split(key, 26)
    f32 = jnp.float32
    n = lambda k, s: jax.random.normal(k, s, f32)
    rows = min(WINDOW, PAST_LEN)
    return {
        "x_prompt": n(ks[0], (BATCH, SEQ, D_MODEL)),
        "x_sample": n(ks[1], (DEC_BATCH, DEC_SEQ, D_MODEL)),
        "cache_k": n(ks[2], (DEPTH, DEC_BATCH, rows, N_KV_HEADS, HEAD_DIM)),
        "cache_v": n(ks[3], (DEPTH, DEC_BATCH, rows, N_KV_HEADS, HEAD_DIM)),
        "state_ssm_re": 0.5 * n(ks[4], (DEPTH, DEC_BATCH, SSM_GROUPS, SSM_STATE)),
        "state_ssm_im": 0.5 * n(ks[5], (DEPTH, DEC_BATCH, SSM_GROUPS, SSM_STATE)),
        "norm_gain": 1.0 + 0.01 * n(ks[6], (DEPTH, D_MODEL)),
        "w_in": n(ks[7], (DEPTH, D_MODEL, IN_WIDTH)) * D_MODEL ** -0.5,
        "ssm_a_re": -0.5 + 0.01 * n(ks[8], (DEPTH, SSM_GROUPS, SSM_STATE)),
        "ssm_a_im": math.pi * jnp.arange(SSM_STATE, dtype=f32) + 0.01 * n(ks[9], (DEPTH, SSM_GROUPS, SSM_STATE)),
        "ssm_log_dt": jax.random.uniform(ks[10], (DEPTH, SSM_GROUPS), f32, math.log(1e-3), math.log(1e-1)),
        "ssm_b_re": n(ks[11], (DEPTH, SSM_GROUPS, SSM_STATE, SSM_GROUP)) * (2 * SSM_GROUP) ** -0.5,
        "ssm_b_im": n(ks[12], (DEPTH, SSM_GROUPS, SSM_STATE, SSM_GROUP)) * (2 * SSM_GROUP) ** -0.5,
        "ssm_c_re": n(ks[13], (DEPTH, SSM_GROUPS, SSM_GROUP, SSM_STATE)) * SSM_STATE ** -0.5,
        "ssm_c_im": n(ks[14], (DEPTH, SSM_GROUPS, SSM_GROUP, SSM_STATE)) * SSM_STATE ** -0.5,
        "ssm_d": n(ks[15], (DEPTH, SSM_WIDTH)),
        "w_glu": n(ks[16], (DEPTH, SSM_WIDTH, SSM_WIDTH)) * SSM_WIDTH ** -0.5,
        "b_glu": 0.01 * n(ks[17], (DEPTH, SSM_WIDTH)),
        "q_gain": 1.0 + 0.01 * n(ks[18], (DEPTH, HEAD_DIM)),
        "k_gain": 1.0 + 0.01 * n(ks[19], (DEPTH, HEAD_DIM)),
        "attn_sinks": n(ks[20], (DEPTH, N_HEADS)),
        "rel_bias": 0.5 * n(ks[21], (N_BUCKETS, N_HEADS)),
        "w_out_a": n(ks[22], (DEPTH, SSM_WIDTH, D_MODEL)) * SSM_WIDTH ** -0.5,
        "w_out_b": n(ks[23], (DEPTH, ATTN_WIDTH, D_MODEL)) * ATTN_WIDTH ** -0.5,
        "w_o": n(ks[24], (DEPTH, D_MODEL, D_MODEL)) * D_MODEL ** -0.5,
    }


def reference(x_prompt, x_sample, cache_k, cache_v, state_ssm_re, state_ssm_im,
              norm_gain, w_in, ssm_a_re, ssm_a_im, ssm_log_dt, ssm_b_re, ssm_b_im,
              ssm_c_re, ssm_c_im, ssm_d, w_glu, b_glu, q_gain, k_gain, attn_sinks,
              rel_bias, w_out_a, w_out_b, w_o):
    y_p, y_s = x_prompt, x_sample
    p_re, p_im, p_k, p_v = [], [], [], []
    s_re, s_im, s_k, s_v = [], [], [], []
    for l in range(DEPTH):
        lam_re, lam_im, bb_re, bb_im = _discretize(ssm_a_re[l], ssm_a_im[l], ssm_log_dt[l],
                                                   ssm_b_re[l], ssm_b_im[l])
        u, z_a, q, k, v, z_b, g_a, g_b = _mixer_inputs(y_p, norm_gain[l], w_in[l], q_gain[l], k_gain[l])
        y_ssm, h_re, h_im = _s5(u, None, None, lam_re, lam_im, bb_re, bb_im,
                                ssm_c_re[l], ssm_c_im[l], ssm_d[l])
        o = _band_attention(q, k, v, rel_bias, attn_sinks[l])
        y_p = _merge(y_p, y_ssm, z_a, o, z_b, g_a, g_b, w_glu[l], b_glu[l], w_out_a[l], w_out_b[l], w_o[l])
        keep = min(WINDOW, k.shape[1])
        p_re.append(h_re)
        p_im.append(h_im)
        p_k.append(k[:, -keep:])
        p_v.append(v[:, -keep:])
        u, z_a, q, k, v, z_b, g_a, g_b = _mixer_inputs(y_s, norm_gain[l], w_in[l], q_gain[l], k_gain[l])
        y_ssm, h_re, h_im = _s5(u, state_ssm_re[l], state_ssm_im[l], lam_re, lam_im, bb_re, bb_im,
                                ssm_c_re[l], ssm_c_im[l], ssm_d[l])
        o = _cached_attention(q, k, v, cache_k[l], cache_v[l], rel_bias, attn_sinks[l])
        y_s = _merge(y_s, y_ssm, z_a, o, z_b, g_a, g_b, w_glu[l], b_glu[l], w_out_a[l], w_out_b[l], w_o[l])
        s_re.append(h_re)
        s_im.append(h_im)
        s_k.append(k)
        s_v.append(v)
    prompt_ssm_re = jnp.stack(p_re)
    prompt_ssm_im = jnp.stack(p_im)
    prompt_k = jnp.stack(p_k)
    prompt_v = jnp.stack(p_v)
    sample_ssm_re = jnp.stack(s_re)
    sample_ssm_im = jnp.stack(s_im)
    sample_k = jnp.stack(s_k)
    sample_v = jnp.stack(s_v)
    return (y_p, y_s, prompt_ssm_re, prompt_ssm_im, prompt_k, prompt_v,
            sample_ssm_re, sample_ssm_im, sample_k, sample_v)
```

```cpp
#include <hip/hip_runtime.h>
#include <hip/hip_cooperative_groups.h>
#include <cstdio>
#include <cstdint>
namespace cg = cooperative_groups;

#ifndef MK_N_LAUNCHES
#define MK_N_LAUNCHES 1
#endif

#define LAS __attribute__((address_space(3)))
typedef unsigned short bf16_t;
typedef short bf16x8 __attribute__((ext_vector_type(8)));
typedef short s16x4 __attribute__((ext_vector_type(4)));
typedef float f32x4 __attribute__((ext_vector_type(4)));
typedef float f32x2 __attribute__((ext_vector_type(2)));
typedef float f32x16 __attribute__((ext_vector_type(16)));
typedef unsigned u32x4 __attribute__((ext_vector_type(4)));
typedef unsigned u32x2 __attribute__((ext_vector_type(2)));

constexpr int DM = 2048, SEQ = 4096, NBATCH = 8, MP = NBATCH * SEQ, MS = 128, MROWS = 33024;
constexpr int NIN = 8448, NCHUNK = 64, NGRP = 64, NSTATE = 64;
constexpr float EPSN = 1e-6f, LOG2E = 1.4426950408889634f, QSCALE = 0.125f * 1.4426950408889634f;
constexpr size_t O_YP = 0, O_YS = 67108864, O_PRE = 67371008, O_PIM = 67403776, O_PK = 67436544, O_PV = 67567616, O_SRE = 67698688, O_SIM = 67731456, O_SK = 67764224, O_SV = 67780608;
constexpr size_t MiB = 1u << 20;
constexpr size_t WS_CTL = 0, WS_WIN = 1 * MiB, WS_WGLU = 34 * MiB, WS_WOUT = 36 * MiB, WS_WO = 44 * MiB, WS_CONST = 52 * MiB, WS_XN = 53 * MiB, WS_U = 182 * MiB, WS_ZA = 247 * MiB,
                 WS_Q = 312 * MiB, WS_ZB = 377 * MiB, WS_K = 442 * MiB, WS_V = 451 * MiB, WS_GA = 460 * MiB, WS_GB = 589 * MiB, WS_S = 718 * MiB, WS_HIN = 734 * MiB, WS_END = 750 * MiB;
constexpr size_t C_LAM = 0, C_LAM64 = 32768, C_BF = 65536, C_CF = 327680, C_BT = 589824;
constexpr int LDS_BYTES = 147456;

__device__ __forceinline__ unsigned cvt_pk_bf16(float lo, float hi) { unsigned r; asm volatile("v_cvt_pk_bf16_f32 %0, %1, %2" : "=v"(r) : "v"(lo), "v"(hi)); return r; }
__device__ __forceinline__ float bf2f(unsigned short b) { return __uint_as_float((unsigned)b << 16); }
__device__ __forceinline__ float bflo(unsigned w) { return __uint_as_float(w << 16); }
__device__ __forceinline__ float bfhi(unsigned w) { return __uint_as_float(w & 0xffff0000u); }
__device__ __forceinline__ float sigmoidf_(float x) { return __builtin_amdgcn_rcpf(1.0f + __builtin_amdgcn_exp2f(-LOG2E * x)); }
__device__ __forceinline__ float siluf_(float x) { return x * sigmoidf_(x); }
__device__ __forceinline__ float geluf_(float v) {
    const float av = fabsf(v), t = __builtin_amdgcn_rcpf(av * 0.2316418882f + 1.0f);
    float q = t * 0.5307027145f + (-0.7265760135f); q = q * t + 0.7107068705f; q = q * t + (-0.142248368f); q = q * t + 0.127414796f; q = q * t;
    const float e = __builtin_amdgcn_exp2f((v * v) * (-0.72134752044f));
    const float m = v * (q * e);
    return v < 0.f ? m : v - m;
}

namespace pg8 {
constexpr int BM = 256, BK = 64, HALF = 128, HTB = HALF * BK * 2, STAGE_BYTES = 8 * HTB, NXCD = 8, WGM = 8;
__host__ __device__ __forceinline__ int lds_byte(int r, int c) { const int st = (r >> 4) * 2 + (c >> 5), rr = r & 15, cc = c & 31, ob = rr * 64 + cc * 2; return st * 1024 + (ob ^ (((ob >> 9) & 1) << 5)); }
__host__ __device__ __forceinline__ void stage_rc(int b, int& R, int& C) { const int st = b / 1024, sb = b % 1024, swz = sb ^ (((sb >> 9) & 1) << 5); R = (st >> 1) * 16 + swz / 64; C = (st & 1) * 32 + (swz % 64) / 2; }
__host__ __device__ __forceinline__ int perm32(int rho) { const int n = rho >> 4, i = rho & 15; return 8 * (i >> 2) + 4 * n + (i & 3); }
struct Unit { int pm, pn; };
struct Gemm { const bf16_t* A; const bf16_t* A2; const bf16_t* Bt; int lda, K, ksplit, nM, nN; };
struct StaticOrder {
    int nM, nN, nwg, G, c;
    __device__ void init(int nM_, int nN_, int G_, int c_) { nM = nM_; nN = nN_; nwg = nM * nN; G = G_; c = c_; }
    __device__ bool next(int i, Unit& u) const {
        const long L = (long)i * G + c; if (L >= nwg) return false;
        int wgid = (int)L; { const int q = nwg / NXCD, r = nwg % NXCD, xcd = wgid % NXCD, off = wgid / NXCD; wgid = (xcd < r ? xcd * (q + 1) : r * (q + 1) + (xcd - r) * q) + off; }
        const int nig = WGM * nN, gid = wgid / nig, fm = gid * WGM, gsz = (nM - fm) < WGM ? (nM - fm) : WGM;
        u.pm = fm + ((wgid % nig) % gsz); u.pn = (wgid % nig) / gsz; return true;
    }
};

template <class Epi, bool ALIGN_EPI>
__device__ __forceinline__ void gemm_phase(LAS unsigned char* lds, const Gemm g, const StaticOrder& S, const Epi& E) {
    const int tid = threadIdx.x, wid = __builtin_amdgcn_readfirstlane(tid >> 6), lane = tid & 63, wr = wid >> 2, wc = wid & 3, fr = lane & 15, fq = lane >> 4;
    const int K = g.K, nt = K / BK, lda = g.lda;
    unsigned voffA[2], voffB[2];
#pragma unroll
    for (int i = 0; i < 2; ++i) { int R, C; stage_rc(tid * 16 + i * 8192, R, C); const int Rb = Epi::PERM ? ((R & ~31) + perm32(R & 31)) : R;
        voffA[i] = (unsigned)(R * lda + C) * 2u; voffB[i] = (unsigned)(Rb * K + C) * 2u; }
    const size_t kstep = (size_t)(BK * 2);
    const size_t hstepA = (size_t)HALF * lda * 2, tstepA = 2 * hstepA;
    const size_t hstepB = (size_t)HALF * K * 2, tstepB = 2 * hstepB;
    const unsigned ldsw = (unsigned)wid * 1024u;
    const int aoff = lds_byte(wr * 64 + fr, fq * 8), boff = lds_byte(wc * 32 + fr, fq * 8);
    const char* Alo = (const char*)g.A; const char* Ahi = (const char*)g.A2 - (size_t)g.ksplit * kstep;
#define PG8_APAN(pm, t) (((t) < g.ksplit ? Alo : Ahi) + (size_t)(pm) * tstepA + (size_t)(t) * kstep)
#define PG8_SA(b, h) (((b) * 2 + (h)) * HTB)
#define PG8_SB(b, h) ((4 + (b) * 2 + (h)) * HTB)
#define PG8_STAGE(bufoff, gbase, voff) do { _Pragma("unroll") for (int _i = 0; _i < 2; ++_i) \
        __builtin_amdgcn_global_load_lds((const unsigned*)((const char*)(gbase) + (voff)[_i]), (LAS unsigned*)(lds + (bufoff) + ldsw + _i * 8192), 16, 0, 0); } while (0)
#define PG8_LDA(dst, b, h) do { _Pragma("unroll") for (int m = 0; m < 4; ++m) _Pragma("unroll") for (int k = 0; k < 2; ++k) dst[m][k] = *(const LAS bf16x8*)(lds + PG8_SA(b, h) + aoff + m * 2048 + k * 1024); } while (0)
#define PG8_LDB(dst, b, h) do { _Pragma("unroll") for (int n = 0; n < 2; ++n) _Pragma("unroll") for (int k = 0; k < 2; ++k) dst[n][k] = *(const LAS bf16x8*)(lds + PG8_SB(b, h) + boff + n * 2048 + k * 1024); } while (0)
#define PG8_MMA(ai, bj, At, Bt) do { __builtin_amdgcn_s_setprio(1); _Pragma("unroll") for (int m = 0; m < 4; ++m) _Pragma("unroll") for (int n = 0; n < 2; ++n) _Pragma("unroll") for (int k = 0; k < 2; ++k) \
        acc[ai][bj][m][n] = __builtin_amdgcn_mfma_f32_16x16x32_bf16(Bt[n][k], At[m][k], acc[ai][bj][m][n], 0, 0, 0); __builtin_amdgcn_s_setprio(0); } while (0)
#define PG8_WAIT_V(n) asm volatile("s_waitcnt vmcnt(" #n ")" ::: "memory")
#define PG8_WAIT_L(n) asm volatile("s_waitcnt lgkmcnt(" #n ")" ::: "memory")
#define PG8_BAR __builtin_amdgcn_s_barrier()
#define PG8_SCHED __builtin_amdgcn_sched_barrier(0)
    Unit cur, nxt; int ui = 0;
    if (!S.next(0, cur)) return;
    f32x4 acc[2][2][4][2];
#pragma unroll
    for (int a = 0; a < 2; ++a)
#pragma unroll
        for (int b = 0; b < 2; ++b)
#pragma unroll
            for (int m = 0; m < 4; ++m)
#pragma unroll
                for (int n = 0; n < 2; ++n) acc[a][b][m][n] = (f32x4){0.f, 0.f, 0.f, 0.f};
    bf16x8 At[4][2], B0[2][2], B1[2][2];
    const char* cA = PG8_APAN(cur.pm, 0); const char* cB = (const char*)g.Bt + (size_t)cur.pn * tstepB;
    PG8_STAGE(PG8_SB(0, 0), cB, voffB); PG8_STAGE(PG8_SB(0, 1), cB + hstepB, voffB); PG8_STAGE(PG8_SA(0, 0), cA, voffA); PG8_STAGE(PG8_SA(0, 1), cA + hstepA, voffA);
    if (wr == 1) PG8_BAR;
    PG8_WAIT_V(2); PG8_BAR;
    PG8_STAGE(PG8_SB(1, 0), cB + kstep, voffB); PG8_STAGE(PG8_SA(1, 0), cA + kstep, voffA); PG8_STAGE(PG8_SB(1, 1), cB + hstepB + kstep, voffB);
    PG8_WAIT_V(6); PG8_BAR;
    for (;;) {
        const bool has_next = S.next(ui + 1, nxt);
        const char* nA = has_next ? PG8_APAN(nxt.pm, 0) : cA; const char* nB = has_next ? (const char*)g.Bt + (size_t)nxt.pn * tstepB : cB;
        for (int t = 0; t < nt; t += 2) {
            if constexpr (Epi::HAS_MID) { if (t == g.ksplit) E.mid(acc, cur, wr, wc, fr, fq); }
            const bool last = (t == nt - 2);
            const char* a1 = PG8_APAN(cur.pm, t + 1);
            const char* a2 = last ? nA : PG8_APAN(cur.pm, t + 2); const char* b2 = last ? nB : cB + (size_t)(t + 2) * kstep;
            const char* a3 = a2 + kstep; const char* b3 = b2 + kstep;
            PG8_LDB(B0, 0, 0); PG8_LDB(B1, 0, 1); PG8_SCHED; PG8_LDA(At, 0, 0); PG8_STAGE(PG8_SA(1, 1), a1 + hstepA, voffA);
            PG8_WAIT_V(8); PG8_WAIT_L(0); PG8_BAR; PG8_MMA(0, 0, At, B0); PG8_MMA(0, 1, At, B1); PG8_BAR; PG8_SCHED;
            PG8_LDA(At, 0, 1); PG8_STAGE(PG8_SB(0, 0), b2, voffB); PG8_STAGE(PG8_SB(0, 1), b2 + hstepB, voffB); PG8_STAGE(PG8_SA(0, 0), a2, voffA);
            PG8_WAIT_V(8); PG8_WAIT_L(0); PG8_BAR; PG8_MMA(1, 0, At, B0); PG8_MMA(1, 1, At, B1); PG8_BAR; PG8_SCHED;
            PG8_LDB(B0, 1, 0); PG8_LDB(B1, 1, 1); PG8_SCHED; PG8_LDA(At, 1, 0); PG8_STAGE(PG8_SA(0, 1), a2 + hstepA, voffA);
            PG8_WAIT_V(8); PG8_WAIT_L(0); PG8_BAR; PG8_MMA(0, 0, At, B0); PG8_MMA(0, 1, At, B1); PG8_BAR; PG8_SCHED;
            PG8_LDA(At, 1, 1); PG8_STAGE(PG8_SB(1, 0), b3, voffB); PG8_STAGE(PG8_SB(1, 1), b3 + hstepB, voffB); PG8_STAGE(PG8_SA(1, 0), a3, voffA);
            PG8_WAIT_V(8); PG8_WAIT_L(0); PG8_BAR; PG8_MMA(1, 0, At, B0); PG8_MMA(1, 1, At, B1); PG8_BAR; PG8_SCHED;
        }
        if constexpr (ALIGN_EPI) { if (wr == 0) PG8_BAR; }
        E(acc, cur, wr, wc, fr, fq);
        if (!has_next) break;
#pragma unroll
        for (int a = 0; a < 2; ++a)
#pragma unroll
            for (int b = 0; b < 2; ++b)
#pragma unroll
                for (int m = 0; m < 4; ++m)
#pragma unroll
                    for (int n = 0; n < 2; ++n) acc[a][b][m][n] = (f32x4){0.f, 0.f, 0.f, 0.f};
        cur = nxt; cA = nA; cB = nB; ++ui;
        if constexpr (ALIGN_EPI) { if (wr == 1) PG8_BAR; }
    }
    PG8_WAIT_V(0);
    if constexpr (!ALIGN_EPI) { if (wr == 0) PG8_BAR; }
    PG8_BAR;
#undef PG8_APAN
#undef PG8_SA
#undef PG8_SB
#undef PG8_STAGE
#undef PG8_LDA
#undef PG8_LDB
#undef PG8_MMA
#undef PG8_WAIT_V
#undef PG8_WAIT_L
#undef PG8_BAR
#undef PG8_SCHED
}
}

typedef const f32x4 (&AccRef)[2][2][4][2];
typedef f32x4 (&AccMut)[2][2][4][2];

__device__ __forceinline__ u32x4 pack8(f32x4 a, f32x4 b) { u32x4 w; w.x = cvt_pk_bf16(a[0], a[1]); w.y = cvt_pk_bf16(a[2], a[3]); w.z = cvt_pk_bf16(b[0], b[1]); w.w = cvt_pk_bf16(b[2], b[3]); return w; }

__device__ __forceinline__ unsigned opaque(unsigned x) { asm volatile("" : "+v"(x)); return x; }

struct EpiIn {
    static constexpr bool PERM = true, HAS_MID = false;
    bf16_t *U, *ZA, *Q, *ZB, *Kb, *Vb, *GA, *GB; const float *qg, *kg; float* out;
    __device__ __forceinline__ void operator()(AccRef acc, const pg8::Unit& u, int wr, int wc, int fr, int fq) const {
        const int pn = u.pn, row0 = u.pm * 256 + wr * 64 + fr, lc0 = 64 * wc + 8 * fq;
        if (pn == 12) {
            const bool isk = wc < 2; const int hd = wc & 1;
            f32x4 gq[2][2];
#pragma unroll
            for (int bj = 0; bj < 2; ++bj)
#pragma unroll
                for (int n = 0; n < 2; ++n) gq[bj][n] = isk ? *(const f32x4*)(kg + 32 * bj + 8 * fq + 4 * n) : (f32x4){1.f, 1.f, 1.f, 1.f};
            char* dst = (char*)(isk ? Kb : Vb); float* opk = out + (isk ? O_PK : O_PV); float* osk = out + (isk ? O_SK : O_SV);
            const unsigned off0 = ((unsigned)row0 * 128u + 64u * hd + 8u * fq) * 2u;
#pragma unroll
            for (int ai = 0; ai < 2; ++ai)
#pragma unroll
                for (int m = 0; m < 4; ++m) {
                    const int row = row0 + ai * 128 + m * 16;
                    const unsigned o = opaque(off0 + (unsigned)(ai * 128 + m * 16) * 256u);
                    float r = 1.f;
                    if (isk) { float ss = 0.f;
#pragma unroll
                        for (int bj = 0; bj < 2; ++bj)
#pragma unroll
                            for (int n = 0; n < 2; ++n) { const f32x4 x = acc[ai][bj][m][n]; ss += (x[0] * x[0] + x[1] * x[1]) + (x[2] * x[2] + x[3] * x[3]); }
                        ss += __shfl_xor(ss, 16); ss += __shfl_xor(ss, 32);
                        r = __builtin_amdgcn_rsqf(ss * (1.0f / 64.0f) + EPSN); }
                    float* fo = nullptr;
                    if (row < MP) { const int t = row & (SEQ - 1); if (t >= SEQ - 128) fo = opk + ((size_t)((row >> 12) * 128 + (t - (SEQ - 128))) * 2 + hd) * 64; }
                    else if (row < MP + MS) { fo = osk + ((size_t)(row - MP) * 2 + hd) * 64; }
#pragma unroll
                    for (int bj = 0; bj < 2; ++bj) {
                        const f32x4 v0 = acc[ai][bj][m][0] * r * gq[bj][0], v1 = acc[ai][bj][m][1] * r * gq[bj][1];
                        *(u32x4*)(dst + o + 64 * bj) = pack8(v0, v1);
                        if (fo) { *(f32x4*)(fo + 32 * bj + 8 * fq) = v0; *(f32x4*)(fo + 32 * bj + 8 * fq + 4) = v1; }
                    }
                }
            return;
        }
        if (pn >= 8 && pn < 12) {
            f32x4 gq[2][2];
#pragma unroll
            for (int bj = 0; bj < 2; ++bj)
#pragma unroll
                for (int n = 0; n < 2; ++n) gq[bj][n] = *(const f32x4*)(qg + 32 * bj + 8 * fq + 4 * n) * QSCALE;
            const unsigned off0 = ((unsigned)row0 * 1024u + (unsigned)((pn - 8) * 256 + lc0)) * 2u;
#pragma unroll
            for (int ai = 0; ai < 2; ++ai)
#pragma unroll
                for (int m = 0; m < 4; ++m) {
                    const unsigned o = opaque(off0 + (unsigned)(ai * 128 + m * 16) * 2048u); float ss = 0.f;
#pragma unroll
                    for (int bj = 0; bj < 2; ++bj)
#pragma unroll
                        for (int n = 0; n < 2; ++n) { const f32x4 x = acc[ai][bj][m][n]; ss += (x[0] * x[0] + x[1] * x[1]) + (x[2] * x[2] + x[3] * x[3]); }
                    ss += __shfl_xor(ss, 16); ss += __shfl_xor(ss, 32);
                    const float r = __builtin_amdgcn_rsqf(ss * (1.0f / 64.0f) + EPSN);
#pragma unroll
                    for (int bj = 0; bj < 2; ++bj)
                        *(u32x4*)((char*)Q + o + 64 * bj) = pack8(acc[ai][bj][m][0] * r * gq[bj][0], acc[ai][bj][m][1] * r * gq[bj][1]);
                }
            return;
        }
        char* dst; unsigned ld, cb; int kind;
        if (pn < 4) { dst = (char*)U; ld = 1024; cb = pn * 256; kind = 0; }
        else if (pn < 8) { dst = (char*)ZA; ld = 1024; cb = (pn - 4) * 256; kind = 1; }
        else if (pn < 17) { dst = (char*)ZB; ld = 1024; cb = (pn - 13) * 256; kind = 1; }
        else if (pn < 25) { dst = (char*)GA; ld = 2048; cb = (pn - 17) * 256; kind = 2; }
        else { dst = (char*)GB; ld = 2048; cb = (pn - 25) * 256; kind = 2; }
        const unsigned off0 = ((unsigned)row0 * ld + cb + (unsigned)lc0) * 2u;
#pragma unroll
        for (int ai = 0; ai < 2; ++ai)
#pragma unroll
            for (int m = 0; m < 4; ++m) {
                const unsigned o = opaque(off0 + (unsigned)(ai * 128 + m * 16) * ld * 2u);
#pragma unroll
                for (int bj = 0; bj < 2; ++bj) {
                    f32x4 v0 = acc[ai][bj][m][0], v1 = acc[ai][bj][m][1];
                    if (kind == 1) {
#pragma unroll
                        for (int i = 0; i < 4; ++i) { v0[i] = siluf_(v0[i]); v1[i] = siluf_(v1[i]); } }
                    else if (kind == 2) {
#pragma unroll
                        for (int i = 0; i < 4; ++i) { v0[i] = sigmoidf_(v0[i]); v1[i] = sigmoidf_(v1[i]); } }
                    *(u32x4*)(dst + o + 64 * bj) = pack8(v0, v1);
                }
            }
    }
};

struct EpiGlu {
    static constexpr bool PERM = true, HAS_MID = false;
    const bf16_t* G; bf16_t* ZA; const float* bias;
    __device__ __forceinline__ void operator()(AccRef acc, const pg8::Unit& u, int wr, int wc, int fr, int fq) const {
        const int row0 = u.pm * 256 + wr * 64 + fr, col0 = u.pn * 256 + wc * 32 + 8 * fq;
        f32x4 bv[2][2];
#pragma unroll
        for (int bj = 0; bj < 2; ++bj)
#pragma unroll
            for (int n = 0; n < 2; ++n) bv[bj][n] = *(const f32x4*)(bias + col0 + bj * 128 + 4 * n);
        const unsigned off0 = ((unsigned)row0 * 1024u + (unsigned)col0) * 2u;
#pragma unroll
        for (int ai = 0; ai < 2; ++ai)
#pragma unroll
            for (int m = 0; m < 4; ++m) {
                const unsigned o = opaque(off0 + (unsigned)(ai * 128 + m * 16) * 2048u);
#pragma unroll
                for (int bj = 0; bj < 2; ++bj) {
                    const u32x4 gw = *(const u32x4*)((const char*)G + o + bj * 256), zw = *(const u32x4*)((const char*)ZA + o + bj * 256);
                    const f32x4 a0 = acc[ai][bj][m][0] + bv[bj][0], a1 = acc[ai][bj][m][1] + bv[bj][1];
                    f32x4 o0, o1;
                    o0[0] = bflo(gw.x) * sigmoidf_(a0[0]) * bflo(zw.x); o0[1] = bfhi(gw.x) * sigmoidf_(a0[1]) * bfhi(zw.x);
                    o0[2] = bflo(gw.y) * sigmoidf_(a0[2]) * bflo(zw.y); o0[3] = bfhi(gw.y) * sigmoidf_(a0[3]) * bfhi(zw.y);
                    o1[0] = bflo(gw.z) * sigmoidf_(a1[0]) * bflo(zw.z); o1[1] = bfhi(gw.z) * sigmoidf_(a1[1]) * bfhi(zw.z);
                    o1[2] = bflo(gw.w) * sigmoidf_(a1[2]) * bflo(zw.w); o1[3] = bfhi(gw.w) * sigmoidf_(a1[3]) * bfhi(zw.w);
                    *(u32x4*)((char*)ZA + o + bj * 256) = pack8(o0, o1);
                }
            }
    }
};

struct EpiOut {
    static constexpr bool PERM = true, HAS_MID = true;
    const bf16_t *GA, *GB; bf16_t* MX;
    __device__ __forceinline__ void mid(AccMut acc, const pg8::Unit& u, int wr, int wc, int fr, int fq) const {
        const int row0 = u.pm * 256 + wr * 64 + fr, col0 = u.pn * 256 + wc * 32 + 8 * fq;
        const unsigned off0 = ((unsigned)row0 * 2048u + (unsigned)col0) * 2u;
#pragma unroll
        for (int ai = 0; ai < 2; ++ai)
#pragma unroll
            for (int m = 0; m < 4; ++m) {
                const unsigned o = opaque(off0 + (unsigned)(ai * 128 + m * 16) * 4096u);
#pragma unroll
                for (int bj = 0; bj < 2; ++bj) {
                    const u32x4 a = *(const u32x4*)((const char*)GA + o + bj * 256), b = *(const u32x4*)((const char*)GB + o + bj * 256);
                    f32x4 r0, r1;
                    r0[0] = bflo(a.x) * __builtin_amdgcn_rcpf(bflo(b.x)); r0[1] = bfhi(a.x) * __builtin_amdgcn_rcpf(bfhi(b.x));
                    r0[2] = bflo(a.y) * __builtin_amdgcn_rcpf(bflo(b.y)); r0[3] = bfhi(a.y) * __builtin_amdgcn_rcpf(bfhi(b.y));
                    r1[0] = bflo(a.z) * __builtin_amdgcn_rcpf(bflo(b.z)); r1[1] = bfhi(a.z) * __builtin_amdgcn_rcpf(bfhi(b.z));
                    r1[2] = bflo(a.w) * __builtin_amdgcn_rcpf(bflo(b.w)); r1[3] = bfhi(a.w) * __builtin_amdgcn_rcpf(bfhi(b.w));
                    acc[ai][bj][m][0] *= r0; acc[ai][bj][m][1] *= r1;
                }
                asm volatile("" ::: "memory");
            }
    }
    __device__ __forceinline__ void operator()(AccRef acc, const pg8::Unit& u, int wr, int wc, int fr, int fq) const {
        const int row0 = u.pm * 256 + wr * 64 + fr, col0 = u.pn * 256 + wc * 32 + 8 * fq;
        const unsigned off0 = ((unsigned)row0 * 2048u + (unsigned)col0) * 2u;
#pragma unroll
        for (int ai = 0; ai < 2; ++ai)
#pragma unroll
            for (int m = 0; m < 4; ++m) {
                const unsigned o = opaque(off0 + (unsigned)(ai * 128 + m * 16) * 4096u);
#pragma unroll
                for (int bj = 0; bj < 2; ++bj) {
                    const u32x4 b = *(const u32x4*)((const char*)GB + o + bj * 256);
                    f32x4 g0, g1; g0[0] = bflo(b.x); g0[1] = bfhi(b.x); g0[2] = bflo(b.y); g0[3] = bfhi(b.y); g1[0] = bflo(b.z); g1[1] = bfhi(b.z); g1[2] = bflo(b.w); g1[3] = bfhi(b.w);
                    *(u32x4*)((char*)MX + o + bj * 256) = pack8(acc[ai][bj][m][0] * g0, acc[ai][bj][m][1] * g1);
                }
            }
    }
};

struct EpiRes {
    static constexpr bool PERM = false, HAS_MID = false;
    const float *xp, *xs; float* out;
    __device__ __forceinline__ void operator()(AccRef acc, const pg8::Unit& u, int wr, int wc, int fr, int fq) const {
        const int row0 = u.pm * 256 + wr * 64 + fr, col0 = u.pn * 256 + wc * 32 + 4 * fq;
        const bool smp = u.pm >= MP / 256;
        const char* xb = (const char*)(smp ? xs : xp); char* ob = (char*)(smp ? out + O_YS : out + O_YP);
        const unsigned off0 = ((unsigned)(smp ? row0 - MP : row0) * (unsigned)DM + (unsigned)col0) * 4u;
#pragma unroll
        for (int ai = 0; ai < 2; ++ai)
#pragma unroll
            for (int m = 0; m < 4; ++m) {
                const int row = row0 + ai * 128 + m * 16;
                if (row < MP + MS) {
                    const unsigned o = opaque(off0 + (unsigned)(ai * 128 + m * 16) * (unsigned)(DM * 4));
#pragma unroll
                    for (int bj = 0; bj < 2; ++bj)
#pragma unroll
                        for (int n = 0; n < 2; ++n) { const unsigned c = o + (unsigned)(bj * 128 + n * 16) * 4u; *(f32x4*)(ob + c) = *(const f32x4*)(xb + c) + acc[ai][bj][m][n]; }
                }
            }
    }
};

struct Args {
    const float* in[25]; float* out; unsigned char* ws; int ph_lo, ph_hi;
};
struct Frame {
    LAS unsigned char* lds; int tid, lane, wave, G, gw, NGW;
    float* out; unsigned char* ws;
};
__device__ __forceinline__ float wave_sum(float v) {
#pragma unroll
    for (int o = 1; o < 64; o <<= 1) v += __shfl_xor(v, o);
    return v;
}

template <bool SIGMA>
__device__ __forceinline__ void p0_transpose_item(const float* W, int N, bf16_t* WT, int ldk, int koff, LAS float* scr, int item, int lane) {
    const int nblk = N / 32, kb = item / nblk, nb = item % nblk, k0 = 64 * kb, n0 = 32 * nb;
#pragma unroll 8
    for (int i = 0; i < 32; ++i) { const int kk = 2 * i + (lane >> 5); scr[kk * 33 + (lane & 31)] = W[(size_t)(k0 + kk) * N + n0 + (lane & 31)]; }
    asm volatile("s_waitcnt lgkmcnt(0)" ::: "memory");
    const int c = lane & 7;
#pragma unroll
    for (int j = 0; j < 4; ++j) { const int n = (lane >> 3) + 8 * j; const LAS float* s = scr + (8 * c) * 33 + n;
        u32x4 o; o.x = cvt_pk_bf16(s[0 * 33], s[1 * 33]); o.y = cvt_pk_bf16(s[2 * 33], s[3 * 33]); o.z = cvt_pk_bf16(s[4 * 33], s[5 * 33]); o.w = cvt_pk_bf16(s[6 * 33], s[7 * 33]);
        int nl = n0 + n;
        if (SIGMA) { const int lc = nl & 255, wcc = lc >> 6, bjj = (lc >> 5) & 1, jj = lc & 31; nl = (nl & ~255) + 128 * bjj + 32 * wcc + jj; }
        *(u32x4*)(WT + (size_t)nl * ldk + koff + k0 + 8 * c) = o; }
    asm volatile("s_waitcnt lgkmcnt(0)" ::: "memory");
}
__device__ __forceinline__ void p0_norm_row(const float* xrow, const f32x4 (&gv)[8], bf16_t* orow, int lane) {
    const f32x4* xr = (const f32x4*)xrow + lane;
    f32x4 v[8]; float s = 0.f;
#pragma unroll
    for (int j = 0; j < 8; ++j) { v[j] = xr[64 * j]; s += (v[j][0] * v[j][0] + v[j][1] * v[j][1]) + (v[j][2] * v[j][2] + v[j][3] * v[j][3]); }
    const float rstd = 1.0f / sqrtf(wave_sum(s) * (1.0f / DM) + EPSN);
    u32x2* o8 = (u32x2*)orow + lane;
#pragma unroll
    for (int j = 0; j < 8; ++j) { const f32x4 y = v[j] * rstd * gv[j]; u32x2 w; w.x = cvt_pk_bf16(y[0], y[1]); w.y = cvt_pk_bf16(y[2], y[3]); o8[64 * j] = w; }
}
__device__ __forceinline__ void p0_prologue(Frame& F, const Args& AR) {
    LAS float* scr = (LAS float*)(F.lds + F.wave * 16384);
    const float* w_in = AR.in[7]; const float* w_glu = AR.in[16]; const float* w_oa = AR.in[22]; const float* w_ob = AR.in[23]; const float* w_o = AR.in[24];
    bf16_t* WIN = (bf16_t*)(F.ws + WS_WIN); bf16_t* WGLU = (bf16_t*)(F.ws + WS_WGLU); bf16_t* WOUT = (bf16_t*)(F.ws + WS_WOUT); bf16_t* WO = (bf16_t*)(F.ws + WS_WO);
    constexpr int I_IN = (DM / 64) * (NIN / 32), I_GLU = (1024 / 64) * (1024 / 32), I_OA = (1024 / 64) * (DM / 32), I_O = (DM / 64) * (DM / 32);
    constexpr int NITEMS = I_IN + I_GLU + 2 * I_OA + I_O;
    for (int it = F.gw; it < NITEMS; it += F.NGW) {
        int r = it;
        if (r < I_IN) { p0_transpose_item<true>(w_in, NIN, WIN, DM, 0, scr, r, F.lane); continue; } r -= I_IN;
        if (r < I_GLU) { p0_transpose_item<false>(w_glu, 1024, WGLU, 1024, 0, scr, r, F.lane); continue; } r -= I_GLU;
        if (r < I_OA) { p0_transpose_item<false>(w_oa, DM, WOUT, 2048, 0, scr, r, F.lane); continue; } r -= I_OA;
        if (r < I_OA) { p0_transpose_item<false>(w_ob, DM, WOUT, 2048, 1024, scr, r, F.lane); continue; } r -= I_OA;
        p0_transpose_item<false>(w_o, DM, WO, DM, 0, scr, r, F.lane);
    }
    { f32x4 gv[8];
#pragma unroll
      for (int j = 0; j < 8; ++j) gv[j] = ((const f32x4*)AR.in[6])[F.lane + 64 * j];
      bf16_t* XN = (bf16_t*)(F.ws + WS_XN);
      for (int m = F.gw; m < MROWS; m += F.NGW) {
          if (m < MP) p0_norm_row(AR.in[0] + (size_t)m * DM, gv, XN + (size_t)m * DM, F.lane);
          else if (m < MP + MS) p0_norm_row(AR.in[1] + (size_t)(m - MP) * DM, gv, XN + (size_t)m * DM, F.lane);
          else { u32x2* o8 = (u32x2*)(XN + (size_t)m * DM) + F.lane;
#pragma unroll
              for (int j = 0; j < 8; ++j) o8[64 * j] = (u32x2){0u, 0u}; }
      } }
    const int gt = blockIdx.x * 512 + F.tid;
    if (gt < NGRP * NSTATE) {
        const int g = gt >> 6, p = gt & 63;
        const double are = (double)AR.in[8][gt], aim = (double)AR.in[9][gt], dt = exp((double)AR.in[10][g]);
        const double mag = exp(are * dt), ang = aim * dt, lre = mag * cos(ang), lim = mag * sin(ang);
        const double den = are * are + aim * aim, cr = ((lre - 1.0) * are + lim * aim) / den, ci = (lim * are - (lre - 1.0) * aim) / den;
        float* LAM = (float*)(F.ws + WS_CONST + C_LAM); float* LAM64 = (float*)(F.ws + WS_CONST + C_LAM64);
        LAM[2 * gt] = (float)lre; LAM[2 * gt + 1] = (float)lim;
        double pr = lre, pi = lim;
#pragma unroll 1
        for (int i = 0; i < 6; ++i) { const double nr = pr * pr - pi * pi, ni = 2.0 * pr * pi; pr = nr; pi = ni; }
        LAM64[2 * gt] = (float)pr; LAM64[2 * gt + 1] = (float)pi;
        bf16_t* BF = (bf16_t*)(F.ws + WS_CONST + C_BF); bf16_t* CF = (bf16_t*)(F.ws + WS_CONST + C_CF);
        const float* bre = AR.in[11] + (size_t)gt * 16; const float* bim = AR.in[12] + (size_t)gt * 16;
#pragma unroll 1
        for (int c = 0; c < 16; ++c) {
            const double br = (double)bre[c], bi = (double)bim[c];
            const float bbr = (float)(cr * br - ci * bi), bbi = (float)(cr * bi + ci * br);
            const int q = c >> 2, jj = c & 3;
            { const int row = p, pt = row >> 4, ps = row & 15; BF[((size_t)(g * 8 + pt) * 64 + 16 * q + ps) * 4 + jj] = (bf16_t)(cvt_pk_bf16(bbr, 0.f) & 0xffffu); }
            { const int row = 64 + p, pt = row >> 4, ps = row & 15; BF[((size_t)(g * 8 + pt) * 64 + 16 * q + ps) * 4 + jj] = (bf16_t)(cvt_pk_bf16(bbi, 0.f) & 0xffffu); }
            const float cre = AR.in[13][(size_t)(g * 16 + c) * 64 + p], cim = AR.in[14][(size_t)(g * 16 + c) * 64 + p];
            const int ks = p >> 4, qq = (p >> 2) & 3, jb = 2 * (p & 3);
            CF[((size_t)(g * 4 + ks) * 64 + 16 * qq + c) * 8 + jb] = (bf16_t)(cvt_pk_bf16(cre, 0.f) & 0xffffu);
            CF[((size_t)(g * 4 + ks) * 64 + 16 * qq + c) * 8 + jb + 1] = (bf16_t)(cvt_pk_bf16(-cim, 0.f) & 0xffffu);
        }
    }
    if (gt < 16 * 256) {
        const int h = gt >> 8, idx = gt & 255; float v = 0.f;
        if (idx < 255) { const int rel = idx - 191; int n = -rel; const int ret = n < 0 ? 16 : 0; n = n < 0 ? -n : n;
            const int large = 8 + (n >= 12) + (n >= 16) + (n >= 23) + (n >= 32) + (n >= 46) + (n >= 64) + (n >= 91);
            const int bucket = ret + (n < 8 ? n : large); v = AR.in[21][bucket * 16 + h] * LOG2E; }
        ((float*)(F.ws + WS_CONST + C_BT))[gt] = v;
    }
}

constexpr int SSM_UROW = 272, SSM_UT = 64 * SSM_UROW, SSM_BU = 128 * 80, SSM_HC = 16 * 272;
template <bool FULL>
__device__ __forceinline__ void ssm_unit(Frame& F, const float* ssm_d, bf16_t* U, int rowbase, int T, int gs, const float* hin_re, const float* hin_im, float* hout_re, float* hout_im) {
    LAS unsigned char* ut = F.lds;
    LAS unsigned char* bu = F.lds + SSM_UT + F.wave * SSM_BU;
    LAS unsigned char* hc = F.lds + SSM_UT + 8 * SSM_BU + F.wave * SSM_HC;
    const int lane = F.lane, w = F.wave, fr = lane & 15, fq = lane >> 4, g = gs * 8 + w;
#pragma unroll
    for (int i = 0; i < 2; ++i) { const int idx = F.tid + 512 * i, row = idx >> 4, ch = idx & 15;
        u32x4 v = (u32x4){0u, 0u, 0u, 0u};
        if (row < T) v = *(const u32x4*)(U + (size_t)(rowbase + row) * 1024 + gs * 128 + ch * 8);
        *(LAS u32x4*)(ut + row * SSM_UROW + ch * 16) = v; }
    const f32x2 lam = ((const f32x2*)(F.ws + WS_CONST + C_LAM))[g * 64 + lane];
    u32x2 bfr[8];
#pragma unroll
    for (int pt = 0; pt < 8; ++pt) bfr[pt] = ((const u32x2*)(F.ws + WS_CONST + C_BF))[(size_t)(g * 8 + pt) * 64 + lane];
    u32x4 cfr[4]; float dsk = 0.f;
    if (FULL) {
#pragma unroll
        for (int ks = 0; ks < 4; ++ks) cfr[ks] = ((const u32x4*)(F.ws + WS_CONST + C_CF))[(size_t)(g * 4 + ks) * 64 + lane];
        dsk = ssm_d[g * 16 + fr];
    }
    float hre = 0.f, him = 0.f;
    if (FULL && hin_re) { hre = hin_re[lane]; him = hin_im[lane]; }
    __syncthreads();
    const int nsb = T >> 4;
    for (int sb = 0; sb < nsb; ++sb) {
        const s16x4 af = __builtin_bit_cast(s16x4, *(const LAS u32x2*)(ut + (16 * sb + fr) * SSM_UROW + w * 32 + fq * 8));
#pragma unroll
        for (int pt = 0; pt < 8; ++pt) {
            const f32x4 d = __builtin_amdgcn_mfma_f32_16x16x16bf16_1k(af, __builtin_bit_cast(s16x4, bfr[pt]), (f32x4){0.f, 0.f, 0.f, 0.f}, 0, 0, 0);
            *(LAS f32x4*)(bu + (16 * pt + fr) * 80 + fq * 16) = d;
        }
        asm volatile("s_waitcnt lgkmcnt(0)" ::: "memory");
        f32x4 br[4], bi[4];
#pragma unroll
        for (int k = 0; k < 4; ++k) { br[k] = *(const LAS f32x4*)(bu + lane * 80 + k * 16); bi[k] = *(const LAS f32x4*)(bu + (64 + lane) * 80 + k * 16); }
#pragma unroll
        for (int t = 0; t < 16; ++t) {
            const float nre = lam.x * hre - lam.y * him + br[t >> 2][t & 3];
            const float nim = lam.x * him + lam.y * hre + bi[t >> 2][t & 3];
            hre = nre; him = nim;
            if (FULL) *(LAS unsigned*)(hc + t * 272 + lane * 4) = cvt_pk_bf16(hre, him);
        }
        if (FULL) {
            asm volatile("s_waitcnt lgkmcnt(0)" ::: "memory");
            f32x4 y = (f32x4){0.f, 0.f, 0.f, 0.f};
#pragma unroll
            for (int ks = 0; ks < 4; ++ks) {
                const bf16x8 a = *(const LAS bf16x8*)(hc + fr * 272 + ks * 64 + fq * 16);
                y = __builtin_amdgcn_mfma_f32_16x16x32_bf16(a, __builtin_bit_cast(bf16x8, cfr[ks]), y, 0, 0, 0);
            }
#pragma unroll
            for (int r = 0; r < 4; ++r) {
                LAS unsigned short* up = (LAS unsigned short*)(ut + (16 * sb + 4 * fq + r) * SSM_UROW + w * 32 + fr * 2);
                const float uv = bf2f(*up);
                *up = (unsigned short)(cvt_pk_bf16(geluf_(y[r] + dsk * uv), 0.f) & 0xffffu);
            }
            asm volatile("s_waitcnt lgkmcnt(0)" ::: "memory");
        }
    }
    if (hout_re) { hout_re[lane] = hre; hout_im[lane] = him; }
    if (FULL) {
        __syncthreads();
#pragma unroll
        for (int i = 0; i < 2; ++i) { const int idx = F.tid + 512 * i, row = idx >> 4, ch = idx & 15;
            if (row < T) *(u32x4*)(U + (size_t)(rowbase + row) * 1024 + gs * 128 + ch * 8) = *(const LAS u32x4*)(ut + row * SSM_UROW + ch * 16); }
    }
    __syncthreads();
}

constexpr int AT_K = 0, AT_V = 24576, AT_BT = 49152, AT_WS = 57344, AT_OST = 59392;
__device__ __forceinline__ int crow(int r, int hi) { return (r & 3) + 8 * (r >> 2) + 4 * hi; }
struct AttnUnit {
    int kvrow[3];
    const float* ck; const float* cv;
    int nkeys[3];
    int qrow0, nq, kvh;
};
__device__ __forceinline__ void attn_unit(Frame& F, const float* sinks, const AttnUnit& A, bf16_t* Q, const bf16_t* Kb, const bf16_t* Vb, const bf16_t* ZB) {
    const int lane = F.lane, w = F.wave, r32 = lane & 31, hi = lane >> 5, h = A.kvh * 8 + w;
    LAS unsigned char* lds = F.lds;
#pragma unroll
    for (int s = 0; s < 3; ++s) {
        if (A.nkeys[s] == 0) continue;
        u32x4 kw = (u32x4){0u, 0u, 0u, 0u}, vw = (u32x4){0u, 0u, 0u, 0u};
        const int vrow = 16 * (w & 3) + (lane >> 2);
        if (A.kvrow[s] >= 0) {
            const size_t krow = (size_t)A.kvrow[s];
            if (lane < A.nkeys[s]) kw = *(const u32x4*)(Kb + (krow + lane) * 128 + A.kvh * 64 + w * 8);
            if (vrow < A.nkeys[s]) vw = *(const u32x4*)(Vb + (krow + vrow) * 128 + A.kvh * 64 + (w >> 2) * 32 + (lane & 3) * 8);
        } else {
            const float* kp = A.ck + ((size_t)(64 * s + lane) * 2 + A.kvh) * 64 + w * 8;
            const f32x4 k0 = *(const f32x4*)kp, k1 = *(const f32x4*)(kp + 4); kw = pack8(k0, k1);
            const float* vp = A.cv + ((size_t)(64 * s + vrow) * 2 + A.kvh) * 64 + (w >> 2) * 32 + (lane & 3) * 8;
            const f32x4 v0 = *(const f32x4*)vp, v1 = *(const f32x4*)(vp + 4); vw = pack8(v0, v1);
        }
        *(LAS u32x4*)(lds + AT_K + s * 8192 + w * 1024 + lane * 16) = kw;
        *(LAS u32x4*)(lds + AT_V + s * 8192 + w * 1024 + lane * 16) = vw;
    }
#pragma unroll
    for (int i = 0; i < 4; ++i) { const int idx = F.tid + 512 * i; ((LAS float*)(lds + AT_BT))[idx] = ((const float*)(F.ws + WS_CONST + C_BT))[A.kvh * 2048 + idx]; }
    __syncthreads();
    const float sink = sinks[h] * LOG2E;
    const LAS float* bt = (const LAS float*)(lds + AT_BT) + w * 256;
    LAS float* wsf = (LAS float*)(lds + AT_WS) + w * 64;
    const int nqt = (A.nq + 31) >> 5;
    for (int qt = 0; qt < nqt; ++qt) {
        const bf16_t* Qw = Q + (size_t)(A.qrow0 + 32 * qt + r32) * 1024 + h * 64;
        bf16x8 qr[4];
#pragma unroll
        for (int d0 = 0; d0 < 4; ++d0) qr[d0] = *(const bf16x8*)(Qw + d0 * 16 + hi * 8);
        f32x16 p[6];
        const int qoff = 32 * qt + r32;
#pragma unroll
        for (int kt = 0; kt < 6; ++kt) {
            const int s = kt >> 1, nk = A.nkeys[s] - 32 * (kt & 1);
            if (nk <= 0) {
#pragma unroll
                for (int r = 0; r < 16; ++r) p[kt][r] = -INFINITY;
                continue;
            }
            f32x16 c;
#pragma unroll
            for (int r = 0; r < 16; ++r) c[r] = bt[32 * kt + crow(r, hi) - qoff + 63];
            const LAS unsigned char* kb = lds + AT_K + s * 8192 + hi * 1024 + r32 * 16 + (kt & 1) * 512;
#pragma unroll
            for (int d0 = 0; d0 < 4; ++d0) c = __builtin_amdgcn_mfma_f32_32x32x16_bf16(*(const LAS bf16x8*)(kb + d0 * 2048), qr[d0], c, 0, 0, 0);
            if (nk < 32) {
#pragma unroll
                for (int r = 0; r < 16; ++r) if (crow(r, hi) >= nk) c[r] = -INFINITY;
            }
            p[kt] = c;
        }
        float mx = sink;
#pragma unroll
        for (int kt = 0; kt < 6; ++kt)
#pragma unroll
            for (int r = 0; r < 16; ++r) mx = fmaxf(mx, p[kt][r]);
        mx = fmaxf(mx, __shfl_xor(mx, 32));
        float l = 0.f;
#pragma unroll
        for (int kt = 0; kt < 6; ++kt)
#pragma unroll
            for (int r = 0; r < 16; ++r) { const float e = __builtin_amdgcn_exp2f(p[kt][r] - mx); p[kt][r] = e; l += e; }
        l += __shfl_xor(l, 32);
        l += __builtin_amdgcn_exp2f(sink - mx);
        if (hi == 0) wsf[r32] = l;
        f32x16 o[2]; o[0] = (f32x16){}; o[1] = (f32x16){};
        const int vb0 = ((lane >> 4) & 1) * 32 + (lane & 3) * 8 + (4 * hi + ((lane & 15) >> 2)) * 64;
#pragma unroll
        for (int kt = 0; kt < 6; ++kt) {
            const int s = kt >> 1;
            if (A.nkeys[s] - 32 * (kt & 1) <= 0) continue;
#pragma unroll
            for (int ss = 0; ss < 2; ++ss) {
                u32x4 pw; pw.x = cvt_pk_bf16(p[kt][8 * ss + 0], p[kt][8 * ss + 1]); pw.y = cvt_pk_bf16(p[kt][8 * ss + 2], p[kt][8 * ss + 3]);
                pw.z = cvt_pk_bf16(p[kt][8 * ss + 4], p[kt][8 * ss + 5]); pw.w = cvt_pk_bf16(p[kt][8 * ss + 6], p[kt][8 * ss + 7]);
                const int ks = 2 * (kt & 1) + ss;
#pragma unroll
                for (int d0 = 0; d0 < 2; ++d0) {
                    const LAS unsigned char* vp = lds + AT_V + s * 8192 + d0 * 4096 + ks * 1024 + vb0;
                    const s16x4 lo = __builtin_bit_cast(s16x4, __builtin_amdgcn_ds_read_tr16_b64_v4i16((LAS s16x4*)vp));
                    const s16x4 hi4 = __builtin_bit_cast(s16x4, __builtin_amdgcn_ds_read_tr16_b64_v4i16((LAS s16x4*)(vp + 512)));
                    const bf16x8 vf = (bf16x8){lo[0], lo[1], lo[2], lo[3], hi4[0], hi4[1], hi4[2], hi4[3]};
                    o[d0] = __builtin_amdgcn_mfma_f32_32x32x16_bf16(__builtin_bit_cast(bf16x8, pw), vf, o[d0], 0, 0, 0);
                }
            }
        }
        asm volatile("s_waitcnt lgkmcnt(0)" ::: "memory");
        LAS bf16_t* stg = (LAS bf16_t*)(lds + AT_OST) + w * 2048;
#pragma unroll
        for (int r = 0; r < 16; ++r) { const int orow = crow(r, hi); const float rl = __builtin_amdgcn_rcpf(wsf[orow]);
#pragma unroll
            for (int d0 = 0; d0 < 2; ++d0) stg[orow * 64 + d0 * 32 + r32] = (bf16_t)(cvt_pk_bf16(o[d0][r] * rl, 0.f) & 0xffffu); }
        asm volatile("s_waitcnt lgkmcnt(0)" ::: "memory");
#pragma unroll
        for (int i = 0; i < 4; ++i) { const int row = i * 8 + (lane >> 3), ch = lane & 7;
            if (32 * qt + row < A.nq) {
                const size_t off = (size_t)(A.qrow0 + 32 * qt + row) * 1024 + h * 64 + ch * 8;
                const u32x4 ov = *(const LAS u32x4*)(stg + row * 64 + ch * 8), zv = *(const u32x4*)(ZB + off);
                u32x4 res; res.x = cvt_pk_bf16(bflo(ov.x) * bflo(zv.x), bfhi(ov.x) * bfhi(zv.x)); res.y = cvt_pk_bf16(bflo(ov.y) * bflo(zv.y), bfhi(ov.y) * bfhi(zv.y));
                res.z = cvt_pk_bf16(bflo(ov.z) * bflo(zv.z), bfhi(ov.z) * bfhi(zv.z)); res.w = cvt_pk_bf16(bflo(ov.w) * bflo(zv.w), bfhi(ov.w) * bfhi(zv.w));
                *(u32x4*)(Q + off) = res; } }
        asm volatile("s_waitcnt lgkmcnt(0)" ::: "memory");
    }
    __syncthreads();
}

__global__ void __launch_bounds__(512, 2) mk_fwd(Args args) {
    extern __shared__ __attribute__((aligned(16))) unsigned char lds_raw[];
    Frame F;
    F.lds = (LAS unsigned char*)lds_raw;
    F.tid = threadIdx.x; F.lane = F.tid & 63; F.wave = __builtin_amdgcn_readfirstlane(F.tid >> 6);
    F.G = gridDim.x; F.gw = blockIdx.x * 8 + F.wave; F.NGW = F.G * 8;
    F.out = args.out; F.ws = args.ws;
    cg::grid_group grid = cg::this_grid();
    const int lo = args.ph_lo, hi = args.ph_hi;
#ifndef PH_MASK
#define PH_MASK 0xff
#endif
#define IN(k) (((PH_MASK >> (k)) & 1) && lo <= (k) && (k) < hi)
#define SEAM(k) do { if (IN(k) && IN((k) + 1)) grid.sync(); } while (0)
    bf16_t* XN = (bf16_t*)(F.ws + WS_XN); bf16_t* U = (bf16_t*)(F.ws + WS_U); bf16_t* ZA = (bf16_t*)(F.ws + WS_ZA); bf16_t* Qb = (bf16_t*)(F.ws + WS_Q); bf16_t* ZB = (bf16_t*)(F.ws + WS_ZB);
    bf16_t* Kb = (bf16_t*)(F.ws + WS_K); bf16_t* Vb = (bf16_t*)(F.ws + WS_V); bf16_t* GA = (bf16_t*)(F.ws + WS_GA); bf16_t* GB = (bf16_t*)(F.ws + WS_GB);
    float* Sst = (float*)(F.ws + WS_S); float* Hin = (float*)(F.ws + WS_HIN);

    if (IN(0)) p0_prologue(F, args);
    SEAM(0);
    if (IN(1)) {
        pg8::Gemm g{XN, XN, (const bf16_t*)(F.ws + WS_WIN), DM, DM, 1 << 20, MROWS / 256, NIN / 256};
        pg8::StaticOrder S; S.init(g.nM, g.nN, F.G, (int)blockIdx.x);
        EpiIn E{U, ZA, Qb, ZB, Kb, Vb, GA, GB, args.in[18], args.in[19], F.out};
        pg8::gemm_phase<EpiIn, true>(F.lds, g, S, E);
    }
    SEAM(1);
    if (IN(2)) {
        for (int it = blockIdx.x; it < NBATCH * NCHUNK * 8; it += F.G) {
            const int gs = it & 7, bj = it >> 3;
            float* so = Sst + ((size_t)bj * NGRP + gs * 8 + F.wave) * 128;
            ssm_unit<false>(F, args.in[15], U, bj * 64, 64, gs, nullptr, nullptr, so, so + 64);
        }
        for (int it = blockIdx.x; it < NBATCH * NCHUNK * 2 + NBATCH * 2; it += F.G) {
            AttnUnit A;
            if (it < NBATCH * NCHUNK * 2) {
                const int kvh = it & 1, bc = it >> 1, c = bc & 63;
#pragma unroll
                for (int s = 0; s < 3; ++s) { const int cc = c - 2 + s; A.nkeys[s] = cc >= 0 ? 64 : 0; A.kvrow[s] = cc >= 0 ? (bc - 2 + s) * 64 : 0; }
                A.ck = nullptr; A.cv = nullptr; A.qrow0 = bc * 64; A.nq = 64; A.kvh = kvh;
            } else {
                const int r = it - NBATCH * NCHUNK * 2, kvh = r & 1, b = r >> 1;
                A.nkeys[0] = 64; A.nkeys[1] = 64; A.nkeys[2] = 16; A.kvrow[0] = -1; A.kvrow[1] = -1; A.kvrow[2] = MP + 16 * b;
                A.ck = args.in[2] + (size_t)b * 128 * 128; A.cv = args.in[3] + (size_t)b * 128 * 128; A.qrow0 = MP + 16 * b; A.nq = 16; A.kvh = kvh;
            }
            attn_unit(F, args.in[20], A, Qb, Kb, Vb, ZB);
        }
    }
    SEAM(2);
    if (IN(3)) {
        if (F.wave < 2) {
            for (int idx = blockIdx.x * 2 + F.wave; idx < NBATCH * NGRP; idx += F.G * 2) {
                const int b = idx >> 6, g = idx & 63;
                const f32x2 l64 = ((const f32x2*)(F.ws + WS_CONST + C_LAM64))[g * 64 + F.lane];
                float hre = 0.f, him = 0.f;
#pragma unroll 8
                for (int j = 0; j < NCHUNK; ++j) {
                    const size_t o = ((size_t)(b * 64 + j) * NGRP + g) * 128 + F.lane;
                    Hin[o] = hre; Hin[o + 64] = him;
                    const float sre = Sst[o], sim = Sst[o + 64];
                    const float nre = l64.x * hre - l64.y * him + sre, nim = l64.x * him + l64.y * hre + sim;
                    hre = nre; him = nim;
                }
                F.out[O_PRE + (size_t)(b * 64 + g) * 64 + F.lane] = hre; F.out[O_PIM + (size_t)(b * 64 + g) * 64 + F.lane] = him;
            }
        }
        for (int it = blockIdx.x; it < NBATCH * 8; it += F.G) {
            const int gs = it & 7, b = it >> 3; const size_t so = (size_t)(b * 64 + gs * 8 + F.wave) * 64;
            ssm_unit<true>(F, args.in[15], U, MP + 16 * b, 16, gs, args.in[4] + so, args.in[5] + so, F.out + O_SRE + so, F.out + O_SIM + so);
        }
    }
    SEAM(3);
    if (IN(4)) {
        for (int it = blockIdx.x; it < NBATCH * NCHUNK * 8; it += F.G) {
            const int gs = it & 7, bj = it >> 3;
            const float* hi_ = Hin + ((size_t)bj * NGRP + gs * 8 + F.wave) * 128;
            ssm_unit<true>(F, args.in[15], U, bj * 64, 64, gs, hi_, hi_ + 64, nullptr, nullptr);
        }
    }
    SEAM(4);
    if (IN(5)) {
        pg8::Gemm g{U, U, (const bf16_t*)(F.ws + WS_WGLU), 1024, 1024, 1 << 20, MROWS / 256, 4};
        pg8::StaticOrder S; S.init(g.nM, g.nN, F.G, (int)blockIdx.x);
        EpiGlu E{U, ZA, args.in[17]};
        pg8::gemm_phase<EpiGlu, true>(F.lds, g, S, E);
    }
    SEAM(5);
    if (IN(6)) {
        pg8::Gemm g{ZA, Qb, (const bf16_t*)(F.ws + WS_WOUT), 1024, 2048, 16, MROWS / 256, 8};
        pg8::StaticOrder S; S.init(g.nM, g.nN, F.G, (int)blockIdx.x);
        EpiOut E{GA, GB, XN};
        pg8::gemm_phase<EpiOut, true>(F.lds, g, S, E);
    }
    SEAM(6);
    if (IN(7)) {
        pg8::Gemm g{XN, XN, (const bf16_t*)(F.ws + WS_WO), DM, DM, 1 << 20, MROWS / 256, 8};
        pg8::StaticOrder S; S.init(g.nM, g.nN, F.G, (int)blockIdx.x);
        EpiRes E{args.in[0], args.in[1], F.out};
        pg8::gemm_phase<EpiRes, true>(F.lds, g, S, E);
    }
#undef IN
#undef SEAM
}

extern "C" void kernel_launch(void* const* d_in, const int* in_sizes, int n_in, void* d_out, int out_size, void* d_ws, size_t ws_size, hipStream_t stream) {
    static int grid = 0;
    if (grid == 0) {
        if (n_in != 25 || ws_size < WS_END) { fprintf(stderr, "kernel_launch: unexpected n_in %d / ws %zu\n", n_in, ws_size); grid = -1; return; }
        int dev = 0, cus = 0, per_cu = 0;
        hipGetDevice(&dev); hipDeviceGetAttribute(&cus, hipDeviceAttributeMultiprocessorCount, dev);
        hipFuncSetAttribute((const void*)mk_fwd, hipFuncAttributeMaxDynamicSharedMemorySize, LDS_BYTES);
        hipOccupancyMaxActiveBlocksPerMultiprocessor(&per_cu, (const void*)mk_fwd, 512, LDS_BYTES);
        if (per_cu < 1) { fprintf(stderr, "kernel_launch: occupancy query says %d blocks/CU\n", per_cu); per_cu = 1; }
        (void)hipGetLastError();
        grid = cus;
    }
    if (grid < 0) return;
    Args a{};
    for (int i = 0; i < 25; ++i) a.in[i] = (const float*)d_in[i];
    a.out = (float*)d_out; a.ws = (unsigned char*)d_ws;
    constexpr int NPH = 8;
    if (MK_N_LAUNCHES == 1) {
        a.ph_lo = 0; a.ph_hi = NPH;
        void* kargs[] = {&a};
        hipError_t e = hipLaunchCooperativeKernel((const void*)mk_fwd, dim3(grid), dim3(512), kargs, LDS_BYTES, stream);
        if (e != hipSuccess) fprintf(stderr, "cooperative launch failed: %s (grid %d)\n", hipGetErrorString(e), grid);
    } else {
        for (int p = 0; p < NPH; ++p) { a.ph_lo = p; a.ph_hi = p + 1; hipLaunchKernelGGL(mk_fwd, dim3(grid), dim3(512), LDS_BYTES, stream, a); }
    }
}
```

```cpp
#include <hip/hip_runtime.h>
#include <hip/hip_cooperative_groups.h>
#include <cstdio>
#include <cstdint>
namespace cg = cooperative_groups;

#ifndef MK_N_LAUNCHES
#define MK_N_LAUNCHES 1
#endif

#define LAS __attribute__((address_space(3)))
typedef unsigned short bf16_t;
typedef short bf16x8 __attribute__((ext_vector_type(8)));
typedef short s16x4 __attribute__((ext_vector_type(4)));
typedef float f32x4 __attribute__((ext_vector_type(4)));
typedef float f32x2 __attribute__((ext_vector_type(2)));
typedef float f32x16 __attribute__((ext_vector_type(16)));
typedef unsigned u32x4 __attribute__((ext_vector_type(4)));
typedef unsigned u32x2 __attribute__((ext_vector_type(2)));

constexpr int DM = 2048, SEQ = 4096, NBATCH = 8, MP = NBATCH * SEQ, MS = 128, MROWS = 33024;
constexpr int NIN = 8448, NCHUNK = 64, NGRP = 64, NSTATE = 64;
constexpr float EPSN = 1e-6f, LOG2E = 1.4426950408889634f, QSCALE = 0.125f * 1.4426950408889634f;
constexpr size_t O_YP = 0, O_YS = 67108864, O_PRE = 67371008, O_PIM = 67403776, O_PK = 67436544, O_PV = 67567616, O_SRE = 67698688, O_SIM = 67731456, O_SK = 67764224, O_SV = 67780608;
constexpr size_t MiB = 1u << 20;
constexpr size_t WS_CTL = 0, WS_WIN = 1 * MiB, WS_WGLU = 34 * MiB, WS_WOUT = 36 * MiB, WS_WO = 44 * MiB, WS_CONST = 52 * MiB, WS_XN = 53 * MiB, WS_U = 182 * MiB, WS_ZA = 247 * MiB,
                 WS_Q = 312 * MiB, WS_ZB = 377 * MiB, WS_K = 442 * MiB, WS_V = 451 * MiB, WS_GA = 460 * MiB, WS_GB = 589 * MiB, WS_S = 718 * MiB, WS_HIN = 734 * MiB, WS_END = 750 * MiB;
constexpr size_t C_LAM = 0, C_LAM64 = 32768, C_BF = 65536, C_CF = 327680, C_BT = 589824;
constexpr int LDS_BYTES = 147456, MISC_OFF = 147456 - 64;

__device__ __forceinline__ unsigned cvt_pk_bf16(float lo, float hi) { unsigned r; asm volatile("v_cvt_pk_bf16_f32 %0, %1, %2" : "=v"(r) : "v"(lo), "v"(hi)); return r; }
__device__ __forceinline__ float bf2f(unsigned short b) { return __uint_as_float((unsigned)b << 16); }
__device__ __forceinline__ float bflo(unsigned w) { return __uint_as_float(w << 16); }
__device__ __forceinline__ float bfhi(unsigned w) { return __uint_as_float(w & 0xffff0000u); }
__device__ __forceinline__ float sigmoidf_(float x) { return __builtin_amdgcn_rcpf(1.0f + __builtin_amdgcn_exp2f(-LOG2E * x)); }
__device__ __forceinline__ float siluf_(float x) { return x * sigmoidf_(x); }
__device__ __forceinline__ float geluf_(float v) {
    const float av = fabsf(v), t = __builtin_amdgcn_rcpf(av * 0.2316418882f + 1.0f);
    float q = t * 0.5307027145f + (-0.7265760135f); q = q * t + 0.7107068705f; q = q * t + (-0.142248368f); q = q * t + 0.127414796f; q = q * t;
    const float e = __builtin_amdgcn_exp2f((v * v) * (-0.72134752044f));
    const float m = v * (q * e);
    return v < 0.f ? m : v - m;
}

namespace pg8 {
constexpr int BM = 256, BK = 64, HALF = 128, HTB = HALF * BK * 2, STAGE_BYTES = 8 * HTB, NXCD = 8, WGM = 8;
__host__ __device__ __forceinline__ int lds_byte(int r, int c) { const int st = (r >> 4) * 2 + (c >> 5), rr = r & 15, cc = c & 31, ob = rr * 64 + cc * 2; return st * 1024 + (ob ^ (((ob >> 9) & 1) << 5)); }
__host__ __device__ __forceinline__ void stage_rc(int b, int& R, int& C) { const int st = b / 1024, sb = b % 1024, swz = sb ^ (((sb >> 9) & 1) << 5); R = (st >> 1) * 16 + swz / 64; C = (st & 1) * 32 + (swz % 64) / 2; }
__host__ __device__ __forceinline__ int perm32(int rho) { const int n = rho >> 4, i = rho & 15; return 8 * (i >> 2) + 4 * n + (i & 3); }
struct Unit { int pm, pn; };
struct Gemm { const bf16_t* A; const bf16_t* A2; const bf16_t* Bt; int lda, K, ksplit, nM, nN; };
struct StaticOrder {
    int nM, nN, nwg, G, c;
    __device__ void init(int nM_, int nN_, int G_, int c_) { nM = nM_; nN = nN_; nwg = nM * nN; G = G_; c = c_; }
    __device__ bool next(int i, Unit& u) const {
        const long L = (long)i * G + c; if (L >= nwg) return false;
        int wgid = (int)L; { const int q = nwg / NXCD, r = nwg % NXCD, xcd = wgid % NXCD, off = wgid / NXCD; wgid = (xcd < r ? xcd * (q + 1) : r * (q + 1) + (xcd - r) * q) + off; }
        const int nig = WGM * nN, gid = wgid / nig, fm = gid * WGM, gsz = (nM - fm) < WGM ? (nM - fm) : WGM;
        u.pm = fm + ((wgid % nig) % gsz); u.pn = (wgid % nig) / gsz; return true;
    }
};

template <class Epi, bool ALIGN_EPI>
__device__ __forceinline__ void gemm_phase(LAS unsigned char* lds, const Gemm g, const StaticOrder& S, const Epi& E) {
    const int tid = threadIdx.x, wid = __builtin_amdgcn_readfirstlane(tid >> 6), lane = tid & 63, wr = wid >> 2, wc = wid & 3, fr = lane & 15, fq = lane >> 4;
    const int K = g.K, nt = K / BK, lda = g.lda;
    unsigned voffA[2], voffB[2];
#pragma unroll
    for (int i = 0; i < 2; ++i) { int R, C; stage_rc(tid * 16 + i * 8192, R, C); const int Rb = Epi::PERM ? ((R & ~31) + perm32(R & 31)) : R;
        voffA[i] = (unsigned)(R * lda + C) * 2u; voffB[i] = (unsigned)(Rb * K + C) * 2u; }
    const size_t kstep = (size_t)(BK * 2);
    const size_t hstepA = (size_t)HALF * lda * 2, tstepA = 2 * hstepA;
    const size_t hstepB = (size_t)HALF * K * 2, tstepB = 2 * hstepB;
    const unsigned ldsw = (unsigned)wid * 1024u;
    const int aoff = lds_byte(wr * 64 + fr, fq * 8), boff = lds_byte(wc * 32 + fr, fq * 8);
    const char* Alo = (const char*)g.A; const char* Ahi = (const char*)g.A2 - (size_t)g.ksplit * kstep;
#define PG8_APAN(pm, t) (((t) < g.ksplit ? Alo : Ahi) + (size_t)(pm) * tstepA + (size_t)(t) * kstep)
#define PG8_SA(b, h) (((b) * 2 + (h)) * HTB)
#define PG8_SB(b, h) ((4 + (b) * 2 + (h)) * HTB)
#define PG8_STAGE(bufoff, gbase, voff) do { _Pragma("unroll") for (int _i = 0; _i < 2; ++_i) \
        __builtin_amdgcn_global_load_lds((const unsigned*)((const char*)(gbase) + (voff)[_i]), (LAS unsigned*)(lds + (bufoff) + ldsw + _i * 8192), 16, 0, 0); } while (0)
#define PG8_LDA(dst, b, h) do { _Pragma("unroll") for (int m = 0; m < 4; ++m) _Pragma("unroll") for (int k = 0; k < 2; ++k) dst[m][k] = *(const LAS bf16x8*)(lds + PG8_SA(b, h) + aoff + m * 2048 + k * 1024); } while (0)
#define PG8_LDB(dst, b, h) do { _Pragma("unroll") for (int n = 0; n < 2; ++n) _Pragma("unroll") for (int k = 0; k < 2; ++k) dst[n][k] = *(const LAS bf16x8*)(lds + PG8_SB(b, h) + boff + n * 2048 + k * 1024); } while (0)
#define PG8_MMA(ai, bj, At, Bt) do { __builtin_amdgcn_s_setprio(1); _Pragma("unroll") for (int m = 0; m < 4; ++m) _Pragma("unroll") for (int n = 0; n < 2; ++n) _Pragma("unroll") for (int k = 0; k < 2; ++k) \
        acc[ai][bj][m][n] = __builtin_amdgcn_mfma_f32_16x16x32_bf16(Bt[n][k], At[m][k], acc[ai][bj][m][n], 0, 0, 0); __builtin_amdgcn_s_setprio(0); } while (0)
#define PG8_WAIT_V(n) asm volatile("s_waitcnt vmcnt(" #n ")" ::: "memory")
#define PG8_WAIT_L(n) asm volatile("s_waitcnt lgkmcnt(" #n ")" ::: "memory")
#define PG8_BAR __builtin_amdgcn_s_barrier()
#define PG8_SCHED __builtin_amdgcn_sched_barrier(0)
    Unit cur, nxt; int ui = 0;
    if (!S.next(0, cur)) return;
    f32x4 acc[2][2][4][2];
#pragma unroll
    for (int a = 0; a < 2; ++a)
#pragma unroll
        for (int b = 0; b < 2; ++b)
#pragma unroll
            for (int m = 0; m < 4; ++m)
#pragma unroll
                for (int n = 0; n < 2; ++n) acc[a][b][m][n] = (f32x4){0.f, 0.f, 0.f, 0.f};
    bf16x8 At[4][2], B0[2][2], B1[2][2];
    const char* cA = PG8_APAN(cur.pm, 0); const char* cB = (const char*)g.Bt + (size_t)cur.pn * tstepB;
    PG8_STAGE(PG8_SB(0, 0), cB, voffB); PG8_STAGE(PG8_SB(0, 1), cB + hstepB, voffB); PG8_STAGE(PG8_SA(0, 0), cA, voffA); PG8_STAGE(PG8_SA(0, 1), cA + hstepA, voffA);
    if (wr == 1) PG8_BAR;
    PG8_WAIT_V(2); PG8_BAR;
    PG8_STAGE(PG8_SB(1, 0), cB + kstep, voffB); PG8_STAGE(PG8_SA(1, 0), cA + kstep, voffA); PG8_STAGE(PG8_SB(1, 1), cB + hstepB + kstep, voffB);
    PG8_WAIT_V(6); PG8_BAR;
    for (;;) {
        const bool has_next = S.next(ui + 1, nxt);
        const char* nA = has_next ? PG8_APAN(nxt.pm, 0) : cA; const char* nB = has_next ? (const char*)g.Bt + (size_t)nxt.pn * tstepB : cB;
        for (int t = 0; t < nt; t += 2) {
            if constexpr (Epi::HAS_MID) { if (t == g.ksplit) E.mid(acc, cur, wr, wc, fr, fq); }
            const bool last = (t == nt - 2);
            const char* a1 = PG8_APAN(cur.pm, t + 1);
            const char* a2 = last ? nA : PG8_APAN(cur.pm, t + 2); const char* b2 = last ? nB : cB + (size_t)(t + 2) * kstep;
            const char* a3 = a2 + kstep; const char* b3 = b2 + kstep;
            PG8_LDB(B0, 0, 0); PG8_LDB(B1, 0, 1); PG8_SCHED; PG8_LDA(At, 0, 0); PG8_STAGE(PG8_SA(1, 1), a1 + hstepA, voffA);
            PG8_WAIT_V(8); PG8_WAIT_L(0); PG8_BAR; PG8_MMA(0, 0, At, B0); PG8_MMA(0, 1, At, B1); PG8_BAR; PG8_SCHED;
            PG8_LDA(At, 0, 1); PG8_STAGE(PG8_SB(0, 0), b2, voffB); PG8_STAGE(PG8_SB(0, 1), b2 + hstepB, voffB); PG8_STAGE(PG8_SA(0, 0), a2, voffA);
            PG8_WAIT_V(8); PG8_WAIT_L(0); PG8_BAR; PG8_MMA(1, 0, At, B0); PG8_MMA(1, 1, At, B1); PG8_BAR; PG8_SCHED;
            PG8_LDB(B0, 1, 0); PG8_LDB(B1, 1, 1); PG8_SCHED; PG8_LDA(At, 1, 0); PG8_STAGE(PG8_SA(0, 1), a2 + hstepA, voffA);
            PG8_WAIT_V(8); PG8_WAIT_L(0); PG8_BAR; PG8_MMA(0, 0, At, B0); PG8_MMA(0, 1, At, B1); PG8_BAR; PG8_SCHED;
            PG8_LDA(At, 1, 1); PG8_STAGE(PG8_SB(1, 0), b3, voffB); PG8_STAGE(PG8_SB(1, 1), b3 + hstepB, voffB); PG8_STAGE(PG8_SA(1, 0), a3, voffA);
            PG8_WAIT_V(8); PG8_WAIT_L(0); PG8_BAR; PG8_MMA(1, 0, At, B0); PG8_MMA(1, 1, At, B1); PG8_BAR; PG8_SCHED;
        }
        if constexpr (ALIGN_EPI) { if (wr == 0) PG8_BAR; }
        E(acc, cur, wr, wc, fr, fq);
        if (!has_next) break;
#pragma unroll
        for (int a = 0; a < 2; ++a)
#pragma unroll
            for (int b = 0; b < 2; ++b)
#pragma unroll
                for (int m = 0; m < 4; ++m)
#pragma unroll
                    for (int n = 0; n < 2; ++n) acc[a][b][m][n] = (f32x4){0.f, 0.f, 0.f, 0.f};
        cur = nxt; cA = nA; cB = nB; ++ui;
        if constexpr (ALIGN_EPI) { if (wr == 1) PG8_BAR; }
    }
    PG8_WAIT_V(0);
    if constexpr (!ALIGN_EPI) { if (wr == 0) PG8_BAR; }
    PG8_BAR;
#undef PG8_APAN
#undef PG8_SA
#undef PG8_SB
#undef PG8_STAGE
#undef PG8_LDA
#undef PG8_LDB
#undef PG8_MMA
#undef PG8_WAIT_V
#undef PG8_WAIT_L
#undef PG8_BAR
#undef PG8_SCHED
}
}

typedef const f32x4 (&AccRef)[2][2][4][2];
typedef f32x4 (&AccMut)[2][2][4][2];

__device__ __forceinline__ u32x4 pack8(f32x4 a, f32x4 b) { u32x4 w; w.x = cvt_pk_bf16(a[0], a[1]); w.y = cvt_pk_bf16(a[2], a[3]); w.z = cvt_pk_bf16(b[0], b[1]); w.w = cvt_pk_bf16(b[2], b[3]); return w; }

__device__ __forceinline__ unsigned opaque(unsigned x) { asm volatile("" : "+v"(x)); return x; }

struct EpiIn {
    static constexpr bool PERM = true, HAS_MID = false;
    bf16_t *U, *ZA, *Q, *ZB, *Kb, *Vb, *GA, *GB; const float *qg, *kg; float* out;
    __device__ __forceinline__ void operator()(AccRef acc, const pg8::Unit& u, int wr, int wc, int fr, int fq) const {
        const int pn = u.pn, row0 = u.pm * 256 + wr * 64 + fr, lc0 = 64 * wc + 8 * fq;
        if (pn == 12) {
            const bool isk = wc < 2; const int hd = wc & 1;
            f32x4 gq[2][2];
#pragma unroll
            for (int bj = 0; bj < 2; ++bj)
#pragma unroll
                for (int n = 0; n < 2; ++n) gq[bj][n] = isk ? *(const f32x4*)(kg + 32 * bj + 8 * fq + 4 * n) : (f32x4){1.f, 1.f, 1.f, 1.f};
            char* dst = (char*)(isk ? Kb : Vb); float* opk = out + (isk ? O_PK : O_PV); float* osk = out + (isk ? O_SK : O_SV);
            const unsigned off0 = ((unsigned)row0 * 128u + 64u * hd + 8u * fq) * 2u;
#pragma unroll
            for (int ai = 0; ai < 2; ++ai)
#pragma unroll
                for (int m = 0; m < 4; ++m) {
                    const int row = row0 + ai * 128 + m * 16;
                    const unsigned o = opaque(off0 + (unsigned)(ai * 128 + m * 16) * 256u);
                    float r = 1.f;
                    if (isk) { float ss = 0.f;
#pragma unroll
                        for (int bj = 0; bj < 2; ++bj)
#pragma unroll
                            for (int n = 0; n < 2; ++n) { const f32x4 x = acc[ai][bj][m][n]; ss += (x[0] * x[0] + x[1] * x[1]) + (x[2] * x[2] + x[3] * x[3]); }
                        ss += __shfl_xor(ss, 16); ss += __shfl_xor(ss, 32);
                        r = __builtin_amdgcn_rsqf(ss * (1.0f / 64.0f) + EPSN); }
                    float* fo = nullptr;
                    if (row < MP) { const int t = row & (SEQ - 1); if (t >= SEQ - 128) fo = opk + ((size_t)((row >> 12) * 128 + (t - (SEQ - 128))) * 2 + hd) * 64; }
                    else if (row < MP + MS) { fo = osk + ((size_t)(row - MP) * 2 + hd) * 64; }
#pragma unroll
                    for (int bj = 0; bj < 2; ++bj) {
                        const f32x4 v0 = acc[ai][bj][m][0] * r * gq[bj][0], v1 = acc[ai][bj][m][1] * r * gq[bj][1];
                        *(u32x4*)(dst + o + 64 * bj) = pack8(v0, v1);
                        if (fo) { *(f32x4*)(fo + 32 * bj + 8 * fq) = v0; *(f32x4*)(fo + 32 * bj + 8 * fq + 4) = v1; }
                    }
                }
            return;
        }
        if (pn >= 8 && pn < 12) {
            f32x4 gq[2][2];
#pragma unroll
            for (int bj = 0; bj < 2; ++bj)
#pragma unroll
                for (int n = 0; n < 2; ++n) gq[bj][n] = *(const f32x4*)(qg + 32 * bj + 8 * fq + 4 * n) * QSCALE;
            const unsigned off0 = ((unsigned)row0 * 1024u + (unsigned)((pn - 8) * 256 + lc0)) * 2u;
#pragma unroll
            for (int ai = 0; ai < 2; ++ai)
#pragma unroll
                for (int m = 0; m < 4; ++m) {
                    const unsigned o = opaque(off0 + (unsigned)(ai * 128 + m * 16) * 2048u); float ss = 0.f;
#pragma unroll
                    for (int bj = 0; bj < 2; ++bj)
#pragma unroll
                        for (int n = 0; n < 2; ++n) { const f32x4 x = acc[ai][bj][m][n]; ss += (x[0] * x[0] + x[1] * x[1]) + (x[2] * x[2] + x[3] * x[3]); }
                    ss += __shfl_xor(ss, 16); ss += __shfl_xor(ss, 32);
                    const float r = __builtin_amdgcn_rsqf(ss * (1.0f / 64.0f) + EPSN);
#pragma unroll
                    for (int bj = 0; bj < 2; ++bj)
                        *(u32x4*)((char*)Q + o + 64 * bj) = pack8(acc[ai][bj][m][0] * r * gq[bj][0], acc[ai][bj][m][1] * r * gq[bj][1]);
                }
            return;
        }
        char* dst; unsigned ld, cb; int kind;
        if (pn < 4) { dst = (char*)U; ld = 1024; cb = pn * 256; kind = 0; }
        else if (pn < 8) { dst = (char*)ZA; ld = 1024; cb = (pn - 4) * 256; kind = 1; }
        else if (pn < 17) { dst = (char*)ZB; ld = 1024; cb = (pn - 13) * 256; kind = 1; }
        else if (pn < 25) { dst = (char*)GA; ld = 2048; cb = (pn - 17) * 256; kind = 2; }
        else { dst = (char*)GB; ld = 2048; cb = (pn - 25) * 256; kind = 2; }
        const unsigned off0 = ((unsigned)row0 * ld + cb + (unsigned)lc0) * 2u;
#pragma unroll
        for (int ai = 0; ai < 2; ++ai)
#pragma unroll
            for (int m = 0; m < 4; ++m) {
                const unsigned o = opaque(off0 + (unsigned)(ai * 128 + m * 16) * ld * 2u);
#pragma unroll
                for (int bj = 0; bj < 2; ++bj) {
                    f32x4 v0 = acc[ai][bj][m][0], v1 = acc[ai][bj][m][1];
                    if (kind == 1) {
#pragma unroll
                        for (int i = 0; i < 4; ++i) { v0[i] = siluf_(v0[i]); v1[i] = siluf_(v1[i]); } }
                    else if (kind == 2) {
#pragma unroll
                        for (int i = 0; i < 4; ++i) { v0[i] = sigmoidf_(v0[i]); v1[i] = sigmoidf_(v1[i]); } }
                    *(u32x4*)(dst + o + 64 * bj) = pack8(v0, v1);
                }
            }
    }
};

struct EpiGlu {
    static constexpr bool PERM = true, HAS_MID = false;
    const bf16_t* G; bf16_t* ZA; const float* bias;
    __device__ __forceinline__ void operator()(AccRef acc, const pg8::Unit& u, int wr, int wc, int fr, int fq) const {
        const int row0 = u.pm * 256 + wr * 64 + fr, col0 = u.pn * 256 + wc * 32 + 8 * fq;
        f32x4 bv[2][2];
#pragma unroll
        for (int bj = 0; bj < 2; ++bj)
#pragma unroll
            for (int n = 0; n < 2; ++n) bv[bj][n] = *(const f32x4*)(bias + col0 + bj * 128 + 4 * n);
        const unsigned off0 = ((unsigned)row0 * 1024u + (unsigned)col0) * 2u;
#pragma unroll
        for (int ai = 0; ai < 2; ++ai)
#pragma unroll
            for (int m = 0; m < 4; ++m) {
                const unsigned o = opaque(off0 + (unsigned)(ai * 128 + m * 16) * 2048u);
#pragma unroll
                for (int bj = 0; bj < 2; ++bj) {
                    const u32x4 gw = *(const u32x4*)((const char*)G + o + bj * 256), zw = *(const u32x4*)((const char*)ZA + o + bj * 256);
                    const f32x4 a0 = acc[ai][bj][m][0] + bv[bj][0], a1 = acc[ai][bj][m][1] + bv[bj][1];
                    f32x4 o0, o1;
                    o0[0] = bflo(gw.x) * sigmoidf_(a0[0]) * bflo(zw.x); o0[1] = bfhi(gw.x) * sigmoidf_(a0[1]) * bfhi(zw.x);
                    o0[2] = bflo(gw.y) * sigmoidf_(a0[2]) * bflo(zw.y); o0[3] = bfhi(gw.y) * sigmoidf_(a0[3]) * bfhi(zw.y);
                    o1[0] = bflo(gw.z) * sigmoidf_(a1[0]) * bflo(zw.z); o1[1] = bfhi(gw.z) * sigmoidf_(a1[1]) * bfhi(zw.z);
                    o1[2] = bflo(gw.w) * sigmoidf_(a1[2]) * bflo(zw.w); o1[3] = bfhi(gw.w) * sigmoidf_(a1[3]) * bfhi(zw.w);
                    *(u32x4*)((char*)ZA + o + bj * 256) = pack8(o0, o1);
                }
            }
    }
};

struct EpiOut {
    static constexpr bool PERM = true, HAS_MID = true;
    const bf16_t *GA, *GB; bf16_t* MX;
    __device__ __forceinline__ void mid(AccMut acc, const pg8::Unit& u, int wr, int wc, int fr, int fq) const {
        const int row0 = u.pm * 256 + wr * 64 + fr, col0 = u.pn * 256 + wc * 32 + 8 * fq;
        const unsigned off0 = ((unsigned)row0 * 2048u + (unsigned)col0) * 2u;
#pragma unroll
        for (int ai = 0; ai < 2; ++ai)
#pragma unroll
            for (int m = 0; m < 4; ++m) {
                const unsigned o = opaque(off0 + (unsigned)(ai * 128 + m * 16) * 4096u);
#pragma unroll
                for (int bj = 0; bj < 2; ++bj) {
                    const u32x4 a = *(const u32x4*)((const char*)GA + o + bj * 256), b = *(const u32x4*)((const char*)GB + o + bj * 256);
                    f32x4 r0, r1;
                    r0[0] = bflo(a.x) * __builtin_amdgcn_rcpf(bflo(b.x)); r0[1] = bfhi(a.x) * __builtin_amdgcn_rcpf(bfhi(b.x));
                    r0[2] = bflo(a.y) * __builtin_amdgcn_rcpf(bflo(b.y)); r0[3] = bfhi(a.y) * __builtin_amdgcn_rcpf(bfhi(b.y));
                    r1[0] = bflo(a.z) * __builtin_amdgcn_rcpf(bflo(b.z)); r1[1] = bfhi(a.z) * __builtin_amdgcn_rcpf(bfhi(b.z));
                    r1[2] = bflo(a.w) * __builtin_amdgcn_rcpf(bflo(b.w)); r1[3] = bfhi(a.w) * __builtin_amdgcn_rcpf(bfhi(b.w));
                    acc[ai][bj][m][0] *= r0; acc[ai][bj][m][1] *= r1;
                }
                asm volatile("" ::: "memory");
            }
    }
    __device__ __forceinline__ void operator()(AccRef acc, const pg8::Unit& u, int wr, int wc, int fr, int fq) const {
        const int row0 = u.pm * 256 + wr * 64 + fr, col0 = u.pn * 256 + wc * 32 + 8 * fq;
        const unsigned off0 = ((unsigned)row0 * 2048u + (unsigned)col0) * 2u;
#pragma unroll
        for (int ai = 0; ai < 2; ++ai)
#pragma unroll
            for (int m = 0; m < 4; ++m) {
                const unsigned o = opaque(off0 + (unsigned)(ai * 128 + m * 16) * 4096u);
#pragma unroll
                for (int bj = 0; bj < 2; ++bj) {
                    const u32x4 b = *(const u32x4*)((const char*)GB + o + bj * 256);
                    f32x4 g0, g1; g0[0] = bflo(b.x); g0[1] = bfhi(b.x); g0[2] = bflo(b.y); g0[3] = bfhi(b.y); g1[0] = bflo(b.z); g1[1] = bfhi(b.z); g1[2] = bflo(b.w); g1[3] = bfhi(b.w);
                    *(u32x4*)((char*)MX + o + bj * 256) = pack8(acc[ai][bj][m][0] * g0, acc[ai][bj][m][1] * g1);
                }
            }
    }
};

struct EpiRes {
    static constexpr bool PERM = false, HAS_MID = false;
    const float *xp, *xs; float* out;
    __device__ __forceinline__ void operator()(AccRef acc, const pg8::Unit& u, int wr, int wc, int fr, int fq) const {
        const int row0 = u.pm * 256 + wr * 64 + fr, col0 = u.pn * 256 + wc * 32 + 4 * fq;
        const bool smp = u.pm >= MP / 256;
        const char* xb = (const char*)(smp ? xs : xp); char* ob = (char*)(smp ? out + O_YS : out + O_YP);
        const unsigned off0 = ((unsigned)(smp ? row0 - MP : row0) * (unsigned)DM + (unsigned)col0) * 4u;
#pragma unroll
        for (int ai = 0; ai < 2; ++ai)
#pragma unroll
            for (int m = 0; m < 4; ++m) {
                const int row = row0 + ai * 128 + m * 16;
                if (row < MP + MS) {
                    const unsigned o = opaque(off0 + (unsigned)(ai * 128 + m * 16) * (unsigned)(DM * 4));
#pragma unroll
                    for (int bj = 0; bj < 2; ++bj)
#pragma unroll
                        for (int n = 0; n < 2; ++n) { const unsigned c = o + (unsigned)(bj * 128 + n * 16) * 4u; *(f32x4*)(ob + c) = *(const f32x4*)(xb + c) + acc[ai][bj][m][n]; }
                }
            }
    }
};

#define XB_TMO      128
#define XB_XCNT(j)  (256  + 64 * (j))
#define XB_XSUB(j)  (1280 + 64 * (j))
#define XB_XGEN(j)  (2304 + 64 * (j))
#define XB_TOP      3328
#define XB_TOPGEN   3392
#define XCD_BAR_WORDS 3456
#define XB_SPIN_CAP (1u << 18)
__device__ __forceinline__ unsigned xb_ld(unsigned* p)              { return __hip_atomic_load(p, __ATOMIC_RELAXED, __HIP_MEMORY_SCOPE_AGENT); }
__device__ __forceinline__ unsigned xb_add(unsigned* p, unsigned v) { return __hip_atomic_fetch_add(p, v, __ATOMIC_RELAXED, __HIP_MEMORY_SCOPE_AGENT); }
__device__ __forceinline__ unsigned xb_xcc_id() { return (unsigned)__builtin_amdgcn_s_getreg((3 << 11) | 20) & 0xFu; }
#define XB_SPIN(cond, bar) do { unsigned _sp = 0; while (cond) { __builtin_amdgcn_s_sleep(1); \
    if ((++_sp & 255u) == 0u) { if (xb_ld(&(bar)[XB_TMO])) break; if (_sp > XB_SPIN_CAP) { atomicAdd(&(bar)[XB_TMO], 1u); break; } } } } while (0)
struct XcdBarrier { unsigned* bar; unsigned x; volatile LAS unsigned* st; };
__device__ __forceinline__ XcdBarrier xcd_barrier_post(unsigned* bar, volatile LAS unsigned* st) {
    XcdBarrier b; b.bar = bar; b.x = xb_xcc_id(); b.st = st;
    if (threadIdx.x == 0) (void)xb_add(&bar[XB_XCNT(b.x)], 1u);
    return b;
}
__device__ __forceinline__ void xcd_barrier_complete(unsigned* bar, unsigned x, unsigned& nloc, unsigned& nx) {
    const unsigned G = gridDim.x * gridDim.y * gridDim.z;
    unsigned sum, cnt, mine, sp = 0u;
    for (;;) {
        sum = 0u; cnt = 0u; mine = 0u;
#pragma unroll
        for (unsigned j = 0; j < 16; ++j) { const unsigned c = xb_ld(&bar[XB_XCNT(j)]); sum += c; cnt += (c > 0u) ? 1u : 0u; mine = (j == x) ? c : mine; }
        if (sum == G) break;
        __builtin_amdgcn_s_sleep(1);
        if ((++sp & 255u) == 0u) { if (xb_ld(&bar[XB_TMO])) break; if (sp > XB_SPIN_CAP) { atomicAdd(&bar[XB_TMO], 1u); break; } }
    }
    nloc = mine > 0u ? mine : 1u; nx = cnt > 0u ? cnt : 1u;
}
__device__ __forceinline__ void xcd_barrier(const XcdBarrier& b) {
    asm volatile("s_waitcnt vmcnt(0)" ::: "memory");
    __syncthreads();
    if (threadIdx.x == 0) {
        unsigned* bar = b.bar;
        __builtin_amdgcn_s_waitcnt(0);
        unsigned nloc = b.st[0], nx = b.st[1];
        if (nloc == 0u) { xcd_barrier_complete(bar, b.x, nloc, nx); b.st[0] = nloc; b.st[1] = nx; }
        const unsigned old = xb_add(&bar[XB_XSUB(b.x)], 1u);
        const unsigned gen = old / nloc;
        if (old + 1u == (gen + 1u) * nloc) {
            __builtin_amdgcn_fence(__ATOMIC_RELEASE, "agent");
            asm volatile("s_waitcnt vmcnt(0)" ::: "memory");
            const unsigned og = xb_add(&bar[XB_TOP], 1u);
            const unsigned tg = og / nx;
            if (og + 1u == (tg + 1u) * nx) xb_add(&bar[XB_TOPGEN], 1u);
            else XB_SPIN(xb_ld(&bar[XB_TOPGEN]) == tg, bar);
            __builtin_amdgcn_fence(__ATOMIC_ACQUIRE, "agent");
            xb_add(&bar[XB_XGEN(b.x)], 1u);
            asm volatile("s_waitcnt vmcnt(0)" ::: "memory");
        } else {
            XB_SPIN(xb_ld(&bar[XB_XGEN(b.x)]) == gen, bar);
            __builtin_amdgcn_fence(__ATOMIC_ACQUIRE, "agent");
            asm volatile("s_waitcnt vmcnt(0)" ::: "memory");
        }
    }
    __syncthreads();
}

struct Args {
    const float* in[25]; float* out; unsigned char* ws; int ph_lo, ph_hi;
};
struct Frame {
    LAS unsigned char* lds; int tid, lane, wave, G, gw, NGW;
    float* out; unsigned char* ws;
};
__device__ __forceinline__ float wave_sum(float v) {
#pragma unroll
    for (int o = 1; o < 64; o <<= 1) v += __shfl_xor(v, o);
    return v;
}

template <bool SIGMA>
__device__ __forceinline__ void p0_transpose_item(const float* W, int N, bf16_t* WT, int ldk, int koff, LAS float* scr, int item, int lane) {
    const int nblk = N / 32, kb = item / nblk, nb = item % nblk, k0 = 64 * kb, n0 = 32 * nb;
#pragma unroll 8
    for (int i = 0; i < 32; ++i) { const int kk = 2 * i + (lane >> 5); scr[kk * 33 + (lane & 31)] = W[(size_t)(k0 + kk) * N + n0 + (lane & 31)]; }
    asm volatile("s_waitcnt lgkmcnt(0)" ::: "memory");
    const int c = lane & 7;
#pragma unroll
    for (int j = 0; j < 4; ++j) { const int n = (lane >> 3) + 8 * j; const LAS float* s = scr + (8 * c) * 33 + n;
        u32x4 o; o.x = cvt_pk_bf16(s[0 * 33], s[1 * 33]); o.y = cvt_pk_bf16(s[2 * 33], s[3 * 33]); o.z = cvt_pk_bf16(s[4 * 33], s[5 * 33]); o.w = cvt_pk_bf16(s[6 * 33], s[7 * 33]);
        int nl = n0 + n;
        if (SIGMA) { const int lc = nl & 255, wcc = lc >> 6, bjj = (lc >> 5) & 1, jj = lc & 31; nl = (nl & ~255) + 128 * bjj + 32 * wcc + jj; }
        *(u32x4*)(WT + (size_t)nl * ldk + koff + k0 + 8 * c) = o; }
    asm volatile("s_waitcnt lgkmcnt(0)" ::: "memory");
}
__device__ __forceinline__ void p0_norm_row(const float* xrow, const f32x4 (&gv)[8], bf16_t* orow, int lane) {
    const f32x4* xr = (const f32x4*)xrow + lane;
    f32x4 v[8]; float s = 0.f;
#pragma unroll
    for (int j = 0; j < 8; ++j) { v[j] = xr[64 * j]; s += (v[j][0] * v[j][0] + v[j][1] * v[j][1]) + (v[j][2] * v[j][2] + v[j][3] * v[j][3]); }
    const float rstd = 1.0f / sqrtf(wave_sum(s) * (1.0f / DM) + EPSN);
    u32x2* o8 = (u32x2*)orow + lane;
#pragma unroll
    for (int j = 0; j < 8; ++j) { const f32x4 y = v[j] * rstd * gv[j]; u32x2 w; w.x = cvt_pk_bf16(y[0], y[1]); w.y = cvt_pk_bf16(y[2], y[3]); o8[64 * j] = w; }
}
__device__ __forceinline__ void p0_prologue(Frame& F, const Args& AR) {
    LAS float* scr = (LAS float*)(F.lds + F.wave * 16384);
    const float* w_in = AR.in[7]; const float* w_glu = AR.in[16]; const float* w_oa = AR.in[22]; const float* w_ob = AR.in[23]; const float* w_o = AR.in[24];
    bf16_t* WIN = (bf16_t*)(F.ws + WS_WIN); bf16_t* WGLU = (bf16_t*)(F.ws + WS_WGLU); bf16_t* WOUT = (bf16_t*)(F.ws + WS_WOUT); bf16_t* WO = (bf16_t*)(F.ws + WS_WO);
    constexpr int I_IN = (DM / 64) * (NIN / 32), I_GLU = (1024 / 64) * (1024 / 32), I_OA = (1024 / 64) * (DM / 32), I_O = (DM / 64) * (DM / 32);
    constexpr int NITEMS = I_IN + I_GLU + 2 * I_OA + I_O;
    for (int it = F.gw; it < NITEMS; it += F.NGW) {
        int r = it;
        if (r < I_IN) { p0_transpose_item<true>(w_in, NIN, WIN, DM, 0, scr, r, F.lane); continue; } r -= I_IN;
        if (r < I_GLU) { p0_transpose_item<false>(w_glu, 1024, WGLU, 1024, 0, scr, r, F.lane); continue; } r -= I_GLU;
        if (r < I_OA) { p0_transpose_item<false>(w_oa, DM, WOUT, 2048, 0, scr, r, F.lane); continue; } r -= I_OA;
        if (r < I_OA) { p0_transpose_item<false>(w_ob, DM, WOUT, 2048, 1024, scr, r, F.lane); continue; } r -= I_OA;
        p0_transpose_item<false>(w_o, DM, WO, DM, 0, scr, r, F.lane);
    }
    { f32x4 gv[8];
#pragma unroll
      for (int j = 0; j < 8; ++j) gv[j] = ((const f32x4*)AR.in[6])[F.lane + 64 * j];
      bf16_t* XN = (bf16_t*)(F.ws + WS_XN);
      for (int m = F.gw; m < MROWS; m += F.NGW) {
          if (m < MP) p0_norm_row(AR.in[0] + (size_t)m * DM, gv, XN + (size_t)m * DM, F.lane);
          else if (m < MP + MS) p0_norm_row(AR.in[1] + (size_t)(m - MP) * DM, gv, XN + (size_t)m * DM, F.lane);
          else { u32x2* o8 = (u32x2*)(XN + (size_t)m * DM) + F.lane;
#pragma unroll
              for (int j = 0; j < 8; ++j) o8[64 * j] = (u32x2){0u, 0u}; }
      } }
    const int gt = blockIdx.x * 512 + F.tid;
    if (gt < NGRP * NSTATE) {
        const int g = gt >> 6, p = gt & 63;
        const double are = (double)AR.in[8][gt], aim = (double)AR.in[9][gt], dt = exp((double)AR.in[10][g]);
        const double mag = exp(are * dt), ang = aim * dt, lre = mag * cos(ang), lim = mag * sin(ang);
        const double den = are * are + aim * aim, cr = ((lre - 1.0) * are + lim * aim) / den, ci = (lim * are - (lre - 1.0) * aim) / den;
        float* LAM = (float*)(F.ws + WS_CONST + C_LAM); float* LAM64 = (float*)(F.ws + WS_CONST + C_LAM64);
        LAM[2 * gt] = (float)lre; LAM[2 * gt + 1] = (float)lim;
        double pr = lre, pi = lim;
#pragma unroll 1
        for (int i = 0; i < 6; ++i) { const double nr = pr * pr - pi * pi, ni = 2.0 * pr * pi; pr = nr; pi = ni; }
        LAM64[2 * gt] = (float)pr; LAM64[2 * gt + 1] = (float)pi;
        bf16_t* BF = (bf16_t*)(F.ws + WS_CONST + C_BF); bf16_t* CF = (bf16_t*)(F.ws + WS_CONST + C_CF);
        const float* bre = AR.in[11] + (size_t)gt * 16; const float* bim = AR.in[12] + (size_t)gt * 16;
#pragma unroll 1
        for (int c = 0; c < 16; ++c) {
            const double br = (double)bre[c], bi = (double)bim[c];
            const float bbr = (float)(cr * br - ci * bi), bbi = (float)(cr * bi + ci * br);
            const int q = c >> 2, jj = c & 3;
            { const int row = p, pt = row >> 4, ps = row & 15; BF[((size_t)(g * 8 + pt) * 64 + 16 * q + ps) * 4 + jj] = (bf16_t)(cvt_pk_bf16(bbr, 0.f) & 0xffffu); }
            { const int row = 64 + p, pt = row >> 4, ps = row & 15; BF[((size_t)(g * 8 + pt) * 64 + 16 * q + ps) * 4 + jj] = (bf16_t)(cvt_pk_bf16(bbi, 0.f) & 0xffffu); }
            const float cre = AR.in[13][(size_t)(g * 16 + c) * 64 + p], cim = AR.in[14][(size_t)(g * 16 + c) * 64 + p];
            const int ks = p >> 4, qq = (p >> 2) & 3, jb = 2 * (p & 3);
            CF[((size_t)(g * 4 + ks) * 64 + 16 * qq + c) * 8 + jb] = (bf16_t)(cvt_pk_bf16(cre, 0.f) & 0xffffu);
            CF[((size_t)(g * 4 + ks) * 64 + 16 * qq + c) * 8 + jb + 1] = (bf16_t)(cvt_pk_bf16(-cim, 0.f) & 0xffffu);
        }
    }
    if (gt < 16 * 256) {
        const int h = gt >> 8, idx = gt & 255; float v = 0.f;
        if (idx < 255) { const int rel = idx - 191; int n = -rel; const int ret = n < 0 ? 16 : 0; n = n < 0 ? -n : n;
            const int large = 8 + (n >= 12) + (n >= 16) + (n >= 23) + (n >= 32) + (n >= 46) + (n >= 64) + (n >= 91);
            const int bucket = ret + (n < 8 ? n : large); v = AR.in[21][bucket * 16 + h] * LOG2E; }
        ((float*)(F.ws + WS_CONST + C_BT))[gt] = v;
    }
}

constexpr int SSM_UROW = 272, SSM_UT = 64 * SSM_UROW, SSM_BU = 128 * 80, SSM_HC = 16 * 272;
template <bool FULL>
__device__ __forceinline__ void ssm_unit(Frame& F, const float* ssm_d, bf16_t* U, int rowbase, int T, int gs, const float* hin_re, const float* hin_im, float* hout_re, float* hout_im) {
    LAS unsigned char* ut = F.lds;
    LAS unsigned char* bu = F.lds + SSM_UT + F.wave * SSM_BU;
    LAS unsigned char* hc = F.lds + SSM_UT + 8 * SSM_BU + F.wave * SSM_HC;
    const int lane = F.lane, w = F.wave, fr = lane & 15, fq = lane >> 4, g = gs * 8 + w;
#pragma unroll
    for (int i = 0; i < 2; ++i) { const int idx = F.tid + 512 * i, row = idx >> 4, ch = idx & 15;
        u32x4 v = (u32x4){0u, 0u, 0u, 0u};
        if (row < T) v = *(const u32x4*)(U + (size_t)(rowbase + row) * 1024 + gs * 128 + ch * 8);
        *(LAS u32x4*)(ut + row * SSM_UROW + ch * 16) = v; }
    const f32x2 lam = ((const f32x2*)(F.ws + WS_CONST + C_LAM))[g * 64 + lane];
    u32x2 bfr[8];
#pragma unroll
    for (int pt = 0; pt < 8; ++pt) bfr[pt] = ((const u32x2*)(F.ws + WS_CONST + C_BF))[(size_t)(g * 8 + pt) * 64 + lane];
    u32x4 cfr[4]; float dsk = 0.f;
    if (FULL) {
#pragma unroll
        for (int ks = 0; ks < 4; ++ks) cfr[ks] = ((const u32x4*)(F.ws + WS_CONST + C_CF))[(size_t)(g * 4 + ks) * 64 + lane];
        dsk = ssm_d[g * 16 + fr];
    }
    float hre = 0.f, him = 0.f;
    if (FULL && hin_re) { hre = hin_re[lane]; him = hin_im[lane]; }
    __syncthreads();
    const int nsb = T >> 4;
    for (int sb = 0; sb < nsb; ++sb) {
        const s16x4 af = __builtin_bit_cast(s16x4, *(const LAS u32x2*)(ut + (16 * sb + fr) * SSM_UROW + w * 32 + fq * 8));
#pragma unroll
        for (int pt = 0; pt < 8; ++pt) {
            const f32x4 d = __builtin_amdgcn_mfma_f32_16x16x16bf16_1k(af, __builtin_bit_cast(s16x4, bfr[pt]), (f32x4){0.f, 0.f, 0.f, 0.f}, 0, 0, 0);
            *(LAS f32x4*)(bu + (16 * pt + fr) * 80 + fq * 16) = d;
        }
        asm volatile("s_waitcnt lgkmcnt(0)" ::: "memory");
        f32x4 br[4], bi[4];
#pragma unroll
        for (int k = 0; k < 4; ++k) { br[k] = *(const LAS f32x4*)(bu + lane * 80 + k * 16); bi[k] = *(const LAS f32x4*)(bu + (64 + lane) * 80 + k * 16); }
#pragma unroll
        for (int t = 0; t < 16; ++t) {
            const float nre = lam.x * hre - lam.y * him + br[t >> 2][t & 3];
            const float nim = lam.x * him + lam.y * hre + bi[t >> 2][t & 3];
            hre = nre; him = nim;
            if (FULL) *(LAS unsigned*)(hc + t * 272 + lane * 4) = cvt_pk_bf16(hre, him);
        }
        if (FULL) {
            asm volatile("s_waitcnt lgkmcnt(0)" ::: "memory");
            f32x4 y = (f32x4){0.f, 0.f, 0.f, 0.f};
#pragma unroll
            for (int ks = 0; ks < 4; ++ks) {
                const bf16x8 a = *(const LAS bf16x8*)(hc + fr * 272 + ks * 64 + fq * 16);
                y = __builtin_amdgcn_mfma_f32_16x16x32_bf16(a, __builtin_bit_cast(bf16x8, cfr[ks]), y, 0, 0, 0);
            }
#pragma unroll
            for (int r = 0; r < 4; ++r) {
                LAS unsigned short* up = (LAS unsigned short*)(ut + (16 * sb + 4 * fq + r) * SSM_UROW + w * 32 + fr * 2);
                const float uv = bf2f(*up);
                *up = (unsigned short)(cvt_pk_bf16(geluf_(y[r] + dsk * uv), 0.f) & 0xffffu);
            }
            asm volatile("s_waitcnt lgkmcnt(0)" ::: "memory");
        }
    }
    if (hout_re) { hout_re[lane] = hre; hout_im[lane] = him; }
    if (FULL) {
        __syncthreads();
#pragma unroll
        for (int i = 0; i < 2; ++i) { const int idx = F.tid + 512 * i, row = idx >> 4, ch = idx & 15;
            if (row < T) *(u32x4*)(U + (size_t)(rowbase + row) * 1024 + gs * 128 + ch * 8) = *(const LAS u32x4*)(ut + row * SSM_UROW + ch * 16); }
    }
    __syncthreads();
}

constexpr int AT_K = 0, AT_V = 24576, AT_BT = 49152, AT_WS = 57344, AT_OST = 59392;
__device__ __forceinline__ int crow(int r, int hi) { return (r & 3) + 8 * (r >> 2) + 4 * hi; }
struct AttnUnit {
    int kvrow[3];
    const float* ck; const float* cv;
    int nkeys[3];
    int qrow0, nq, kvh;
};
__device__ __forceinline__ void attn_unit(Frame& F, const float* sinks, const AttnUnit& A, bf16_t* Q, const bf16_t* Kb, const bf16_t* Vb, const bf16_t* ZB) {
    const int lane = F.lane, w = F.wave, r32 = lane & 31, hi = lane >> 5, h = A.kvh * 8 + w;
    LAS unsigned char* lds = F.lds;
#pragma unroll
    for (int s = 0; s < 3; ++s) {
        if (A.nkeys[s] == 0) continue;
        u32x4 kw = (u32x4){0u, 0u, 0u, 0u}, vw = (u32x4){0u, 0u, 0u, 0u};
        const int vrow = 16 * (w & 3) + (lane >> 2);
        if (A.kvrow[s] >= 0) {
            const size_t krow = (size_t)A.kvrow[s];
            if (lane < A.nkeys[s]) kw = *(const u32x4*)(Kb + (krow + lane) * 128 + A.kvh * 64 + w * 8);
            if (vrow < A.nkeys[s]) vw = *(const u32x4*)(Vb + (krow + vrow) * 128 + A.kvh * 64 + (w >> 2) * 32 + (lane & 3) * 8);
        } else {
            const float* kp = A.ck + ((size_t)(64 * s + lane) * 2 + A.kvh) * 64 + w * 8;
            const f32x4 k0 = *(const f32x4*)kp, k1 = *(const f32x4*)(kp + 4); kw = pack8(k0, k1);
            const float* vp = A.cv + ((size_t)(64 * s + vrow) * 2 + A.kvh) * 64 + (w >> 2) * 32 + (lane & 3) * 8;
            const f32x4 v0 = *(const f32x4*)vp, v1 = *(const f32x4*)(vp + 4); vw = pack8(v0, v1);
        }
        *(LAS u32x4*)(lds + AT_K + s * 8192 + w * 1024 + lane * 16) = kw;
        *(LAS u32x4*)(lds + AT_V + s * 8192 + w * 1024 + lane * 16) = vw;
    }
#pragma unroll
    for (int i = 0; i < 4; ++i) { const int idx = F.tid + 512 * i; ((LAS float*)(lds + AT_BT))[idx] = ((const float*)(F.ws + WS_CONST + C_BT))[A.kvh * 2048 + idx]; }
    __syncthreads();
    const float sink = sinks[h] * LOG2E;
    const LAS float* bt = (const LAS float*)(lds + AT_BT) + w * 256;
    LAS float* wsf = (LAS float*)(lds + AT_WS) + w * 64;
    const int nqt = (A.nq + 31) >> 5;
    for (int qt = 0; qt < nqt; ++qt) {
        const bf16_t* Qw = Q + (size_t)(A.qrow0 + 32 * qt + r32) * 1024 + h * 64;
        bf16x8 qr[4];
#pragma unroll
        for (int d0 = 0; d0 < 4; ++d0) qr[d0] = *(const bf16x8*)(Qw + d0 * 16 + hi * 8);
        f32x16 p[6];
        const int qoff = 32 * qt + r32;
#pragma unroll
        for (int kt = 0; kt < 6; ++kt) {
            const int s = kt >> 1, nk = A.nkeys[s] - 32 * (kt & 1);
            if (nk <= 0) {
#pragma unroll
                for (int r = 0; r < 16; ++r) p[kt][r] = -INFINITY;
                continue;
            }
            f32x16 c;
#pragma unroll
            for (int r = 0; r < 16; ++r) c[r] = bt[32 * kt + crow(r, hi) - qoff + 63];
            const LAS unsigned char* kb = lds + AT_K + s * 8192 + hi * 1024 + r32 * 16 + (kt & 1) * 512;
#pragma unroll
            for (int d0 = 0; d0 < 4; ++d0) c = __builtin_amdgcn_mfma_f32_32x32x16_bf16(*(const LAS bf16x8*)(kb + d0 * 2048), qr[d0], c, 0, 0, 0);
            if (nk < 32) {
#pragma unroll
                for (int r = 0; r < 16; ++r) if (crow(r, hi) >= nk) c[r] = -INFINITY;
            }
            p[kt] = c;
        }
        float mx = sink;
#pragma unroll
        for (int kt = 0; kt < 6; ++kt)
#pragma unroll
            for (int r = 0; r < 16; ++r) mx = fmaxf(mx, p[kt][r]);
        mx = fmaxf(mx, __shfl_xor(mx, 32));
        float l = 0.f;
#pragma unroll
        for (int kt = 0; kt < 6; ++kt)
#pragma unroll
            for (int r = 0; r < 16; ++r) { const float e = __builtin_amdgcn_exp2f(p[kt][r] - mx); p[kt][r] = e; l += e; }
        l += __shfl_xor(l, 32);
        l += __builtin_amdgcn_exp2f(sink - mx);
        if (hi == 0) wsf[r32] = l;
        f32x16 o[2]; o[0] = (f32x16){}; o[1] = (f32x16){};
        const int vb0 = ((lane >> 4) & 1) * 32 + (lane & 3) * 8 + (4 * hi + ((lane & 15) >> 2)) * 64;
#pragma unroll
        for (int kt = 0; kt < 6; ++kt) {
            const int s = kt >> 1;
            if (A.nkeys[s] - 32 * (kt & 1) <= 0) continue;
#pragma unroll
            for (int ss = 0; ss < 2; ++ss) {
                u32x4 pw; pw.x = cvt_pk_bf16(p[kt][8 * ss + 0], p[kt][8 * ss + 1]); pw.y = cvt_pk_bf16(p[kt][8 * ss + 2], p[kt][8 * ss + 3]);
                pw.z = cvt_pk_bf16(p[kt][8 * ss + 4], p[kt][8 * ss + 5]); pw.w = cvt_pk_bf16(p[kt][8 * ss + 6], p[kt][8 * ss + 7]);
                const int ks = 2 * (kt & 1) + ss;
#pragma unroll
                for (int d0 = 0; d0 < 2; ++d0) {
                    const LAS unsigned char* vp = lds + AT_V + s * 8192 + d0 * 4096 + ks * 1024 + vb0;
                    const s16x4 lo = __builtin_bit_cast(s16x4, __builtin_amdgcn_ds_read_tr16_b64_v4i16((LAS s16x4*)vp));
                    const s16x4 hi4 = __builtin_bit_cast(s16x4, __builtin_amdgcn_ds_read_tr16_b64_v4i16((LAS s16x4*)(vp + 512)));
                    const bf16x8 vf = (bf16x8){lo[0], lo[1], lo[2], lo[3], hi4[0], hi4[1], hi4[2], hi4[3]};
                    o[d0] = __builtin_amdgcn_mfma_f32_32x32x16_bf16(__builtin_bit_cast(bf16x8, pw), vf, o[d0], 0, 0, 0);
                }
            }
        }
        asm volatile("s_waitcnt lgkmcnt(0)" ::: "memory");
        LAS bf16_t* stg = (LAS bf16_t*)(lds + AT_OST) + w * 2048;
#pragma unroll
        for (int r = 0; r < 16; ++r) { const int orow = crow(r, hi); const float rl = __builtin_amdgcn_rcpf(wsf[orow]);
#pragma unroll
            for (int d0 = 0; d0 < 2; ++d0) stg[orow * 64 + d0 * 32 + r32] = (bf16_t)(cvt_pk_bf16(o[d0][r] * rl, 0.f) & 0xffffu); }
        asm volatile("s_waitcnt lgkmcnt(0)" ::: "memory");
#pragma unroll
        for (int i = 0; i < 4; ++i) { const int row = i * 8 + (lane >> 3), ch = lane & 7;
            if (32 * qt + row < A.nq) {
                const size_t off = (size_t)(A.qrow0 + 32 * qt + row) * 1024 + h * 64 + ch * 8;
                const u32x4 ov = *(const LAS u32x4*)(stg + row * 64 + ch * 8), zv = *(const u32x4*)(ZB + off);
                u32x4 res; res.x = cvt_pk_bf16(bflo(ov.x) * bflo(zv.x), bfhi(ov.x) * bfhi(zv.x)); res.y = cvt_pk_bf16(bflo(ov.y) * bflo(zv.y), bfhi(ov.y) * bfhi(zv.y));
                res.z = cvt_pk_bf16(bflo(ov.z) * bflo(zv.z), bfhi(ov.z) * bfhi(zv.z)); res.w = cvt_pk_bf16(bflo(ov.w) * bflo(zv.w), bfhi(ov.w) * bfhi(zv.w));
                *(u32x4*)(Q + off) = res; } }
        asm volatile("s_waitcnt lgkmcnt(0)" ::: "memory");
    }
    __syncthreads();
}

__global__ void __launch_bounds__(512, 2) mk_fwd(Args args) {
    extern __shared__ __attribute__((aligned(16))) unsigned char lds_raw[];
    Frame F;
    F.lds = (LAS unsigned char*)lds_raw;
    F.tid = threadIdx.x; F.lane = F.tid & 63; F.wave = __builtin_amdgcn_readfirstlane(F.tid >> 6);
    F.G = gridDim.x; F.gw = blockIdx.x * 8 + F.wave; F.NGW = F.G * 8;
    F.out = args.out; F.ws = args.ws;
    cg::grid_group grid = cg::this_grid();
    const int lo = args.ph_lo, hi = args.ph_hi;
    volatile LAS unsigned* misc = (volatile LAS unsigned*)(F.lds + MISC_OFF);
    if (F.tid < 16) misc[F.tid] = 0u;
    __syncthreads();
    XcdBarrier xbar; xbar.bar = (unsigned*)(F.ws + WS_CTL); xbar.x = 0; xbar.st = nullptr;
    if (hi - lo > 1) xbar = xcd_barrier_post((unsigned*)(F.ws + WS_CTL), misc);
#ifndef PH_MASK
#define PH_MASK 0xff
#endif
#define IN(k) (((PH_MASK >> (k)) & 1) && lo <= (k) && (k) < hi)
#define SEAM(k) do { if (IN(k) && IN((k) + 1)) { if ((k) == 0) grid.sync(); else xcd_barrier(xbar); } } while (0)
    bf16_t* XN = (bf16_t*)(F.ws + WS_XN); bf16_t* U = (bf16_t*)(F.ws + WS_U); bf16_t* ZA = (bf16_t*)(F.ws + WS_ZA); bf16_t* Qb = (bf16_t*)(F.ws + WS_Q); bf16_t* ZB = (bf16_t*)(F.ws + WS_ZB);
    bf16_t* Kb = (bf16_t*)(F.ws + WS_K); bf16_t* Vb = (bf16_t*)(F.ws + WS_V); bf16_t* GA = (bf16_t*)(F.ws + WS_GA); bf16_t* GB = (bf16_t*)(F.ws + WS_GB);
    float* Sst = (float*)(F.ws + WS_S); float* Hin = (float*)(F.ws + WS_HIN);

    if (IN(0)) p0_prologue(F, args);
    SEAM(0);
    if (IN(1)) {
        pg8::Gemm g{XN, XN, (const bf16_t*)(F.ws + WS_WIN), DM, DM, 1 << 20, MROWS / 256, NIN / 256};
        pg8::StaticOrder S; S.init(g.nM, g.nN, F.G, (int)blockIdx.x);
        EpiIn E{U, ZA, Qb, ZB, Kb, Vb, GA, GB, args.in[18], args.in[19], F.out};
        pg8::gemm_phase<EpiIn, true>(F.lds, g, S, E);
    }
    SEAM(1);
    if (IN(2)) {
        for (int it = blockIdx.x; it < NBATCH * NCHUNK * 8; it += F.G) {
            const int gs = it & 7, bj = it >> 3;
            float* so = Sst + ((size_t)bj * NGRP + gs * 8 + F.wave) * 128;
            ssm_unit<false>(F, args.in[15], U, bj * 64, 64, gs, nullptr, nullptr, so, so + 64);
        }
        for (int it = blockIdx.x; it < NBATCH * NCHUNK * 2 + NBATCH * 2; it += F.G) {
            AttnUnit A;
            if (it < NBATCH * NCHUNK * 2) {
                const int kvh = it & 1, bc = it >> 1, c = bc & 63;
#pragma unroll
                for (int s = 0; s < 3; ++s) { const int cc = c - 2 + s; A.nkeys[s] = cc >= 0 ? 64 : 0; A.kvrow[s] = cc >= 0 ? (bc - 2 + s) * 64 : 0; }
                A.ck = nullptr; A.cv = nullptr; A.qrow0 = bc * 64; A.nq = 64; A.kvh = kvh;
            } else {
                const int r = it - NBATCH * NCHUNK * 2, kvh = r & 1, b = r >> 1;
                A.nkeys[0] = 64; A.nkeys[1] = 64; A.nkeys[2] = 16; A.kvrow[0] = -1; A.kvrow[1] = -1; A.kvrow[2] = MP + 16 * b;
                A.ck = args.in[2] + (size_t)b * 128 * 128; A.cv = args.in[3] + (size_t)b * 128 * 128; A.qrow0 = MP + 16 * b; A.nq = 16; A.kvh = kvh;
            }
            attn_unit(F, args.in[20], A, Qb, Kb, Vb, ZB);
        }
    }
    SEAM(2);
    if (IN(3)) {
        if (F.wave < 2) {
            for (int idx = blockIdx.x * 2 + F.wave; idx < NBATCH * NGRP; idx += F.G * 2) {
                const int b = idx >> 6, g = idx & 63;
                const f32x2 l64 = ((const f32x2*)(F.ws + WS_CONST + C_LAM64))[g * 64 + F.lane];
                float hre = 0.f, him = 0.f;
#pragma unroll 8
                for (int j = 0; j < NCHUNK; ++j) {
                    const size_t o = ((size_t)(b * 64 + j) * NGRP + g) * 128 + F.lane;
                    Hin[o] = hre; Hin[o + 64] = him;
                    const float sre = Sst[o], sim = Sst[o + 64];
                    const float nre = l64.x * hre - l64.y * him + sre, nim = l64.x * him + l64.y * hre + sim;
                    hre = nre; him = nim;
                }
                F.out[O_PRE + (size_t)(b * 64 + g) * 64 + F.lane] = hre; F.out[O_PIM + (size_t)(b * 64 + g) * 64 + F.lane] = him;
            }
        }
        for (int it = blockIdx.x; it < NBATCH * 8; it += F.G) {
            const int gs = it & 7, b = it >> 3; const size_t so = (size_t)(b * 64 + gs * 8 + F.wave) * 64;
            ssm_unit<true>(F, args.in[15], U, MP + 16 * b, 16, gs, args.in[4] + so, args.in[5] + so, F.out + O_SRE + so, F.out + O_SIM + so);
        }
    }
    SEAM(3);
    if (IN(4)) {
        for (int it = blockIdx.x; it < NBATCH * NCHUNK * 8; it += F.G) {
            const int gs = it & 7, bj = it >> 3;
            const float* hi_ = Hin + ((size_t)bj * NGRP + gs * 8 + F.wave) * 128;
            ssm_unit<true>(F, args.in[15], U, bj * 64, 64, gs, hi_, hi_ + 64, nullptr, nullptr);
        }
    }
    SEAM(4);
    if (IN(5)) {
        pg8::Gemm g{U, U, (const bf16_t*)(F.ws + WS_WGLU), 1024, 1024, 1 << 20, MROWS / 256, 4};
        pg8::StaticOrder S; S.init(g.nM, g.nN, F.G, (int)blockIdx.x);
        EpiGlu E{U, ZA, args.in[17]};
        pg8::gemm_phase<EpiGlu, true>(F.lds, g, S, E);
    }
    SEAM(5);
    if (IN(6)) {
        pg8::Gemm g{ZA, Qb, (const bf16_t*)(F.ws + WS_WOUT), 1024, 2048, 16, MROWS / 256, 8};
        pg8::StaticOrder S; S.init(g.nM, g.nN, F.G, (int)blockIdx.x);
        EpiOut E{GA, GB, XN};
        pg8::gemm_phase<EpiOut, true>(F.lds, g, S, E);
    }
    SEAM(6);
    if (IN(7)) {
        pg8::Gemm g{XN, XN, (const bf16_t*)(F.ws + WS_WO), DM, DM, 1 << 20, MROWS / 256, 8};
        pg8::StaticOrder S; S.init(g.nM, g.nN, F.G, (int)blockIdx.x);
        EpiRes E{args.in[0], args.in[1], F.out};
        pg8::gemm_phase<EpiRes, true>(F.lds, g, S, E);
    }
#undef IN
#undef SEAM
}

extern "C" void kernel_launch(void* const* d_in, const int* in_sizes, int n_in, void* d_out, int out_size, void* d_ws, size_t ws_size, hipStream_t stream) {
    static int grid = 0;
    if (grid == 0) {
        if (n_in != 25 || ws_size < WS_END) { fprintf(stderr, "kernel_launch: unexpected n_in %d / ws %zu\n", n_in, ws_size); grid = -1; return; }
        int dev = 0, cus = 0, per_cu = 0;
        hipGetDevice(&dev); hipDeviceGetAttribute(&cus, hipDeviceAttributeMultiprocessorCount, dev);
        hipFuncSetAttribute((const void*)mk_fwd, hipFuncAttributeMaxDynamicSharedMemorySize, LDS_BYTES);
        hipOccupancyMaxActiveBlocksPerMultiprocessor(&per_cu, (const void*)mk_fwd, 512, LDS_BYTES);
        if (per_cu < 1) { fprintf(stderr, "kernel_launch: occupancy query says %d blocks/CU\n", per_cu); per_cu = 1; }
        (void)hipGetLastError();
        grid = cus;
    }
    if (grid < 0) return;
    if (hipMemsetAsync((char*)d_ws + WS_CTL, 0, 16384, stream) != hipSuccess) { fprintf(stderr, "kernel_launch: memset of the barrier words failed\n"); return; }
    Args a{};
    for (int i = 0; i < 25; ++i) a.in[i] = (const float*)d_in[i];
    a.out = (float*)d_out; a.ws = (unsigned char*)d_ws;
    constexpr int NPH = 8;
    if (MK_N_LAUNCHES == 1) {
        a.ph_lo = 0; a.ph_hi = NPH;
        void* kargs[] = {&a};
        hipError_t e = hipLaunchCooperativeKernel((const void*)mk_fwd, dim3(grid), dim3(512), kargs, LDS_BYTES, stream);
        if (e != hipSuccess) fprintf(stderr, "cooperative launch failed: %s (grid %d)\n", hipGetErrorString(e), grid);
    } else {
        for (int p = 0; p < NPH; ++p) { a.ph_lo = p; a.ph_hi = p + 1; hipLaunchKernelGGL(mk_fwd, dim3(grid), dim3(512), LDS_BYTES, stream, a); }
    }
}
```

```cpp
#include <hip/hip_runtime.h>
#include <hip/hip_cooperative_groups.h>
#include <cstdio>
#include <cstdint>
namespace cg = cooperative_groups;

#ifndef ATT_S3
#define ATT_S3 7
#endif
#ifndef PROBE
#define PROBE 0
#endif
#ifndef USE_CG_SYNC
#define USE_CG_SYNC 0
#endif
#ifndef STAGGER
#define STAGGER 0
#endif
#ifndef WGM_IN16
#define WGM_IN16 4
#endif
#ifndef WGM_IN8
#define WGM_IN8 4
#endif
#ifndef WGM_P5
#define WGM_P5 4
#endif
#ifndef WGM_P67
#define WGM_P67 4
#endif
#ifndef MK_N_LAUNCHES
#define MK_N_LAUNCHES 1
#endif

#define LAS __attribute__((address_space(3)))
typedef unsigned short bf16_t;
typedef short bf16x8 __attribute__((ext_vector_type(8)));
typedef short s16x4 __attribute__((ext_vector_type(4)));
typedef float f32x4 __attribute__((ext_vector_type(4)));
typedef float f32x2 __attribute__((ext_vector_type(2)));
typedef float f32x16 __attribute__((ext_vector_type(16)));
typedef unsigned u32x4 __attribute__((ext_vector_type(4)));
typedef unsigned u32x2 __attribute__((ext_vector_type(2)));
typedef int v8i32 __attribute__((ext_vector_type(8)));
typedef int i32x4 __attribute__((ext_vector_type(4)));
typedef short bf16x16 __attribute__((ext_vector_type(16)));

constexpr int DM = 2048, SEQ = 4096, NBATCH = 8, MP = NBATCH * SEQ, MS = 128, MROWS = 33024;
constexpr int NIN = 8448, NCHUNK = 64, NGRP = 64, NSTATE = 64;
constexpr float EPSN = 1e-6f, LOG2E = 1.4426950408889634f, QSCALE = 0.125f * 1.4426950408889634f;
constexpr size_t O_YP = 0, O_YS = 67108864, O_PRE = 67371008, O_PIM = 67403776, O_PK = 67436544, O_PV = 67567616, O_SRE = 67698688, O_SIM = 67731456, O_SK = 67764224, O_SV = 67780608;
constexpr size_t MiB = 1u << 20;
constexpr int LD1 = 1024 + 64, LD2 = 2048 + 64;
constexpr size_t WS_CTL = 0, WS_WIN = 1 * MiB, WS_WGLU = 36 * MiB, WS_WOUT = 39 * MiB, WS_WO = 48 * MiB, WS_CONST = 57 * MiB, WS_XN = 58 * MiB, WS_U = 192 * MiB, WS_ZA = 261 * MiB,
                 WS_Q = 330 * MiB, WS_ZB = 399 * MiB, WS_K = 468 * MiB, WS_V = 477 * MiB, WS_GA = 486 * MiB, WS_GB = 620 * MiB, WS_S = 754 * MiB, WS_W8GLU = 755 * MiB, WS_W8OUT = 757 * MiB, WS_W8O = 762 * MiB,
                 WS_G8 = 767 * MiB, WS_BR8 = 804 * MiB, WS_MX8 = 873 * MiB, WS_XN8 = 873 * MiB  , WS_W8IN = 942 * MiB, WS_DUMMY = 873 * MiB, WS_END = 957 * MiB;
#ifndef FP8_ZB
#define FP8_ZB 1
#endif
constexpr int IN8_TILES = 28, INB_TILES = 5;
__host__ __device__ constexpr int in8_tile(int j) { return j < 8 ? 4 + j : 5 + j; }
constexpr int LD8A = 1024 + 128, LD8B = 2048 + 128;
constexpr float F8_W = 64.f, F8_G = 8.f, F8_BR = 16.f, F8_MX = 64.f, F8_X = 8.f;
constexpr int E8_W = (127 - 6) * 0x01010101, E8_G = (127 - 3) * 0x01010101, E8_BR = (127 - 4) * 0x01010101, E8_MX = (127 - 6) * 0x01010101, E8_X = (127 - 3) * 0x01010101;
constexpr size_t C_LAM = 0, C_LAM64 = 32768, C_BF = 65536, C_CF = 327680, C_BT = 589824, C_RS = 606208;
constexpr int LDS_BYTES = 163840, MISC_OFF = 163840 - 64, PRE_OFF = 131072;

typedef __bf16 bf16x2_t __attribute__((ext_vector_type(2)));
__device__ __forceinline__ unsigned cvt_pk_bf16(float lo, float hi) { const bf16x2_t r = __builtin_convertvector((f32x2){lo, hi}, bf16x2_t); return __builtin_bit_cast(unsigned, r); }
__device__ __forceinline__ unsigned cvt_pk_bf16_nv(float lo, float hi) { return cvt_pk_bf16(lo, hi); }
__device__ __forceinline__ unsigned cvt_pk_bf16_b(float lo, float hi) { const bf16x2_t r = __builtin_convertvector((f32x2){lo, hi}, bf16x2_t); return __builtin_bit_cast(unsigned, r); }
__device__ __forceinline__ unsigned pk4_fp8(float a, float b, float c, float d) {
    a = fminf(fmaxf(a, -448.f), 448.f); b = fminf(fmaxf(b, -448.f), 448.f); c = fminf(fmaxf(c, -448.f), 448.f); d = fminf(fmaxf(d, -448.f), 448.f);
    int w = __builtin_amdgcn_cvt_pk_fp8_f32(a, b, 0, false); w = __builtin_amdgcn_cvt_pk_fp8_f32(c, d, w, true); return (unsigned)w; }
__device__ __forceinline__ float bf2f(unsigned short b) { return __uint_as_float((unsigned)b << 16); }
__device__ __forceinline__ float bflo(unsigned w) { return __uint_as_float(w << 16); }
__device__ __forceinline__ float bfhi(unsigned w) { return __uint_as_float(w & 0xffff0000u); }
__device__ __forceinline__ float sigmoidf_(float x) { return __builtin_amdgcn_rcpf(1.0f + __builtin_amdgcn_exp2f(-LOG2E * x)); }
__device__ __forceinline__ float siluf_(float x) { return x * sigmoidf_(x); }
__device__ __forceinline__ float geluf_(float v) {
    const float av = fabsf(v), t = __builtin_amdgcn_rcpf(av * 0.2316418882f + 1.0f);
    float q = t * 0.5307027145f + (-0.7265760135f); q = q * t + 0.7107068705f; q = q * t + (-0.142248368f); q = q * t + 0.127414796f; q = q * t;
    const float e = __builtin_amdgcn_exp2f((v * v) * (-0.72134752044f));
    const float m = v * (q * e);
    return v < 0.f ? m : v - m;
}

#define GAS1 __attribute__((address_space(1)))
__device__ __forceinline__ unsigned char* ws_fresh(unsigned char* p) { GAS1 unsigned char* g = (GAS1 unsigned char*)p; asm volatile("" : "+s"(g)); return (unsigned char*)g; }
__device__ __forceinline__ int lane_id_fresh() { int l; asm volatile("v_mbcnt_lo_u32_b32 %0, -1, 0\n\tv_mbcnt_hi_u32_b32 %0, -1, %0" : "=v"(l)); return l; }
namespace pg8 {
constexpr int BM = 256, BK = 64, HALF = 128, HTB = HALF * BK * 2, STAGE_BYTES = 8 * HTB, NXCD = 8;
__host__ __device__ __forceinline__ int lds_byte(int r, int c) { const int st = (r >> 4) * 2 + (c >> 5), rr = r & 15, cc = c & 31, ob = rr * 64 + cc * 2; return st * 1024 + (ob ^ (((ob >> 9) & 1) << 5)); }
__host__ __device__ __forceinline__ void stage_rc(int b, int& R, int& C) { const int st = b / 1024, sb = b % 1024, swz = sb ^ (((sb >> 9) & 1) << 5); R = (st >> 1) * 16 + swz / 64; C = (st & 1) * 32 + (swz % 64) / 2; }
__host__ __device__ __forceinline__ int perm32(int rho) { const int n = rho >> 4, i = rho & 15; return 8 * (i >> 2) + 4 * n + (i & 3); }
struct Unit { int pm, pn; };
struct Gemm { const bf16_t* A; const bf16_t* A2; const bf16_t* Bt; int lda, ldb, K, ksplit, nM, nN, fold, scaleA, scaleB; };
struct StaticOrder {
    int nM, nN, nwg, G, c, nx, xpm, inmap, pm0, WGM;
    __device__ void init(int nM_, int nN_, int G_, int c_, int nx_ = 0, int xpm_ = 0, int inmap_ = 0, int pm0_ = 0, int wgm_ = 4) { nM = nM_; nN = nN_; nwg = nM * nN; G = G_; c = c_; nx = nx_; xpm = xpm_; inmap = inmap_; pm0 = pm0_; WGM = wgm_; }
    __device__ bool next(int i, Unit& u) const {
        const int L = i * G + c; if (L >= nwg) { if (L >= nwg + nx) return false; const int j = (int)(L - nwg); u.pm = xpm; u.pn = j < 8 ? 4 + j : 5 + j; return true; }
        int wgid = L; { const int q = nwg / NXCD, r = nwg % NXCD, xcd = wgid % NXCD, off = wgid / NXCD; wgid = (xcd < r ? xcd * (q + 1) : r * (q + 1) + (xcd - r) * q) + off; }
        const int nig = WGM * nN, gid = wgid / nig, fm = gid * WGM, gsz = (nM - fm) < WGM ? (nM - fm) : WGM;
        u.pm = pm0 + fm + ((wgid % nig) % gsz); u.pn = (wgid % nig) / gsz; if (inmap && u.pn >= 4) u.pn += 8; return true;
    }
};

template <class Epi, bool ALIGN_EPI>
__device__ __forceinline__ void gemm_phase(LAS unsigned char* lds, const Gemm g, const StaticOrder& S, const Epi& E, int wid_in) {
    const int wid = wid_in, lane = lane_id_fresh(), tid = wid * 64 + lane, wr = wid >> 2, wc = wid & 3, fr = lane & 15, fq = lane >> 4;
    const int K = g.K, nt = K / BK, lda = g.lda, ldb = g.ldb;
    unsigned voffA[2], voffB[2];
#pragma unroll
    for (int i = 0; i < 2; ++i) { int R, C; stage_rc(tid * 16 + i * 8192, R, C); const int Rb = Epi::PERM ? ((R & ~31) + perm32(R & 31)) : R;
        voffA[i] = (unsigned)(R * lda + C) * 2u; voffB[i] = (unsigned)(Rb * ldb + C) * 2u; }
    const size_t kstep = (size_t)(BK * 2);
    const size_t hstepA = (size_t)HALF * lda * 2, tstepA = 2 * hstepA;
    const size_t hstepB = (size_t)HALF * ldb * 2, tstepB = 2 * hstepB;
    const unsigned ldsw = (unsigned)wid * 1024u;
    const int aoff = lds_byte(wr * 64 + fr, fq * 8), boff = lds_byte(wc * 32 + fr, fq * 8);
    const char* Alo = (const char*)g.A; const char* Ahi = (const char*)g.A2 - (size_t)g.ksplit * kstep;
#define PG8_APAN(pm, t) (((t) < g.ksplit ? Alo : Ahi) + (size_t)(g.fold ? 0 : (pm)) * tstepA + (size_t)(t) * kstep)
#define PG8_SA(b, h) (((b) * 2 + (h)) * HTB)
#define PG8_SB(b, h) ((4 + (b) * 2 + (h)) * HTB)
#define PG8_STAGE(bufoff, gbase, voff) do { _Pragma("unroll") for (int _i = 0; _i < 2; ++_i) \
        __builtin_amdgcn_global_load_lds((const unsigned*)((const char*)(gbase) + (voff)[_i]), (LAS unsigned*)(lds + (bufoff) + ldsw + _i * 8192), 16, 0, 0); } while (0)
#define PG8_LDA(dst, b, h) do { _Pragma("unroll") for (int m = 0; m < 4; ++m) _Pragma("unroll") for (int k = 0; k < 2; ++k) dst[m][k] = *(const LAS bf16x8*)(lds + PG8_SA(b, h) + aoff + m * 2048 + k * 1024); } while (0)
#define PG8_LDB(dst, b, h) do { _Pragma("unroll") for (int n = 0; n < 2; ++n) _Pragma("unroll") for (int k = 0; k < 2; ++k) dst[n][k] = *(const LAS bf16x8*)(lds + PG8_SB(b, h) + boff + n * 2048 + k * 1024); } while (0)
#define PG8_MMA(ai, bj, At, Bt) do { __builtin_amdgcn_s_setprio(1); _Pragma("unroll") for (int m = 0; m < 4; ++m) _Pragma("unroll") for (int n = 0; n < 2; ++n) _Pragma("unroll") for (int k = 0; k < 2; ++k) \
        acc[ai][bj][m][n] = __builtin_amdgcn_mfma_f32_16x16x32_bf16(Bt[n][k], At[m][k], acc[ai][bj][m][n], 0, 0, 0); __builtin_amdgcn_s_setprio(0); } while (0)
#define PG8_WAIT_V(n) asm volatile("s_waitcnt vmcnt(" #n ")" ::: "memory")
#define PG8_WAIT_L(n) asm volatile("s_waitcnt lgkmcnt(" #n ")" ::: "memory")
#define PG8_BAR __builtin_amdgcn_s_barrier()
#define PG8_SCHED __builtin_amdgcn_sched_barrier(0)
    Unit cur, nxt; int ui = 0;
    if (!S.next(0, cur)) return;
    f32x4 acc[2][2][4][2];
#pragma unroll
    for (int a = 0; a < 2; ++a)
#pragma unroll
        for (int b = 0; b < 2; ++b)
#pragma unroll
            for (int m = 0; m < 4; ++m)
#pragma unroll
                for (int n = 0; n < 2; ++n) acc[a][b][m][n] = (f32x4){0.f, 0.f, 0.f, 0.f};
    bf16x8 At[4][2], B0[2][2], B1[2][2];
    const char* cA = PG8_APAN(cur.pm, 0); const char* cB = (const char*)g.Bt + (size_t)(g.fold ? 0 : cur.pn) * tstepB;
    PG8_STAGE(PG8_SB(0, 0), cB, voffB); PG8_STAGE(PG8_SB(0, 1), cB + hstepB, voffB); PG8_STAGE(PG8_SA(0, 0), cA, voffA); PG8_STAGE(PG8_SA(0, 1), cA + hstepA, voffA);
    if (wr == 1) PG8_BAR;
    PG8_WAIT_V(2); PG8_BAR;
    PG8_STAGE(PG8_SB(1, 0), cB + kstep, voffB); PG8_STAGE(PG8_SA(1, 0), cA + kstep, voffA); PG8_STAGE(PG8_SB(1, 1), cB + hstepB + kstep, voffB);
    PG8_WAIT_V(6); PG8_BAR;
    for (;;) {
        const bool has_next = S.next(ui + 1, nxt);
        const char* nA = has_next ? PG8_APAN(nxt.pm, 0) : cA; const char* nB = has_next ? (const char*)g.Bt + (size_t)(g.fold ? 0 : nxt.pn) * tstepB : cB;
        for (int t = 0; t < nt; t += 2) {
            if constexpr (Epi::HAS_MID) { if (t == g.ksplit) E.mid(acc, cur, wr, wc, fr, fq); }
            const bool last = (t == nt - 2);
            const char* a1 = PG8_APAN(cur.pm, t + 1);
            const char* a2 = last ? nA : PG8_APAN(cur.pm, t + 2); const char* b2 = last ? nB : cB + (size_t)(t + 2) * kstep;
            const char* a3 = a2 + kstep; const char* b3 = b2 + kstep;
            PG8_LDB(B0, 0, 0); PG8_LDB(B1, 0, 1); PG8_SCHED; PG8_LDA(At, 0, 0); PG8_STAGE(PG8_SA(1, 1), a1 + hstepA, voffA);
            PG8_WAIT_V(8); PG8_WAIT_L(0); PG8_BAR; PG8_MMA(0, 0, At, B0); PG8_MMA(0, 1, At, B1); PG8_BAR; PG8_SCHED;
            PG8_LDA(At, 0, 1); PG8_STAGE(PG8_SB(0, 0), b2, voffB); PG8_STAGE(PG8_SB(0, 1), b2 + hstepB, voffB); PG8_STAGE(PG8_SA(0, 0), a2, voffA);
            PG8_WAIT_V(8); PG8_WAIT_L(0); PG8_BAR; PG8_MMA(1, 0, At, B0); PG8_MMA(1, 1, At, B1); PG8_BAR; PG8_SCHED;
            PG8_LDB(B0, 1, 0); PG8_LDB(B1, 1, 1); PG8_SCHED; PG8_LDA(At, 1, 0); PG8_STAGE(PG8_SA(0, 1), a2 + hstepA, voffA);
            PG8_WAIT_V(8); PG8_WAIT_L(0); PG8_BAR; PG8_MMA(0, 0, At, B0); PG8_MMA(0, 1, At, B1); PG8_BAR; PG8_SCHED;
            PG8_LDA(At, 1, 1); PG8_STAGE(PG8_SB(1, 0), b3, voffB); PG8_STAGE(PG8_SB(1, 1), b3 + hstepB, voffB); PG8_STAGE(PG8_SA(1, 0), a3, voffA);
            PG8_WAIT_V(8); PG8_WAIT_L(0); PG8_BAR; PG8_MMA(1, 0, At, B0); PG8_MMA(1, 1, At, B1); PG8_BAR; PG8_SCHED;
        }
        if constexpr (ALIGN_EPI) { if (wr == 0) PG8_BAR; }
        E(acc, cur, wr, wc, fr, fq);
        if (!has_next) break;
#pragma unroll
        for (int a = 0; a < 2; ++a)
#pragma unroll
            for (int b = 0; b < 2; ++b)
#pragma unroll
                for (int m = 0; m < 4; ++m)
#pragma unroll
                    for (int n = 0; n < 2; ++n) acc[a][b][m][n] = (f32x4){0.f, 0.f, 0.f, 0.f};
        cur = nxt; cA = nA; cB = nB; ++ui;
        if constexpr (ALIGN_EPI) { if (wr == 1) PG8_BAR; }
    }
    PG8_WAIT_V(0);
    if constexpr (!ALIGN_EPI) { if (wr == 0) PG8_BAR; }
    PG8_BAR;
#undef PG8_APAN
#undef PG8_SA
#undef PG8_SB
#undef PG8_STAGE
#undef PG8_LDA
#undef PG8_LDB
#undef PG8_MMA
#undef PG8_WAIT_V
#undef PG8_WAIT_L
#undef PG8_BAR
#undef PG8_SCHED
}
template <class Epi, bool ALIGN_EPI, int SCA, int SCB>
__device__ __forceinline__ void gemm_phase8(LAS unsigned char* lds, const Gemm g, const StaticOrder& S, const Epi& E, int wid_in) {
    const int wid = wid_in, lane = lane_id_fresh(), tid = wid * 64 + lane, wr = wid >> 2, wc = wid & 3, fr = lane & 15, fq = lane >> 4;
    const int K = g.K, nt = K / BK, lda = g.lda, ldb = g.ldb;
    unsigned voffA[2], voffB[2];
#pragma unroll
    for (int i = 0; i < 2; ++i) { int R, C; stage_rc(tid * 16 + i * 8192, R, C); const int Rb = Epi::PERM ? ((R & ~31) + perm32(R & 31)) : R;
        voffA[i] = (unsigned)(R * lda + C) * 2u; voffB[i] = (unsigned)(Rb * ldb + C) * 2u; }
    const unsigned kstep = (unsigned)(BK * 2);
    const unsigned hstepA = (unsigned)HALF * lda * 2, tstepA = 2 * hstepA;
    const unsigned hstepB = (unsigned)HALF * ldb * 2, tstepB = 2 * hstepB;
    const unsigned ldsw = (unsigned)wid * 1024u;
    const int aoff0 = lds_byte(wr * 64 + fr, fq * 16), boff0 = lds_byte(wc * 32 + fr, fq * 16);
    constexpr int aoff1d = 16, boff1d = 16;
    const char* Abase = (const char*)g.A; const char* Bbase = (const char*)g.Bt;
#define PG8_APAN(pm, t) ((unsigned)(pm) * tstepA + (unsigned)(t) * kstep)
#define PG8_SA(b, h) (((b) * 2 + (h)) * HTB)
#define PG8_SB(b, h) ((4 + (b) * 2 + (h)) * HTB)
#define PG8_STAGE(bufoff, gbase, voff) do { _Pragma("unroll") for (int _i = 0; _i < 2; ++_i) \
        { unsigned vo_ = (voff)[_i]; asm volatile("" : "+v"(vo_));   \
        __builtin_amdgcn_global_load_lds((const unsigned*)(gbase + vo_), (LAS unsigned*)(lds + (bufoff) + ldsw + _i * 8192), 16, 0, 0); } } while (0)
#define PG8_GA(off) (Abase + (size_t)(off))
#define PG8_GB(off) (Bbase + (size_t)(off))
#define PG8_LDA(dst, b, h) do { _Pragma("unroll") for (int m = 0; m < 4; ++m) { const i32x4 lo_ = *(const LAS i32x4*)(lds + PG8_SA(b, h) + aoff0 + m * 2048), hi_ = *(const LAS i32x4*)(lds + PG8_SA(b, h) + aoff0 + aoff1d + m * 2048); dst[m] = __builtin_shufflevector(lo_, hi_, 0, 1, 2, 3, 4, 5, 6, 7); } } while (0)
#define PG8_LDB(dst, b, h) do { _Pragma("unroll") for (int n = 0; n < 2; ++n) { const i32x4 lo_ = *(const LAS i32x4*)(lds + PG8_SB(b, h) + boff0 + n * 2048), hi_ = *(const LAS i32x4*)(lds + PG8_SB(b, h) + boff0 + boff1d + n * 2048); dst[n] = __builtin_shufflevector(lo_, hi_, 0, 1, 2, 3, 4, 5, 6, 7); } } while (0)
#define PG8_MMA(ai, bj, At, Bt) do { __builtin_amdgcn_s_setprio(1); _Pragma("unroll") for (int m = 0; m < 4; ++m) _Pragma("unroll") for (int n = 0; n < 2; ++n) \
        acc[ai][bj][m][n] = __builtin_amdgcn_mfma_scale_f32_16x16x128_f8f6f4(Bt[n], At[m], acc[ai][bj][m][n], 0, 0, 0, SCB, 0, SCA); __builtin_amdgcn_s_setprio(0); } while (0)
#define PG8_WAIT_V(n) asm volatile("s_waitcnt vmcnt(" #n ")" ::: "memory")
#define PG8_WAIT_L(n) asm volatile("s_waitcnt lgkmcnt(" #n ")" ::: "memory")
#define PG8_BAR __builtin_amdgcn_s_barrier()
#define PG8_SCHED __builtin_amdgcn_sched_barrier(0)
    Unit cur, nxt; int ui = 0;
    if (!S.next(0, cur)) return;
    f32x4 acc[2][2][4][2];
#pragma unroll
    for (int a = 0; a < 2; ++a)
#pragma unroll
        for (int b = 0; b < 2; ++b)
#pragma unroll
            for (int m = 0; m < 4; ++m)
#pragma unroll
                for (int n = 0; n < 2; ++n) acc[a][b][m][n] = (f32x4){0.f, 0.f, 0.f, 0.f};
    v8i32 At[4], B0[2], B1[2];
    unsigned cA = PG8_APAN(cur.pm, 0), cB = (unsigned)cur.pn * tstepB;
    PG8_STAGE(PG8_SB(0, 0), PG8_GB(cB), voffB); PG8_STAGE(PG8_SB(0, 1), PG8_GB(cB + hstepB), voffB); PG8_STAGE(PG8_SA(0, 0), PG8_GA(cA), voffA); PG8_STAGE(PG8_SA(0, 1), PG8_GA(cA + hstepA), voffA);
    if (wr == 1) PG8_BAR;
    PG8_WAIT_V(2); PG8_BAR;
    PG8_STAGE(PG8_SB(1, 0), PG8_GB(cB + kstep), voffB); PG8_STAGE(PG8_SA(1, 0), PG8_GA(cA + kstep), voffA); PG8_STAGE(PG8_SB(1, 1), PG8_GB(cB + hstepB + kstep), voffB);
    PG8_WAIT_V(6); PG8_BAR;
    for (;;) {
        const bool has_next = S.next(ui + 1, nxt);
        const unsigned nA = has_next ? PG8_APAN(nxt.pm, 0) : cA, nB = has_next ? (unsigned)nxt.pn * tstepB : cB;
#pragma unroll 1
        for (int t = 0; t < nt; t += 2) {
            if constexpr (Epi::HAS_MID) { if (t == g.ksplit) { const int l_ = lane_id_fresh(); E.mid(acc, cur, wr, wc, l_ & 15, l_ >> 4); } }
            const bool last = (t == nt - 2);
            const unsigned a1 = cA + (unsigned)(t + 1) * kstep;
            const unsigned a2 = last ? nA : cA + (unsigned)(t + 2) * kstep, b2 = last ? nB : cB + (unsigned)(t + 2) * kstep;
            const unsigned a3 = a2 + kstep, b3 = b2 + kstep;
            if constexpr (Epi::HAS_PRE) { if (last) { const int l_ = lane_id_fresh(); E.prefetch(lds + PRE_OFF + ldsw, cur, wr, wc, l_ & 15, l_ >> 4); }
                                          else if (Epi::HAS_MID && t + 2 == g.ksplit) { const int l_ = lane_id_fresh(); E.prefetch_mid(lds + PRE_OFF + ldsw, cur, wr, wc, l_ & 15, l_ >> 4); } }
            PG8_LDB(B0, 0, 0); PG8_LDB(B1, 0, 1); PG8_SCHED; PG8_LDA(At, 0, 0); PG8_STAGE(PG8_SA(1, 1), PG8_GA(a1 + hstepA), voffA);
            PG8_WAIT_V(8); PG8_WAIT_L(0); PG8_BAR; PG8_MMA(0, 0, At, B0); PG8_MMA(0, 1, At, B1); PG8_BAR; PG8_SCHED;
            PG8_LDA(At, 0, 1); PG8_STAGE(PG8_SB(0, 0), PG8_GB(b2), voffB); PG8_STAGE(PG8_SB(0, 1), PG8_GB(b2 + hstepB), voffB); PG8_STAGE(PG8_SA(0, 0), PG8_GA(a2), voffA);
            PG8_WAIT_V(8); PG8_WAIT_L(0); PG8_BAR; PG8_MMA(1, 0, At, B0); PG8_MMA(1, 1, At, B1); PG8_BAR; PG8_SCHED;
            PG8_LDB(B0, 1, 0); PG8_LDB(B1, 1, 1); PG8_SCHED; PG8_LDA(At, 1, 0); PG8_STAGE(PG8_SA(0, 1), PG8_GA(a2 + hstepA), voffA);
            PG8_WAIT_V(8); PG8_WAIT_L(0); PG8_BAR; PG8_MMA(0, 0, At, B0); PG8_MMA(0, 1, At, B1); PG8_BAR; PG8_SCHED;
            PG8_LDA(At, 1, 1); PG8_STAGE(PG8_SB(1, 0), PG8_GB(b3), voffB); PG8_STAGE(PG8_SB(1, 1), PG8_GB(b3 + hstepB), voffB); PG8_STAGE(PG8_SA(1, 0), PG8_GA(a3), voffA);
            PG8_WAIT_V(8); PG8_WAIT_L(0); PG8_BAR; PG8_MMA(1, 0, At, B0); PG8_MMA(1, 1, At, B1); PG8_BAR; PG8_SCHED;
        }
        if constexpr (ALIGN_EPI) { if (wr == 0) PG8_BAR; }
        { const int l_ = lane_id_fresh(); E(acc, cur, wr, wc, l_ & 15, l_ >> 4); }
        if (!has_next) break;
#pragma unroll
        for (int a = 0; a < 2; ++a)
#pragma unroll
            for (int b = 0; b < 2; ++b)
#pragma unroll
                for (int m = 0; m < 4; ++m)
#pragma unroll
                    for (int n = 0; n < 2; ++n) acc[a][b][m][n] = (f32x4){0.f, 0.f, 0.f, 0.f};
        cur = nxt; cA = nA; cB = nB; ++ui;
        if constexpr (ALIGN_EPI) { if (wr == 1) PG8_BAR; }
    }
    PG8_WAIT_V(0);
    if constexpr (!ALIGN_EPI) { if (wr == 0) PG8_BAR; }
    PG8_BAR;
#undef PG8_APAN
#undef PG8_GA
#undef PG8_GB
#undef PG8_SA
#undef PG8_SB
#undef PG8_STAGE
#undef PG8_LDA
#undef PG8_LDB
#undef PG8_MMA
#undef PG8_WAIT_V
#undef PG8_WAIT_L
#undef PG8_BAR
#undef PG8_SCHED
}
}

typedef const f32x4 (&AccRef)[2][2][4][2];
typedef f32x4 (&AccMut)[2][2][4][2];

__device__ __forceinline__ u32x2 pack8_fp8(f32x4 a, f32x4 b, float s) { u32x2 w; w.x = pk4_fp8(a[0] * s, a[1] * s, a[2] * s, a[3] * s); w.y = pk4_fp8(b[0] * s, b[1] * s, b[2] * s, b[3] * s); return w; }
__device__ __forceinline__ u32x4 pack8(f32x4 a, f32x4 b) { u32x4 w; w.x = cvt_pk_bf16(a[0], a[1]); w.y = cvt_pk_bf16(a[2], a[3]); w.z = cvt_pk_bf16(b[0], b[1]); w.w = cvt_pk_bf16(b[2], b[3]); return w; }

__device__ __forceinline__ unsigned opaque(unsigned x) { asm volatile("" : "+v"(x)); return x; }

#define EPI_PREFETCH3(base_off, ldrow) do { _Pragma("unroll") for (int j = 0; j < 3; ++j) { unsigned vo_ = (base_off) + (unsigned)((j >> 1) * 16) * (unsigned)((ldrow) * 2) + (unsigned)((j & 1) * 256); asm volatile("" : "+v"(vo_)); \
            __builtin_amdgcn_global_load_lds((const unsigned*)(ws + vo_), (LAS unsigned*)(dstw + j * 8192), 16, 0, 0); } } while (0)
#define EPI_PRE_PTR() ((const LAS unsigned char*)(uintptr_t)(PRE_OFF + ((wr * 4 + wc) * 64 + fq * 16 + fr) * 16))
struct EpiIn {
    static constexpr bool PERM = true, HAS_MID = false, HAS_PRE = false;
    bf16_t *U, *ZA, *Q, *ZB, *Kb, *Vb, *GA, *GB; const float *qg, *kg; float* out; bool nostore; int pn_off;
    __device__ __forceinline__ void operator()(AccRef acc, const pg8::Unit& u, int wr, int wc, int fr, int fq) const {
        const int pn = pn_off ? (u.pn < 8 ? 4 + u.pn : 5 + u.pn) : u.pn, row0 = u.pm * 256 + wr * 64 + fr, lc0 = 64 * wc + 8 * fq;
        if (pn == 12) {
            const bool isk = wc < 2; const int hd = wc & 1;
            f32x4 gq[2][2];
#pragma unroll
            for (int bj = 0; bj < 2; ++bj)
#pragma unroll
                for (int n = 0; n < 2; ++n) gq[bj][n] = isk ? *(const f32x4*)(kg + 32 * bj + 8 * fq + 4 * n) : (f32x4){1.f, 1.f, 1.f, 1.f};
            char* dst = (char*)(isk ? Kb : Vb); float* opk = out + (isk ? O_PK : O_PV); float* osk = out + (isk ? O_SK : O_SV);
            const unsigned off0 = ((unsigned)row0 * 128u + 64u * hd + 8u * fq) * 2u;
#pragma unroll
            for (int ai = 0; ai < 2; ++ai)
#pragma unroll
                for (int m = 0; m < 4; ++m) {
                    const int row = row0 + ai * 128 + m * 16;
                    const unsigned o = opaque(off0 + (unsigned)(ai * 128 + m * 16) * 256u);
                    float r = 1.f;
                    if (isk) { float ss = 0.f;
#pragma unroll
                        for (int bj = 0; bj < 2; ++bj)
#pragma unroll
                            for (int n = 0; n < 2; ++n) { const f32x4 x = acc[ai][bj][m][n]; ss += (x[0] * x[0] + x[1] * x[1]) + (x[2] * x[2] + x[3] * x[3]); }
                        ss += __shfl_xor(ss, 16); ss += __shfl_xor(ss, 32);
                        r = __builtin_amdgcn_rsqf(ss * (1.0f / 64.0f) + EPSN); }
                    float* fo = nullptr;
                    if (row < MP) { const int t = row & (SEQ - 1); if (t >= SEQ - 128) fo = opk + ((size_t)((row >> 12) * 128 + (t - (SEQ - 128))) * 2 + hd) * 64; }
                    else if (row < MP + MS) { fo = osk + ((size_t)(row - MP) * 2 + hd) * 64; }
#pragma unroll
                    for (int bj = 0; bj < 2; ++bj) {
                        const f32x4 v0 = acc[ai][bj][m][0] * r * gq[bj][0], v1 = acc[ai][bj][m][1] * r * gq[bj][1];
                        if (!nostore) *(u32x4*)(dst + o + 64 * bj) = pack8(v0, v1);
                        if (fo && !nostore) { *(f32x4*)(fo + 32 * bj + 8 * fq) = v0; *(f32x4*)(fo + 32 * bj + 8 * fq + 4) = v1; }
                    }
                }
            return;
        }
        if (pn >= 8 && pn < 12) {
            f32x4 gq[2][2];
#pragma unroll
            for (int bj = 0; bj < 2; ++bj)
#pragma unroll
                for (int n = 0; n < 2; ++n) gq[bj][n] = *(const f32x4*)(qg + 32 * bj + 8 * fq + 4 * n) * QSCALE;
            const unsigned off0 = ((unsigned)row0 * (unsigned)LD1 + (unsigned)((pn - 8) * 256 + lc0)) * 2u;
#pragma unroll
            for (int ai = 0; ai < 2; ++ai)
#pragma unroll
                for (int m = 0; m < 4; ++m) {
                    const unsigned o = opaque(off0 + (unsigned)(ai * 128 + m * 16) * (unsigned)(LD1 * 2)); float ss = 0.f;
#pragma unroll
                    for (int bj = 0; bj < 2; ++bj)
#pragma unroll
                        for (int n = 0; n < 2; ++n) { const f32x4 x = acc[ai][bj][m][n]; ss += (x[0] * x[0] + x[1] * x[1]) + (x[2] * x[2] + x[3] * x[3]); }
                    ss += __shfl_xor(ss, 16); ss += __shfl_xor(ss, 32);
                    const float r = __builtin_amdgcn_rsqf(ss * (1.0f / 64.0f) + EPSN);
#pragma unroll
                    for (int bj = 0; bj < 2; ++bj)
                        { const u32x4 pk = pack8(acc[ai][bj][m][0] * r * gq[bj][0], acc[ai][bj][m][1] * r * gq[bj][1]); if (!nostore) *(u32x4*)((char*)Q + o + 64 * bj) = pk; else asm volatile("" :: "v"(pk)); }
                }
            return;
        }
        if (pn >= 17) {
            const unsigned off0 = ((unsigned)row0 * (unsigned)LD2 + (unsigned)((pn - 17) * 128 + 32 * wc + 8 * fq)) * 2u;
#pragma unroll
            for (int ai = 0; ai < 2; ++ai)
#pragma unroll
                for (int m = 0; m < 4; ++m) {
                    const unsigned o = opaque(off0 + (unsigned)(ai * 128 + m * 16) * (unsigned)(LD2 * 2));
                    f32x4 r0, r1, i0, i1;
#pragma unroll
                    for (int i = 0; i < 4; ++i) {
                        const float a0 = 1.0f + __builtin_amdgcn_exp2f(fminf(acc[ai][0][m][0][i], 86.5f)), a1 = 1.0f + __builtin_amdgcn_exp2f(fminf(acc[ai][0][m][1][i], 86.5f));
                        const float b0 = 1.0f + __builtin_amdgcn_exp2f(fminf(acc[ai][1][m][0][i], 86.5f)), b1 = 1.0f + __builtin_amdgcn_exp2f(fminf(acc[ai][1][m][1][i], 86.5f));
                        r0[i] = b0 * __builtin_amdgcn_rcpf(a0); r1[i] = b1 * __builtin_amdgcn_rcpf(a1); i0[i] = __builtin_amdgcn_rcpf(b0); i1[i] = __builtin_amdgcn_rcpf(b1);
                    }
                    const u32x4 pr = pack8(r0, r1), pi = pack8(i0, i1);
                    if (!nostore) { *(u32x4*)((char*)GA + o) = pr; *(u32x4*)((char*)GB + o) = pi; } else asm volatile("" :: "v"(pr), "v"(pi));
                }
            return;
        }
        char* dst; unsigned ld, cb; int kind;
        if (pn < 4) { dst = (char*)U; ld = LD1; cb = pn * 256; kind = 0; }
        else if (pn < 8) { dst = (char*)ZA; ld = LD1; cb = (pn - 4) * 256; kind = 1; }
        else { dst = (char*)ZB; ld = LD1; cb = (pn - 13) * 256; kind = 1; }
        const unsigned off0 = ((unsigned)row0 * ld + cb + (unsigned)lc0) * 2u;
#define EPI_IN_LOOP(BODY) _Pragma("unroll") for (int ai = 0; ai < 2; ++ai) _Pragma("unroll") for (int m = 0; m < 4; ++m) { \
            const unsigned o = opaque(off0 + (unsigned)(ai * 128 + m * 16) * ld * 2u); \
            _Pragma("unroll") for (int bj = 0; bj < 2; ++bj) { f32x4 v0 = acc[ai][bj][m][0], v1 = acc[ai][bj][m][1]; BODY; \
                const u32x4 pk = pack8(v0, v1); if (!nostore) *(u32x4*)(dst + o + 64 * bj) = pk; else asm volatile("" :: "v"(pk)); } }
        if (kind == 0) { EPI_IN_LOOP((void)0) }
        else { EPI_IN_LOOP(_Pragma("unroll") for (int i = 0; i < 4; ++i) { v0[i] = siluf_(v0[i]); v1[i] = siluf_(v1[i]); }) }
#undef EPI_IN_LOOP
    }
};

struct EpiGlu {
    static constexpr bool PERM = true, HAS_MID = false, HAS_PRE = true;
    unsigned char* ws; const float* bias;
    __device__ __forceinline__ void prefetch_mid(LAS unsigned char*, const pg8::Unit&, int, int, int, int) const {}
    __device__ __forceinline__ void prefetch(LAS unsigned char* dstw, const pg8::Unit& u, int wr, int wc, int fr, int fq) const {
        const int row0 = u.pm * 256 + wr * 64 + fr, col0 = u.pn * 256 + wc * 32 + 8 * fq;
        EPI_PREFETCH3(((unsigned)row0 * (unsigned)LD1 + (unsigned)col0) * 2u + (unsigned)WS_U, LD1);
    }
    __device__ __forceinline__ void operator()(AccRef acc, const pg8::Unit& u, int wr, int wc, int fr, int fq) const {
        const int row0 = u.pm * 256 + wr * 64 + fr, col0 = u.pn * 256 + wc * 32 + 8 * fq;
        f32x4 bv[2][2];
#pragma unroll
        for (int bj = 0; bj < 2; ++bj)
#pragma unroll
            for (int n = 0; n < 2; ++n) bv[bj][n] = *(const f32x4*)(bias + col0 + bj * 128 + 4 * n);
        const unsigned off0 = ((unsigned)row0 * (unsigned)LD1 + (unsigned)col0) * 2u + (unsigned)WS_U, off8 = (unsigned)row0 * (unsigned)LD8B + (unsigned)col0 + (unsigned)WS_BR8;
#pragma unroll
        for (int ai = 0; ai < 2; ++ai)
        { constexpr int mh = 0;
            u32x4 gw[4][2];
#pragma unroll
            for (int mm = 0; mm < 4; ++mm) { const unsigned o = opaque(off0 + (unsigned)(ai * 128 + (mh * 2 + mm) * 16) * (unsigned)(LD1 * 2));
#pragma unroll
                for (int bj = 0; bj < 2; ++bj) { if (ai == 0 && 2 * mm + bj < 3) gw[mm][bj] = *(const LAS u32x4*)(EPI_PRE_PTR() + (2 * mm + bj) * 8192); else gw[mm][bj] = *(const u32x4*)(ws + o + bj * 256); } }
            asm volatile("" ::: "memory");
#pragma unroll
            for (int mm = 0; mm < 4; ++mm) { const int m = mh * 2 + mm;
#pragma unroll
                for (int bj = 0; bj < 2; ++bj) {
                    const u32x4 g4 = gw[mm][bj];
                    const f32x4 a0 = acc[ai][bj][m][0] + bv[bj][0], a1 = acc[ai][bj][m][1] + bv[bj][1];
                    f32x4 o0, o1;
                    o0[0] = bflo(g4.x) * sigmoidf_(a0[0]); o0[1] = bfhi(g4.x) * sigmoidf_(a0[1]);
                    o0[2] = bflo(g4.y) * sigmoidf_(a0[2]); o0[3] = bfhi(g4.y) * sigmoidf_(a0[3]);
                    o1[0] = bflo(g4.z) * sigmoidf_(a1[0]); o1[1] = bfhi(g4.z) * sigmoidf_(a1[1]);
                    o1[2] = bflo(g4.w) * sigmoidf_(a1[2]); o1[3] = bfhi(g4.w) * sigmoidf_(a1[3]);
                    *(u32x2*)(ws + opaque(off8 + (unsigned)(ai * 128 + m * 16) * (unsigned)LD8B) + bj * 128) = pack8_fp8(o0, o1, F8_BR);
                } }
            asm volatile("" ::: "memory");
        }
    }
};

struct EpiOut {
    static constexpr bool PERM = true, HAS_MID = true, HAS_PRE = true;
    unsigned char* ws;
    __device__ __forceinline__ void prefetch_mid(LAS unsigned char* dstw, const pg8::Unit& u, int wr, int wc, int fr, int fq) const {
        const int row0 = u.pm * 256 + wr * 64 + fr, col0 = u.pn * 256 + wc * 32 + 8 * fq;
        EPI_PREFETCH3(((unsigned)row0 * (unsigned)LD2 + (unsigned)col0) * 2u + (unsigned)WS_GA, LD2);
    }
    __device__ __forceinline__ void prefetch(LAS unsigned char* dstw, const pg8::Unit& u, int wr, int wc, int fr, int fq) const {
        const int row0 = u.pm * 256 + wr * 64 + fr, col0 = u.pn * 256 + wc * 32 + 8 * fq;
        EPI_PREFETCH3(((unsigned)row0 * (unsigned)LD2 + (unsigned)col0) * 2u + (unsigned)WS_GB, LD2);
    }
    __device__ __forceinline__ void mid(AccMut acc, const pg8::Unit& u, int wr, int wc, int fr, int fq) const {
        const int row0 = u.pm * 256 + wr * 64 + fr, col0 = u.pn * 256 + wc * 32 + 8 * fq;
        const unsigned off0 = ((unsigned)row0 * (unsigned)LD2 + (unsigned)col0) * 2u + (unsigned)WS_GA;
#pragma unroll
        for (int ai = 0; ai < 2; ++ai)
        {
            u32x4 av[4][2];
#pragma unroll
            for (int mm = 0; mm < 4; ++mm) { const unsigned o = opaque(off0 + (unsigned)(ai * 128 + mm * 16) * (unsigned)(LD2 * 2));
#pragma unroll
                for (int bj = 0; bj < 2; ++bj) { if (ai == 0 && 2 * mm + bj < 3) av[mm][bj] = *(const LAS u32x4*)(EPI_PRE_PTR() + (2 * mm + bj) * 8192); else av[mm][bj] = *(const u32x4*)(ws + o + bj * 256); } }
            asm volatile("" ::: "memory");
#pragma unroll
            for (int mm = 0; mm < 4; ++mm)
#pragma unroll
                for (int bj = 0; bj < 2; ++bj) {
                    const u32x4 a = av[mm][bj];
                    f32x4 r0, r1;
                    r0[0] = bflo(a.x); r0[1] = bfhi(a.x); r0[2] = bflo(a.y); r0[3] = bfhi(a.y);
                    r1[0] = bflo(a.z); r1[1] = bfhi(a.z); r1[2] = bflo(a.w); r1[3] = bfhi(a.w);
                    acc[ai][bj][mm][0] *= r0; acc[ai][bj][mm][1] *= r1;
                }
            asm volatile("" ::: "memory");
        }
    }
    __device__ __forceinline__ void operator()(AccRef acc, const pg8::Unit& u, int wr, int wc, int fr, int fq) const {
        const int row0 = u.pm * 256 + wr * 64 + fr, col0 = u.pn * 256 + wc * 32 + 8 * fq;
        const unsigned off0 = ((unsigned)row0 * (unsigned)LD2 + (unsigned)col0) * 2u + (unsigned)WS_GB, off8 = (unsigned)row0 * (unsigned)LD8B + (unsigned)col0 + (unsigned)WS_MX8;
#pragma unroll
        for (int ai = 0; ai < 2; ++ai) {
            u32x4 bv[4][2];
#pragma unroll
            for (int m = 0; m < 4; ++m) { const unsigned o = opaque(off0 + (unsigned)(ai * 128 + m * 16) * (unsigned)(LD2 * 2));
#pragma unroll
                for (int bj = 0; bj < 2; ++bj) { if (ai == 0 && 2 * m + bj < 3) bv[m][bj] = *(const LAS u32x4*)(EPI_PRE_PTR() + (2 * m + bj) * 8192); else bv[m][bj] = *(const u32x4*)(ws + o + bj * 256); } }
            asm volatile("" ::: "memory");
#pragma unroll
            for (int m = 0; m < 4; ++m)
#pragma unroll
                for (int bj = 0; bj < 2; ++bj) {
                    const u32x4 b = bv[m][bj];
                    f32x4 g0, g1; g0[0] = bflo(b.x); g0[1] = bfhi(b.x); g0[2] = bflo(b.y); g0[3] = bfhi(b.y);
                    g1[0] = bflo(b.z); g1[1] = bfhi(b.z); g1[2] = bflo(b.w); g1[3] = bfhi(b.w);
                    *(u32x2*)(ws + opaque(off8 + (unsigned)(ai * 128 + m * 16) * (unsigned)LD8B) + bj * 128) = pack8_fp8(acc[ai][bj][m][0] * g0, acc[ai][bj][m][1] * g1, F8_MX);
                }
            asm volatile("" ::: "memory");
        }
    }
};

struct EpiRes {
    static constexpr bool PERM = true, HAS_MID = false, HAS_PRE = true;
    unsigned char* ws; const float* gain; float* out;
    __device__ __forceinline__ void prefetch_mid(LAS unsigned char*, const pg8::Unit&, int, int, int, int) const {}
    __device__ __forceinline__ void prefetch(LAS unsigned char* dstw, const pg8::Unit& u, int wr, int wc, int fr, int fq) const {
        const int row0 = u.pm * 256 + wr * 64 + fr, col0 = u.pn * 256 + wc * 32 + 8 * fq;
        const unsigned offx = ((unsigned)row0 * (unsigned)LD2 + (unsigned)col0) * 2u + (unsigned)WS_XN;
#pragma unroll
        for (int j = 0; j < 3; ++j) { unsigned vo_ = offx + (unsigned)((j >> 1) * 16) * (unsigned)(LD2 * 2) + (unsigned)((j & 1) * 256); asm volatile("" : "+v"(vo_));
            __builtin_amdgcn_global_load_lds((const unsigned*)(ws + vo_), (LAS unsigned*)(dstw + j * 8192), 16, 0, 0); }
    }
    __device__ __forceinline__ void operator()(AccRef acc, const pg8::Unit& u, int wr, int wc, int fr, int fq) const {
        const int row0 = u.pm * 256 + wr * 64 + fr, col0 = u.pn * 256 + wc * 32 + 8 * fq;
        const LAS unsigned char* pre = (const LAS unsigned char*)(uintptr_t)(PRE_OFF + ((wr * 4 + wc) * 64 + fq * 16 + fr) * 16);
        f32x4 ig[2][2];
#pragma unroll
        for (int bj = 0; bj < 2; ++bj)
#pragma unroll
            for (int n = 0; n < 2; ++n) { const f32x4 gq = *(const f32x4*)(gain + col0 + bj * 128 + 4 * n);
#pragma unroll
                for (int i = 0; i < 4; ++i) ig[bj][n][i] = __builtin_amdgcn_rcpf(gq[i]); }
        char* ob = (char*)(out + O_YP);
        const unsigned offx = ((unsigned)row0 * (unsigned)LD2 + (unsigned)col0) * 2u + (unsigned)WS_XN, offy = ((unsigned)row0 * (unsigned)DM + (unsigned)col0) * 4u;
#pragma unroll
        for (int ai = 0; ai < 2; ++ai) {
            u32x4 xv[4][2]; float rr[4];
#pragma unroll
            for (int m = 0; m < 4; ++m) { const unsigned o = opaque(offx + (unsigned)(ai * 128 + m * 16) * (unsigned)(LD2 * 2));
                rr[m] = *(const float*)(ws + (unsigned)(WS_CONST + C_RS) + (unsigned)(row0 + ai * 128 + m * 16) * 4u);
#pragma unroll
                for (int bj = 0; bj < 2; ++bj) { if (ai == 0 && 2 * m + bj < 3) xv[m][bj] = *(const LAS u32x4*)(pre + (2 * m + bj) * 8192); else xv[m][bj] = __builtin_nontemporal_load((const u32x4*)(ws + o + bj * 256)); } }
            asm volatile("" ::: "memory");
#pragma unroll
            for (int m = 0; m < 4; ++m) { const unsigned o = opaque(offy + (unsigned)(ai * 128 + m * 16) * (unsigned)(DM * 4));
#pragma unroll
                for (int bj = 0; bj < 2; ++bj) {
                    const u32x4 x8 = xv[m][bj]; const float r = rr[m];
                    f32x4 x0, x1; x0[0] = bflo(x8.x); x0[1] = bfhi(x8.x); x0[2] = bflo(x8.y); x0[3] = bfhi(x8.y); x1[0] = bflo(x8.z); x1[1] = bfhi(x8.z); x1[2] = bflo(x8.w); x1[3] = bfhi(x8.w);
                    *(f32x4*)(ob + o + bj * 512) = x0 * r * ig[bj][0] + acc[ai][bj][m][0];
                    *(f32x4*)(ob + o + bj * 512 + 16) = x1 * r * ig[bj][1] + acc[ai][bj][m][1];
                } }
            asm volatile("" ::: "memory");
        }
    }
};

struct EpiNull {
    static constexpr bool PERM = true, HAS_MID = false, HAS_PRE = false; float* sink;
    __device__ __forceinline__ void operator()(AccRef acc, const pg8::Unit& u, int wr, int wc, int fr, int fq) const {
        f32x4 s = (f32x4){0.f, 0.f, 0.f, 0.f};
#pragma unroll
        for (int ai = 0; ai < 2; ++ai)
#pragma unroll
            for (int bj = 0; bj < 2; ++bj)
#pragma unroll
                for (int m = 0; m < 4; ++m)
#pragma unroll
                    for (int n = 0; n < 2; ++n) s += acc[ai][bj][m][n];
        if (s[0] + s[1] + s[2] + s[3] == 12345.678f) sink[fr] = s[0];
    }
};

#define XB_TMO      128
#define XB_XCNT(j)  (256  + 64 * (j))
#define XB_XSUB(j)  (1280 + 64 * (j))
#define XB_XGEN(j)  (2304 + 64 * (j))
#define XB_TOP      3328
#define XB_TOPGEN   3392
#define XCD_BAR_WORDS 3456
#define XB_SPIN_CAP (1u << 18)
__device__ __forceinline__ unsigned xb_ld(unsigned* p)              { return __hip_atomic_load(p, __ATOMIC_RELAXED, __HIP_MEMORY_SCOPE_AGENT); }
__device__ __forceinline__ unsigned xb_add(unsigned* p, unsigned v) { return __hip_atomic_fetch_add(p, v, __ATOMIC_RELAXED, __HIP_MEMORY_SCOPE_AGENT); }
__device__ __forceinline__ unsigned xb_xcc_id() { return (unsigned)__builtin_amdgcn_s_getreg((3 << 11) | 20) & 0xFu; }
#define XB_SPIN(cond, bar) do { unsigned _sp = 0; while (cond) { __builtin_amdgcn_s_sleep(1); \
    if ((++_sp & 255u) == 0u) { if (xb_ld(&(bar)[XB_TMO])) break; if (_sp > XB_SPIN_CAP) { atomicAdd(&(bar)[XB_TMO], 1u); break; } } } } while (0)
struct XcdBarrier { unsigned* bar; unsigned x; volatile LAS unsigned* st; unsigned expect; };
__device__ __forceinline__ XcdBarrier xcd_barrier_post(unsigned* bar, volatile LAS unsigned* st, unsigned expect, bool leader) {
    XcdBarrier b; b.bar = bar; b.x = xb_xcc_id(); b.st = st; b.expect = expect;
    if (leader) (void)xb_add(&bar[XB_XCNT(b.x)], 1u);
    return b;
}
__device__ __forceinline__ void xcd_barrier_complete(unsigned* bar, unsigned x, unsigned G, unsigned& nloc, unsigned& nx) {
    unsigned sum, cnt, mine, sp = 0u;
    for (;;) {
        sum = 0u; cnt = 0u; mine = 0u;
#pragma unroll
        for (unsigned j = 0; j < 16; ++j) { const unsigned c = xb_ld(&bar[XB_XCNT(j)]); sum += c; cnt += (c > 0u) ? 1u : 0u; mine = (j == x) ? c : mine; }
        if (sum == G) break;
        __builtin_amdgcn_s_sleep(1);
        if ((++sp & 255u) == 0u) { if (xb_ld(&bar[XB_TMO])) break; if (sp > XB_SPIN_CAP) { atomicAdd(&bar[XB_TMO], 1u); break; } }
    }
    nloc = mine > 0u ? mine : 1u; nx = cnt > 0u ? cnt : 1u;
}
__device__ __forceinline__ void xcd_barrier(unsigned* bbar, unsigned bx, volatile LAS unsigned* bst, unsigned bexpect, bool leader) {
    struct { unsigned* bar; unsigned x; volatile LAS unsigned* st; unsigned expect; } b = {bbar, bx, bst, bexpect};
    asm volatile("s_waitcnt vmcnt(0)" ::: "memory");
    __syncthreads();
    if (leader) {
        unsigned* bar = b.bar;
        __builtin_amdgcn_s_waitcnt(0);
        unsigned nloc = b.st[0], nx = b.st[1];
        if (nloc == 0u) { xcd_barrier_complete(bar, b.x, b.expect, nloc, nx); b.st[0] = nloc; b.st[1] = nx; }
        const unsigned old = xb_add(&bar[XB_XSUB(b.x)], 1u);
        const unsigned gen = old / nloc;
        if (old + 1u == (gen + 1u) * nloc) {
            __builtin_amdgcn_fence(__ATOMIC_RELEASE, "agent");
            asm volatile("s_waitcnt vmcnt(0)" ::: "memory");
            const unsigned og = xb_add(&bar[XB_TOP], 1u);
            const unsigned tg = og / nx;
            if (og + 1u == (tg + 1u) * nx) xb_add(&bar[XB_TOPGEN], 1u);
            else XB_SPIN(xb_ld(&bar[XB_TOPGEN]) == tg, bar);
            __builtin_amdgcn_fence(__ATOMIC_ACQUIRE, "agent");
            xb_add(&bar[XB_XGEN(b.x)], 1u);
            asm volatile("s_waitcnt vmcnt(0)" ::: "memory");
        } else {
            XB_SPIN(xb_ld(&bar[XB_XGEN(b.x)]) == gen, bar);
            __builtin_amdgcn_fence(__ATOMIC_ACQUIRE, "agent");
            asm volatile("s_waitcnt vmcnt(0)" ::: "memory");
        }
    }
    __syncthreads();
}

__device__ __forceinline__ void xcd_stagger(unsigned xcc, unsigned ticks_per_step) {
    const unsigned long long t0 = __builtin_amdgcn_s_memrealtime(), want = (unsigned long long)((xcc & 3u) * ticks_per_step);
    while (__builtin_amdgcn_s_memrealtime() - t0 < want) __builtin_amdgcn_s_sleep(16);
}

struct Args {
    const float* in[25]; float* out; unsigned char* ws; int ph_lo, ph_hi;
};
typedef const __attribute__((address_space(4))) Args* KArgs;
__device__ __forceinline__ KArgs kargs_fresh() { KArgs p = (KArgs)__builtin_amdgcn_kernarg_segment_ptr(); asm volatile("" : "+s"(p)); return p; }
struct Frame {
    LAS unsigned char* lds; int tid, lane, wave;
    float* out; unsigned char* ws;
};
__device__ __forceinline__ float wave_sum(float v) {
#pragma unroll
    for (int o = 1; o < 64; o <<= 1) v += __shfl_xor(v, o);
    return v;
}

template <bool SIGMA>
__device__ __forceinline__ void p0_transpose_item(const float* W, int N, bf16_t* WT, int ldk, int koff, LAS float* scr, int item, int lane, unsigned char* WT8 = nullptr, int ldk8 = 0) {
    const int nblk = N / 32, kb = item / nblk, nb = item % nblk, k0 = 64 * kb, n0 = 32 * nb;
#pragma unroll 8
    for (int i = 0; i < 32; ++i) { const int kk = 2 * i + (lane >> 5); scr[kk * 33 + (lane & 31)] = W[(size_t)(k0 + kk) * N + n0 + (lane & 31)]; }
    asm volatile("s_waitcnt lgkmcnt(0)" ::: "memory");
    const int c = lane & 7;
#pragma unroll
    for (int j = 0; j < 4; ++j) { const int n = (lane >> 3) + 8 * j; const LAS float* s = scr + (8 * c) * 33 + n;
        const float sc = (SIGMA && n0 + n >= 4352) ? -LOG2E : 1.0f;
        u32x4 o; o.x = cvt_pk_bf16(s[0 * 33] * sc, s[1 * 33] * sc); o.y = cvt_pk_bf16(s[2 * 33] * sc, s[3 * 33] * sc); o.z = cvt_pk_bf16(s[4 * 33] * sc, s[5 * 33] * sc); o.w = cvt_pk_bf16(s[6 * 33] * sc, s[7 * 33] * sc);
        int nl = n0 + n;
        if (SIGMA) { if (nl >= 4352) { const int c_ = (nl - 4352) & 2047, gate_ = (nl - 4352) >> 11; nl = (17 + (c_ >> 7)) * 256 + 128 * gate_ + (c_ & 127); }
            else { const int lc = nl & 255, wcc = lc >> 6, bjj = (lc >> 5) & 1, jj = lc & 31; nl = (nl & ~255) + 128 * bjj + 32 * wcc + jj; } }
        *(u32x4*)(WT + (size_t)nl * ldk + koff + k0 + 8 * c) = o;
        if (SIGMA) { if (n0 >= 3328 || (n0 >= 1024 && n0 < 3072)) { const int nl8 = n0 >= 3072 ? nl - 3328 + 2048 : nl - 1024; u32x2 o8; o8.x = pk4_fp8(s[0 * 33] * (sc * F8_W), s[1 * 33] * (sc * F8_W), s[2 * 33] * (sc * F8_W), s[3 * 33] * (sc * F8_W)); o8.y = pk4_fp8(s[4 * 33] * (sc * F8_W), s[5 * 33] * (sc * F8_W), s[6 * 33] * (sc * F8_W), s[7 * 33] * (sc * F8_W));
            *(u32x2*)(WT8 + (size_t)nl8 * ldk8 + koff + k0 + 8 * c) = o8; } }
        else if (WT8) { u32x2 o8; o8.x = pk4_fp8(s[0 * 33] * F8_W, s[1 * 33] * F8_W, s[2 * 33] * F8_W, s[3 * 33] * F8_W); o8.y = pk4_fp8(s[4 * 33] * F8_W, s[5 * 33] * F8_W, s[6 * 33] * F8_W, s[7 * 33] * F8_W);
            *(u32x2*)(WT8 + (size_t)nl * ldk8 + koff + k0 + 8 * c) = o8; } }
    asm volatile("s_waitcnt lgkmcnt(0)" ::: "memory");
}
__device__ __forceinline__ void p0_norm_row(const float* xrow, const f32x4 (&gv)[8], bf16_t* orow, unsigned char* orow8, float* rs, int lane) {
    const f32x4* xr = (const f32x4*)xrow + lane;
    f32x4 v[8]; float s = 0.f;
#pragma unroll
    for (int j = 0; j < 8; ++j) { v[j] = __builtin_nontemporal_load(xr + 64 * j); s += (v[j][0] * v[j][0] + v[j][1] * v[j][1]) + (v[j][2] * v[j][2] + v[j][3] * v[j][3]); }
    const float rms = sqrtf(wave_sum(s) * (1.0f / DM) + EPSN), rstd = 1.0f / rms;
    if (rs && lane == 0) *rs = rms;
    u32x2* o8 = (u32x2*)orow + lane;
#pragma unroll
    for (int j = 0; j < 8; ++j) { const f32x4 y = v[j] * rstd * gv[j]; u32x2 w; w.x = cvt_pk_bf16(y[0], y[1]); w.y = cvt_pk_bf16(y[2], y[3]); o8[64 * j] = w;
        if (orow8) ((unsigned*)orow8)[lane + 64 * j] = pk4_fp8(y[0] * F8_X, y[1] * F8_X, y[2] * F8_X, y[3] * F8_X); }
}
template <int PARTS>
__device__ __forceinline__ void p0_prologue(Frame& F) {
    const KArgs ARp = kargs_fresh();
#define AR (*ARp)
    LAS float* scr = (LAS float*)(F.lds + F.wave * 16384);
    const float* w_in = ((const float*)(GAS1 const float*)AR.in[7]); const float* w_glu = ((const float*)(GAS1 const float*)AR.in[16]); const float* w_oa = ((const float*)(GAS1 const float*)AR.in[22]); const float* w_ob = ((const float*)(GAS1 const float*)AR.in[23]); const float* w_o = ((const float*)(GAS1 const float*)AR.in[24]);
    bf16_t* WIN = (bf16_t*)(F.ws + WS_WIN); bf16_t* WGLU = (bf16_t*)(F.ws + WS_WGLU); bf16_t* WOUT = (bf16_t*)(F.ws + WS_WOUT); bf16_t* WO = (bf16_t*)(F.ws + WS_WO);
    constexpr int I_IN = (DM / 64) * (NIN / 32), I_GLU = (1024 / 64) * (1024 / 32), I_OA = (1024 / 64) * (DM / 32), I_O = (DM / 64) * (DM / 32);
    (void)w_glu; (void)w_oa; (void)w_ob; (void)w_o; (void)WGLU; (void)WOUT; (void)WO; (void)I_GLU; (void)I_OA; (void)I_O;
    if (PARTS & 1) for (int it = ((int)blockIdx.x * 8 + F.wave); it < I_IN; it += ((int)gridDim.x * 8))
        p0_transpose_item<true>(w_in, NIN, WIN, LD2, 0, scr, it, F.lane, F.ws + WS_W8IN, LD8B);
    if (PARTS & 2) { f32x4 gv[8];
#pragma unroll
      for (int j = 0; j < 8; ++j) gv[j] = ((const f32x4*)((const float*)(GAS1 const float*)AR.in[6]))[F.lane + 64 * j];
      bf16_t* XN = (bf16_t*)(F.ws + WS_XN);
      for (int m = ((int)blockIdx.x * 8 + F.wave); m < MROWS; m += ((int)gridDim.x * 8)) {
          if (m < MP) p0_norm_row(((const float*)(GAS1 const float*)AR.in[0]) + (size_t)m * DM, gv, XN + (size_t)m * LD2, F.ws + WS_XN8 + (size_t)m * LD8B, (float*)(F.ws + WS_CONST + C_RS) + m, F.lane);
          else if (m < MP + MS) p0_norm_row(((const float*)(GAS1 const float*)AR.in[1]) + (size_t)(m - MP) * DM, gv, XN + (size_t)m * LD2, nullptr, nullptr, F.lane);
          else { u32x2* o8 = (u32x2*)(XN + (size_t)m * LD2) + F.lane;
#pragma unroll
              for (int j = 0; j < 8; ++j) o8[64 * j] = (u32x2){0u, 0u}; }
      } }
    const int gt = (PARTS & 4) ? blockIdx.x * 512 + F.tid : (1 << 30);
    if (gt < NGRP * NSTATE) {
        const int g = gt >> 6, p = gt & 63;
        const double are = (double)((const float*)(GAS1 const float*)AR.in[8])[gt], aim = (double)((const float*)(GAS1 const float*)AR.in[9])[gt], dt = exp((double)((const float*)(GAS1 const float*)AR.in[10])[g]);
        const double mag = exp(are * dt), ang = aim * dt, lre = mag * cos(ang), lim = mag * sin(ang);
        const double den = are * are + aim * aim, cr = ((lre - 1.0) * are + lim * aim) / den, ci = (lim * are - (lre - 1.0) * aim) / den;
        float* LAM = (float*)(F.ws + WS_CONST + C_LAM); float* LAM64 = (float*)(F.ws + WS_CONST + C_LAM64);
        LAM[2 * gt] = (float)lre; LAM[2 * gt + 1] = (float)lim;
        double pr = lre, pi = lim;
#pragma unroll 1
        for (int i = 0; i < 10; ++i) { const double nr = pr * pr - pi * pi, ni = 2.0 * pr * pi; pr = nr; pi = ni; }
        LAM64[2 * gt] = (float)pr; LAM64[2 * gt + 1] = (float)pi;
        bf16_t* BF = (bf16_t*)(F.ws + WS_CONST + C_BF); bf16_t* CF = (bf16_t*)(F.ws + WS_CONST + C_CF);
        const float* bre = ((const float*)(GAS1 const float*)AR.in[11]) + (size_t)gt * 16; const float* bim = ((const float*)(GAS1 const float*)AR.in[12]) + (size_t)gt * 16;
#pragma unroll 1
        for (int c = 0; c < 16; ++c) {
            const double br = (double)bre[c], bi = (double)bim[c];
            const float bbr = (float)(cr * br - ci * bi), bbi = (float)(cr * bi + ci * br);
            const int q = c >> 2, jj = c & 3;
            { const int row = p, pt = row >> 4, ps = row & 15; BF[((size_t)(g * 8 + pt) * 64 + 16 * q + ps) * 4 + jj] = (bf16_t)(cvt_pk_bf16(bbr, 0.f) & 0xffffu); }
            { const int row = 64 + p, pt = row >> 4, ps = row & 15; BF[((size_t)(g * 8 + pt) * 64 + 16 * q + ps) * 4 + jj] = (bf16_t)(cvt_pk_bf16(bbi, 0.f) & 0xffffu); }
            const float cre = ((const float*)(GAS1 const float*)AR.in[13])[(size_t)(g * 16 + c) * 64 + p], cim = ((const float*)(GAS1 const float*)AR.in[14])[(size_t)(g * 16 + c) * 64 + p];
            const int ks = p >> 4, qq = (p >> 2) & 3, jb = 2 * (p & 3);
            CF[((size_t)(g * 4 + ks) * 64 + 16 * qq + c) * 8 + jb] = (bf16_t)(cvt_pk_bf16(cre, 0.f) & 0xffffu);
            CF[((size_t)(g * 4 + ks) * 64 + 16 * qq + c) * 8 + jb + 1] = (bf16_t)(cvt_pk_bf16(-cim, 0.f) & 0xffffu);
        }
    }
    if (gt < 16 * 256) {
        const int h = gt >> 8, idx = gt & 255; float v = 0.f;
        if (idx < 255) { const int rel = idx - 191; int n = -rel; const int ret = n < 0 ? 16 : 0; n = n < 0 ? -n : n;
            const int large = 8 + (n >= 12) + (n >= 16) + (n >= 23) + (n >= 32) + (n >= 46) + (n >= 64) + (n >= 91);
            const int bucket = ret + (n < 8 ? n : large); v = ((const float*)(GAS1 const float*)AR.in[21])[bucket * 16 + h] * LOG2E; }
        ((float*)(F.ws + WS_CONST + C_BT))[gt] = v;
    }
}

#undef AR
__device__ __forceinline__ void p1_late_weights(Frame& F, int rank, int nrank) {
    const KArgs ARp = kargs_fresh();
    LAS float* scr = (LAS float*)(F.lds + F.wave * 16384);
    const float* w_glu = (const float*)(GAS1 const float*)ARp->in[16]; const float* w_oa = (const float*)(GAS1 const float*)ARp->in[22];
    const float* w_ob = (const float*)(GAS1 const float*)ARp->in[23]; const float* w_o = (const float*)(GAS1 const float*)ARp->in[24];
    bf16_t* WGLU = (bf16_t*)(F.ws + WS_WGLU); bf16_t* WOUT = (bf16_t*)(F.ws + WS_WOUT); bf16_t* WO = (bf16_t*)(F.ws + WS_WO);
    constexpr int I_GLU = (1024 / 64) * (1024 / 32), I_OA = (1024 / 64) * (DM / 32), I_O = (DM / 64) * (DM / 32);
    for (int it = rank * 8 + F.wave; it < I_GLU + 2 * I_OA + I_O; it += nrank * 8) {
        int r = it;
        if (r < I_GLU) { p0_transpose_item<false>(w_glu, 1024, WGLU, LD1, 0, scr, r, F.lane, F.ws + WS_W8GLU, LD8A); continue; } r -= I_GLU;
        if (r < I_OA) { p0_transpose_item<false>(w_oa, DM, WOUT, LD2, 0, scr, r, F.lane, F.ws + WS_W8OUT, LD8B); continue; } r -= I_OA;
        if (r < I_OA) { p0_transpose_item<false>(w_ob, DM, WOUT, LD2, 1024, scr, r, F.lane, F.ws + WS_W8OUT, LD8B); continue; } r -= I_OA;
        p0_transpose_item<false>(w_o, DM, WO, LD2, 0, scr, r, F.lane, F.ws + WS_W8O, LD8B);
    }
}

constexpr int SSM_UROW = 272, SSM_UT = 64 * SSM_UROW, SSM_BU = 128 * 80, SSM_HC = 16 * 272;
template <bool FULL>
__device__ __forceinline__ void ssm_unit(Frame& F, const float* ssm_d, const bf16_t* U, bf16_t* Uo, int rowbase, int T, int gs, const float* hin_re, const float* hin_im, float* hout_re, float* hout_im) {
    LAS unsigned char* ut = F.lds;
    LAS unsigned char* bu = F.lds + SSM_UT + F.wave * SSM_BU;
    LAS unsigned char* hc = F.lds + SSM_UT + 8 * SSM_BU + F.wave * SSM_HC;
    const int lane = F.lane, w = F.wave, fr = lane & 15, fq = lane >> 4, g = gs * 8 + w;
#pragma unroll
    for (int i = 0; i < 2; ++i) { const int idx = F.tid + 512 * i, row = idx >> 4, ch = idx & 15;
        u32x4 v = (u32x4){0u, 0u, 0u, 0u};
        if (row < T) v = *(const u32x4*)(U + (size_t)(rowbase + row) * LD1 + gs * 128 + ch * 8);
        *(LAS u32x4*)(ut + row * SSM_UROW + ch * 16) = v; }
    const f32x2 lam = ((const f32x2*)(F.ws + WS_CONST + C_LAM))[g * 64 + lane];
    u32x2 bfr[8];
#pragma unroll
    for (int pt = 0; pt < 8; ++pt) bfr[pt] = ((const u32x2*)(F.ws + WS_CONST + C_BF))[(size_t)(g * 8 + pt) * 64 + lane];
    u32x4 cfr[4]; float dsk = 0.f;
    if (FULL) {
#pragma unroll
        for (int ks = 0; ks < 4; ++ks) cfr[ks] = ((const u32x4*)(F.ws + WS_CONST + C_CF))[(size_t)(g * 4 + ks) * 64 + lane];
        dsk = ssm_d[g * 16 + fr];
    }
    float hre = 0.f, him = 0.f;
    if (FULL && hin_re) { hre = hin_re[lane]; him = hin_im[lane]; }
    __syncthreads();
    const int nsb = T >> 4;
    for (int sb = 0; sb < nsb; ++sb) {
        const s16x4 af = __builtin_bit_cast(s16x4, *(const LAS u32x2*)(ut + (16 * sb + fr) * SSM_UROW + w * 32 + fq * 8));
#pragma unroll
        for (int pt = 0; pt < 8; ++pt) {
            const f32x4 d = __builtin_amdgcn_mfma_f32_16x16x16bf16_1k(af, __builtin_bit_cast(s16x4, bfr[pt]), (f32x4){0.f, 0.f, 0.f, 0.f}, 0, 0, 0);
            *(LAS f32x4*)(bu + (16 * pt + fr) * 80 + fq * 16) = d;
        }
        asm volatile("s_waitcnt lgkmcnt(0)" ::: "memory");
        f32x4 br[4], bi[4];
#pragma unroll
        for (int k = 0; k < 4; ++k) { br[k] = *(const LAS f32x4*)(bu + lane * 80 + k * 16); bi[k] = *(const LAS f32x4*)(bu + (64 + lane) * 80 + k * 16); }
#pragma unroll
        for (int t = 0; t < 16; ++t) {
            const float nre = lam.x * hre - lam.y * him + br[t >> 2][t & 3];
            const float nim = lam.x * him + lam.y * hre + bi[t >> 2][t & 3];
            hre = nre; him = nim;
            if (FULL) *(LAS unsigned*)(hc + t * 272 + lane * 4) = cvt_pk_bf16(hre, him);
        }
        if (FULL) {
            asm volatile("s_waitcnt lgkmcnt(0)" ::: "memory");
            f32x4 y = (f32x4){0.f, 0.f, 0.f, 0.f};
#pragma unroll
            for (int ks = 0; ks < 4; ++ks) {
                const bf16x8 a = *(const LAS bf16x8*)(hc + fr * 272 + ks * 64 + fq * 16);
                y = __builtin_amdgcn_mfma_f32_16x16x32_bf16(a, __builtin_bit_cast(bf16x8, cfr[ks]), y, 0, 0, 0);
            }
#pragma unroll
            for (int r = 0; r < 4; ++r) {
                LAS unsigned short* up = (LAS unsigned short*)(ut + (16 * sb + 4 * fq + r) * SSM_UROW + w * 32 + fr * 2);
                const float uv = bf2f(*up);
                *up = (unsigned short)(cvt_pk_bf16(geluf_(y[r] + dsk * uv), 0.f) & 0xffffu);
            }
            asm volatile("s_waitcnt lgkmcnt(0)" ::: "memory");
        }
    }
    if (hout_re) { hout_re[lane] = hre; hout_im[lane] = him; }
    if (FULL) {
        __syncthreads();
#pragma unroll
        for (int i = 0; i < 2; ++i) { const int idx = F.tid + 512 * i, row = idx >> 4, ch = idx & 15;
            if (row < T) *(u32x4*)(Uo + (size_t)(rowbase + row) * LD1 + gs * 128 + ch * 8) = *(const LAS u32x4*)(ut + row * SSM_UROW + ch * 16); }
    }
    __syncthreads();
}

template <bool FULL, int VAR = 0>
__device__ __forceinline__ void ssm_phase(Frame& F, const float* ssm_d, const bf16_t* U, bf16_t* Uo, float* Sseg, float* outre, float* outim, unsigned char* G8) {
    LAS unsigned char* ut = F.lds;
    LAS unsigned char* bu = F.lds + SSM_UT + F.wave * SSM_BU;
    LAS unsigned char* hc = F.lds + SSM_UT + 8 * SSM_BU + F.wave * SSM_HC;
    const int lane = F.lane, w = F.wave, fr = lane & 15, fq = lane >> 4;
    const int trow = F.tid >> 4, tch = F.tid & 15;
    for (int item = blockIdx.x; item < NBATCH * 4 * 8; item += ((int)gridDim.x)) {
        const int gs = item & 7, bs = item >> 3, b = bs >> 2, seg = bs & 3, g = gs * 8 + w;
        if (!FULL && seg == 3) continue;
        const f32x2 lam = ((const f32x2*)(F.ws + WS_CONST + C_LAM))[g * 64 + lane];
        u32x2 bfr[8];
#pragma unroll
        for (int pt = 0; pt < 8; ++pt) bfr[pt] = ((const u32x2*)(F.ws + WS_CONST + C_BF))[(size_t)(g * 8 + pt) * 64 + lane];
        u32x4 cfr[4]; float dsk = 0.f;
        float hre = 0.f, him = 0.f;
        if (FULL) {
#pragma unroll
            for (int ks = 0; ks < 4; ++ks) cfr[ks] = ((const u32x4*)(F.ws + WS_CONST + C_CF))[(size_t)(g * 4 + ks) * 64 + lane];
            dsk = ssm_d[g * 16 + fr];
            const f32x2 lk = ((const f32x2*)(F.ws + WS_CONST + C_LAM64))[g * 64 + lane];
            for (int sp = 0; sp < seg; ++sp) { const float* sp_ = Sseg + ((size_t)((b * 4 + sp) * NGRP + g)) * 128 + lane; const float sre = sp_[0], sim = sp_[64];
                const float nre = lk.x * hre - lk.y * him + sre, nim = lk.x * him + lk.y * hre + sim; hre = nre; him = nim; }
        }
        f32x2 hh = {hre, him}; const f32x2 lrr = {lam.x, lam.x}, lix = {-lam.y, lam.y};
        const int bj0 = b * 64 + seg * 16;
        u32x4 pre0, pre1;
        { const bf16_t* up = U + (size_t)(bj0 * 64 + trow) * LD1 + gs * 128 + tch * 8; pre0 = *(const u32x4*)up; pre1 = *(const u32x4*)(up + (size_t)32 * LD1); }
        for (int k = 0; k < 16; ++k) {
            const int bj = bj0 + k;
            *(LAS u32x4*)(ut + trow * SSM_UROW + tch * 16) = pre0;
            *(LAS u32x4*)(ut + (trow + 32) * SSM_UROW + tch * 16) = pre1;
            __syncthreads();
            if (k < 15) { const bf16_t* up = U + (size_t)((bj + 1) * 64 + trow) * LD1 + gs * 128 + tch * 8; pre0 = *(const u32x4*)up; pre1 = *(const u32x4*)(up + (size_t)32 * LD1); }
            u32x4 za0 = (u32x4){0u, 0u, 0u, 0u}, za1 = za0;
            if (FULL) { const bf16_t* zp = U + (size_t)(WS_ZA - WS_U) / 2 + (size_t)(bj * 64 + trow) * LD1 + gs * 128 + tch * 8; za0 = *(const u32x4*)zp; za1 = *(const u32x4*)(zp + (size_t)32 * LD1); }
#define SSM_FENCE() asm volatile("" ::: "memory")
            f32x4 dA[8];
#define SSM_A_MFMA(sb_) do { const s16x4 af_ = __builtin_bit_cast(s16x4, *(const LAS u32x2*)(ut + (16 * (sb_) + fr) * SSM_UROW + w * 32 + fq * 8)); \
                _Pragma("unroll") for (int pt = 0; pt < 8; ++pt) dA[pt] = __builtin_amdgcn_mfma_f32_16x16x16bf16_1k(af_, __builtin_bit_cast(s16x4, bfr[pt]), (f32x4){0.f, 0.f, 0.f, 0.f}, 0, 0, 0); } while (0)
#define SSM_SWAP32(x_, y_) do { const auto r_ = __builtin_amdgcn_permlane32_swap(__float_as_uint(x_), __float_as_uint(y_), false, false); x_ = __uint_as_float(r_[0]); y_ = __uint_as_float(r_[1]); } while (0)
#define SSM_SWAP16(x_, y_) do { const auto r_ = __builtin_amdgcn_permlane16_swap(__float_as_uint(x_), __float_as_uint(y_), false, false); x_ = __uint_as_float(r_[0]); y_ = __uint_as_float(r_[1]); } while (0)
#define SSM_TRANSPOSE() do { _Pragma("unroll") for (int c_ = 0; c_ < 2; ++c_) _Pragma("unroll") for (int r_i = 0; r_i < 4; ++r_i) { \
                float x0 = dA[4 * c_][r_i], x1 = dA[4 * c_ + 1][r_i], x2 = dA[4 * c_ + 2][r_i], x3 = dA[4 * c_ + 3][r_i]; \
                SSM_SWAP32(x0, x2); SSM_SWAP32(x1, x3); SSM_SWAP16(x0, x1); SSM_SWAP16(x2, x3); \
                bN[4 * c_][r_i] = x0; bN[4 * c_ + 1][r_i] = x1; bN[4 * c_ + 2][r_i] = x2; bN[4 * c_ + 3][r_i] = x3; } } while (0)
            f32x4 bN[8];
            if (VAR != 5) {
            SSM_A_MFMA(0); SSM_TRANSPOSE();
            bf16x8 ca[4];
#pragma unroll
            for (int sb = 0; sb < 4; ++sb) {
                f32x4 bv[8];
#pragma unroll
                for (int kk = 0; kk < 8; ++kk) bv[kk] = bN[kk];
                if (FULL && sb > 0 && VAR != 6 && VAR != 7) {
#pragma unroll
                    for (int ks = 0; ks < 4; ++ks) ca[ks] = *(const LAS bf16x8*)(hc + fr * 272 + ks * 64 + fq * 16);
                }
                SSM_FENCE();
                if (sb < 3) SSM_A_MFMA(sb + 1);
                f32x4 y = (f32x4){0.f, 0.f, 0.f, 0.f};
                if (FULL && sb > 0 && VAR != 6 && VAR != 7) {
#pragma unroll
                    for (int ks = 0; ks < 4; ++ks) y = __builtin_amdgcn_mfma_f32_16x16x32_bf16(ca[ks], __builtin_bit_cast(bf16x8, cfr[ks]), y, 0, 0, 0);
                }
                SSM_FENCE();
#pragma unroll
                for (int t = 0; t < 16; ++t) {
                    const float bre_ = bv[t >> 2][t & 3], bim_ = bv[4 + (t >> 2)][t & 3];
                    if (VAR != 1) { const float nre_ = __builtin_fmaf(lrr.x, hh.x, __builtin_fmaf(lix.x, hh.y, bre_)), nim_ = __builtin_fmaf(lrr.x, hh.y, __builtin_fmaf(lix.y, hh.x, bim_));
                    hh.x = nre_; hh.y = nim_; } else { hh.x += bre_; hh.y += bim_ * 0.5f; }
                    if (FULL && VAR != 7) *(LAS unsigned*)(hc + t * 272 + lane * 4) = cvt_pk_bf16_nv(hh.x, hh.y);
                }
                SSM_FENCE();
                if (sb < 3) SSM_TRANSPOSE();
                if (FULL && sb > 0 && VAR != 6 && VAR != 7) {
#pragma unroll
                    for (int r = 0; r < 4; ++r) {
                        LAS unsigned short* up = (LAS unsigned short*)(ut + (16 * (sb - 1) + 4 * fq + r) * SSM_UROW + w * 32 + fr * 2);
                        const float uv = bf2f(*up);
                        *up = (unsigned short)(cvt_pk_bf16_nv((VAR == 2 ? (y[r] + dsk * uv) : geluf_(y[r] + dsk * uv)), 0.f) & 0xffffu);
                    }
                    SSM_FENCE();
                }
            }
            if (FULL && VAR != 6 && VAR != 7) {
                f32x4 y = (f32x4){0.f, 0.f, 0.f, 0.f};
#pragma unroll
                for (int ks = 0; ks < 4; ++ks) {
                    const bf16x8 a = *(const LAS bf16x8*)(hc + fr * 272 + ks * 64 + fq * 16);
                    y = __builtin_amdgcn_mfma_f32_16x16x32_bf16(a, __builtin_bit_cast(bf16x8, cfr[ks]), y, 0, 0, 0);
                }
#pragma unroll
                for (int r = 0; r < 4; ++r) {
                    LAS unsigned short* up = (LAS unsigned short*)(ut + (16 * 3 + 4 * fq + r) * SSM_UROW + w * 32 + fr * 2);
                    const float uv = bf2f(*up);
                    *up = (unsigned short)(cvt_pk_bf16_nv((VAR == 2 ? (y[r] + dsk * uv) : geluf_(y[r] + dsk * uv)), 0.f) & 0xffffu);
                }
                SSM_FENCE();
            }
            }
#undef SSM_A_MFMA
#undef SSM_TRANSPOSE
#undef SSM_SWAP32
#undef SSM_SWAP16
            if (FULL) {
                __syncthreads();
                bf16_t* op = Uo + (size_t)(bj * 64 + trow) * LD1 + gs * 128 + tch * 8;
                const u32x4 g0 = *(const LAS u32x4*)(ut + trow * SSM_UROW + tch * 16), g1 = *(const LAS u32x4*)(ut + (trow + 32) * SSM_UROW + tch * 16);
                { u32x4 z0, z1;
                  z0.x = cvt_pk_bf16(bflo(g0.x) * bflo(za0.x), bfhi(g0.x) * bfhi(za0.x)); z0.y = cvt_pk_bf16(bflo(g0.y) * bflo(za0.y), bfhi(g0.y) * bfhi(za0.y));
                  z0.z = cvt_pk_bf16(bflo(g0.z) * bflo(za0.z), bfhi(g0.z) * bfhi(za0.z)); z0.w = cvt_pk_bf16(bflo(g0.w) * bflo(za0.w), bfhi(g0.w) * bfhi(za0.w));
                  z1.x = cvt_pk_bf16(bflo(g1.x) * bflo(za1.x), bfhi(g1.x) * bfhi(za1.x)); z1.y = cvt_pk_bf16(bflo(g1.y) * bflo(za1.y), bfhi(g1.y) * bfhi(za1.y));
                  z1.z = cvt_pk_bf16(bflo(g1.z) * bflo(za1.z), bfhi(g1.z) * bfhi(za1.z)); z1.w = cvt_pk_bf16(bflo(g1.w) * bflo(za1.w), bfhi(g1.w) * bfhi(za1.w));
                  *(u32x4*)op = z0; *(u32x4*)(op + (size_t)32 * LD1) = z1; }
                unsigned char* o8 = G8 + (size_t)(bj * 64 + trow) * LD8A + gs * 128 + tch * 8;
                u32x2 e0, e1;
                e0.x = pk4_fp8(bflo(g0.x) * F8_G, bfhi(g0.x) * F8_G, bflo(g0.y) * F8_G, bfhi(g0.y) * F8_G); e0.y = pk4_fp8(bflo(g0.z) * F8_G, bfhi(g0.z) * F8_G, bflo(g0.w) * F8_G, bfhi(g0.w) * F8_G);
                e1.x = pk4_fp8(bflo(g1.x) * F8_G, bfhi(g1.x) * F8_G, bflo(g1.y) * F8_G, bfhi(g1.y) * F8_G); e1.y = pk4_fp8(bflo(g1.z) * F8_G, bfhi(g1.z) * F8_G, bflo(g1.w) * F8_G, bfhi(g1.w) * F8_G);
                *(u32x2*)o8 = e0; *(u32x2*)(o8 + (size_t)32 * LD8A) = e1;
            }
            __syncthreads();
        }
        if (!FULL) { float* so = Sseg + ((size_t)((b * 4 + seg) * NGRP + g)) * 128 + lane; so[0] = hh.x; so[64] = hh.y; }
        if (FULL && seg == 3) { outre[(size_t)(b * 64 + g) * 64 + lane] = hh.x; outim[(size_t)(b * 64 + g) * 64 + lane] = hh.y; }
    }
}

constexpr int AT_K = 0, AT_V = 24576, AT_BT = 49152, AT_BTC = 8192 + 64, AT_OST = AT_BT + 4 * AT_BTC;
__device__ __forceinline__ int crow(int r, int hi) { return (r & 3) + 8 * (r >> 2) + 4 * hi; }
struct AttnUnit {
    int kvrow[3];
    const float* ck; const float* cv;
    int nkeys[3];
    int qrow0, nq, kvh;
};
__device__ __forceinline__ void attn_unit(Frame& F, const float* sinks, const float* qgain, const float* kgain, const AttnUnit& A, bf16_t* Q, unsigned char* BR8, const bf16_t* Kb, const bf16_t* Vb, const bf16_t* ZB) {
    const int lane = F.lane, w = F.wave, r32 = lane & 31, hi = lane >> 5, h = A.kvh * 8 + w;
    LAS unsigned char* lds = F.lds;
    bf16x8 qr[4];
    { const bf16_t* Qw = Q + (size_t)(A.qrow0 + r32) * LD1 + h * 64;
#pragma unroll
      for (int d0 = 0; d0 < 4; ++d0) qr[d0] = *(const bf16x8*)(Qw + d0 * 16 + hi * 8); }
#pragma unroll
    for (int s = 0; s < 3; ++s) {
        if (A.nkeys[s] == 0) continue;
        u32x4 kw = (u32x4){0u, 0u, 0u, 0u}, vw = (u32x4){0u, 0u, 0u, 0u};
        const int vrow = 16 * (w & 3) + (lane >> 2);
        if (A.kvrow[s] >= 0) {
            const size_t krow = (size_t)A.kvrow[s];
            if (lane < A.nkeys[s]) kw = *(const u32x4*)(Kb + (krow + lane) * 128 + A.kvh * 64 + w * 8);
            if (vrow < A.nkeys[s]) vw = *(const u32x4*)(Vb + (krow + vrow) * 128 + A.kvh * 64 + (w >> 2) * 32 + (lane & 3) * 8);
        } else {
            const float* kp = A.ck + ((size_t)(64 * s + lane) * 2 + A.kvh) * 64 + w * 8;
            const f32x4 k0 = *(const f32x4*)kp, k1 = *(const f32x4*)(kp + 4); kw = pack8(k0, k1);
            const float* vp = A.cv + ((size_t)(64 * s + vrow) * 2 + A.kvh) * 64 + (w >> 2) * 32 + (lane & 3) * 8;
            const f32x4 v0 = *(const f32x4*)vp, v1 = *(const f32x4*)(vp + 4); vw = pack8(v0, v1);
        }
        *(LAS u32x4*)(lds + AT_K + s * 8192 + w * 1024 + lane * 16) = kw;
        *(LAS u32x4*)(lds + AT_V + s * 8192 + w * 1024 + lane * 16) = vw;
    }
#pragma unroll
    for (int i = 0; i < 4; ++i) { const int idx = F.tid + 512 * i; ((LAS float*)(lds + AT_BT))[idx] = ((const float*)(F.ws + WS_CONST + C_BT))[A.kvh * 2048 + idx]; }
    __syncthreads();
    const float sink = sinks[h] * LOG2E;
    LAS float* btw = (LAS float*)(lds + AT_BT) + w * 256;
    float mref;
    { float gq = fabsf(qgain[lane]), gk = fabsf(kgain[lane]), bm = fmaxf(fmaxf(btw[lane], btw[lane + 64]), fmaxf(btw[lane + 128], lane + 192 < 255 ? btw[lane + 192] : -INFINITY));
#pragma unroll
      for (int o_ = 1; o_ < 64; o_ <<= 1) { gq = fmaxf(gq, __shfl_xor(gq, o_)); gk = fmaxf(gk, __shfl_xor(gk, o_)); bm = fmaxf(bm, __shfl_xor(bm, o_)); }
      mref = fmaxf(sink, 8.0f * LOG2E * gq * gk * 1.0001f + bm); }
    asm volatile("s_waitcnt lgkmcnt(0)" ::: "memory");
    { float tv[4];
#pragma unroll
      for (int i = 0; i < 4; ++i) tv[i] = btw[lane + 64 * i] - mref;
      asm volatile("" ::: "memory");
#pragma unroll
      for (int i = 0; i < 4; ++i)
#pragma unroll
          for (int j = 0; j < 4; ++j) { const int pos = lane + 64 * i - j; if (pos >= 0) ((LAS float*)((LAS unsigned char*)btw + j * AT_BTC))[pos] = tv[i]; } }
    asm volatile("s_waitcnt lgkmcnt(0)" ::: "memory");
    const int sft = (3 - r32) & 3;
    const LAS float* bt = (const LAS float*)((const LAS unsigned char*)btw + sft * AT_BTC) + (63 - r32 + 4 * hi - sft);
    const float esink = __builtin_amdgcn_exp2f(sink - mref), oscale = (A.nq == 16) ? 1.0f : F8_BR;
    const int nqt = (A.nq + 31) >> 5;
    for (int qt = 0; qt < nqt; ++qt) {
        f32x16 p[6];
        const int qoff = 32 * qt + r32;
#pragma unroll
        for (int kt = 0; kt < 6; ++kt) {
            const int s = kt >> 1, nk = A.nkeys[s] - 32 * (kt & 1);
            if (nk <= 0) {
#pragma unroll
                for (int r = 0; r < 16; ++r) p[kt][r] = -INFINITY;
                continue;
            }
            f32x16 c;
#pragma unroll
            for (int g4 = 0; g4 < 4; ++g4) { const f32x4 bv4 = *(const LAS f32x4*)(bt + 32 * kt + 8 * g4 - 32 * qt);
                c[4 * g4] = bv4[0]; c[4 * g4 + 1] = bv4[1]; c[4 * g4 + 2] = bv4[2]; c[4 * g4 + 3] = bv4[3]; }
            const LAS unsigned char* kb = lds + AT_K + s * 8192 + hi * 1024 + r32 * 16 + (kt & 1) * 512;
#pragma unroll
            for (int d0 = 0; d0 < 4; ++d0) c = __builtin_amdgcn_mfma_f32_32x32x16_bf16(*(const LAS bf16x8*)(kb + d0 * 2048), qr[d0], c, 0, 0, 0);
            if (nk < 32) {
#pragma unroll
                for (int r = 0; r < 16; ++r) if (crow(r, hi) >= nk) c[r] = -INFINITY;
            }
            p[kt] = c;
        }
        if (qt + 1 < nqt) { const bf16_t* Qw = Q + (size_t)(A.qrow0 + 32 * (qt + 1) + r32) * LD1 + h * 64;
#pragma unroll
            for (int d0 = 0; d0 < 4; ++d0) qr[d0] = *(const bf16x8*)(Qw + d0 * 16 + hi * 8); }
        u32x4 zbv[4];
#pragma unroll
        for (int kt = 0; kt < 6; ++kt)
#pragma unroll
            for (int r = 0; r < 16; ++r) p[kt][r] = __builtin_amdgcn_exp2f(p[kt][r]);
        f32x16 o[2]; o[0] = (f32x16){}; o[1] = (f32x16){};
        f32x16 ls;
#pragma unroll
        for (int r = 0; r < 16; ++r) ls[r] = esink;
        const bf16x8 ones8 = (bf16x8){(short)0x3F80, (short)0x3F80, (short)0x3F80, (short)0x3F80, (short)0x3F80, (short)0x3F80, (short)0x3F80, (short)0x3F80};
        const int vb0 = ((lane >> 4) & 1) * 32 + (lane & 3) * 8 + (4 * hi + ((lane & 15) >> 2)) * 64;
#pragma unroll
        for (int kt = 0; kt < 6; ++kt) {
            const int s = kt >> 1;
            if (kt == 4) {
#pragma unroll
                for (int i = 0; i < 4; ++i) zbv[i] = *(const u32x4*)(ZB + (size_t)(A.qrow0 + 32 * qt + i * 8 + (lane >> 3)) * LD1 + h * 64 + (lane & 7) * 8); }
            if (A.nkeys[s] - 32 * (kt & 1) <= 0) continue;
#pragma unroll
            for (int ss = 0; ss < 2; ++ss) {
                u32x4 pw; pw.x = cvt_pk_bf16_b(p[kt][8 * ss + 0], p[kt][8 * ss + 1]); pw.y = cvt_pk_bf16_b(p[kt][8 * ss + 2], p[kt][8 * ss + 3]);
                pw.z = cvt_pk_bf16_b(p[kt][8 * ss + 4], p[kt][8 * ss + 5]); pw.w = cvt_pk_bf16_b(p[kt][8 * ss + 6], p[kt][8 * ss + 7]);
                const int ks = 2 * (kt & 1) + ss;
                ls = __builtin_amdgcn_mfma_f32_32x32x16_bf16(__builtin_bit_cast(bf16x8, pw), ones8, ls, 0, 0, 0);
#pragma unroll
                for (int d0 = 0; d0 < 2; ++d0) {
                    const LAS unsigned char* vp = lds + AT_V + s * 8192 + d0 * 4096 + ks * 1024 + vb0;
                    const s16x4 lo = __builtin_bit_cast(s16x4, __builtin_amdgcn_ds_read_tr16_b64_v4i16((LAS s16x4*)vp));
                    const s16x4 hi4 = __builtin_bit_cast(s16x4, __builtin_amdgcn_ds_read_tr16_b64_v4i16((LAS s16x4*)(vp + 512)));
                    const bf16x8 vf = (bf16x8){lo[0], lo[1], lo[2], lo[3], hi4[0], hi4[1], hi4[2], hi4[3]};
                    o[d0] = __builtin_amdgcn_mfma_f32_32x32x16_bf16(__builtin_bit_cast(bf16x8, pw), vf, o[d0], 0, 0, 0);
                }
            }
        }
        asm volatile("" ::: "memory");
        LAS bf16_t* stg = (LAS bf16_t*)(lds + AT_OST) + w * 2048;
#pragma unroll
        for (int r = 0; r < 16; ++r) { const int orow = crow(r, hi); const float rl = __builtin_amdgcn_rcpf(ls[r]) * oscale;
            const unsigned pk = cvt_pk_bf16(o[0][r] * rl, o[1][r] * rl);
            stg[orow * 64 + r32] = (bf16_t)(pk & 0xffffu); stg[orow * 64 + 32 + r32] = (bf16_t)(pk >> 16); }
        asm volatile("s_waitcnt lgkmcnt(0)" ::: "memory");
#pragma unroll
        for (int i = 0; i < 4; ++i) { const int row = i * 8 + (lane >> 3), ch = lane & 7;
            if (32 * qt + row < A.nq) {
                const size_t off = (size_t)(A.qrow0 + 32 * qt + row) * LD1 + h * 64 + ch * 8;
                const u32x4 ov = *(const LAS u32x4*)(stg + row * 64 + ch * 8), zv = zbv[i];
                if (A.nq == 16) {
                    u32x4 res; res.x = cvt_pk_bf16(bflo(ov.x) * bflo(zv.x), bfhi(ov.x) * bfhi(zv.x)); res.y = cvt_pk_bf16(bflo(ov.y) * bflo(zv.y), bfhi(ov.y) * bfhi(zv.y));
                    res.z = cvt_pk_bf16(bflo(ov.z) * bflo(zv.z), bfhi(ov.z) * bfhi(zv.z)); res.w = cvt_pk_bf16(bflo(ov.w) * bflo(zv.w), bfhi(ov.w) * bfhi(zv.w));
                    *(u32x4*)(Q + off) = res;
                } else {
                    u32x2 e; e.x = pk4_fp8(bflo(ov.x) * bflo(zv.x), bfhi(ov.x) * bfhi(zv.x), bflo(ov.y) * bflo(zv.y), bfhi(ov.y) * bfhi(zv.y));
                    e.y = pk4_fp8(bflo(ov.z) * bflo(zv.z), bfhi(ov.z) * bfhi(zv.z), bflo(ov.w) * bflo(zv.w), bfhi(ov.w) * bfhi(zv.w));
                    *(u32x2*)(BR8 + (size_t)(A.qrow0 + 32 * qt + row) * LD8B + 1024 + h * 64 + ch * 8) = e; } } }
        asm volatile("s_waitcnt lgkmcnt(0)" ::: "memory");
    }
    __syncthreads();
}

template <int MODE>
__device__ __forceinline__ void sample_gemm(Frame& F, const bf16_t* A, const bf16_t* A2, int lda, const bf16_t* Wt, int ldb, int K, int N,
                                            const bf16_t* P0, const bf16_t* P1, const float* PF, void* OUT, int it0, int itstep) {
    const int lane = F.lane, w = F.wave, fr = lane & 15, fq = lane >> 4;
    LAS float* red = (LAS float*)F.lds;
    const int kper = K / 8, nks = kper / 32;
    for (int it = it0; it < N / 16; it += itstep) {
        const int k0 = w * kper;
        const bf16_t* Ab = (MODE == 1 && w >= 4) ? A2 + (size_t)MP * lda + (k0 - 1024) : A + (size_t)MP * lda + k0;
        const bf16_t* Bb = Wt + (size_t)(16 * it + fr) * ldb + k0 + 8 * fq;
        f32x4 acc[8];
#pragma unroll
        for (int mt = 0; mt < 8; ++mt) acc[mt] = (f32x4){0.f, 0.f, 0.f, 0.f};
        for (int ks = 0; ks < nks; ++ks) {
            const bf16x8 bfrag = *(const bf16x8*)(Bb + ks * 32);
#pragma unroll
            for (int mt = 0; mt < 8; ++mt) {
                const bf16x8 afrag = *(const bf16x8*)(Ab + (size_t)(16 * mt + fr) * lda + ks * 32 + 8 * fq);
                acc[mt] = __builtin_amdgcn_mfma_f32_16x16x32_bf16(afrag, bfrag, acc[mt], 0, 0, 0);
            }
        }
#pragma unroll
        for (int mt = 0; mt < 8; ++mt)
#pragma unroll
            for (int r = 0; r < 4; ++r) red[((w * 8 + mt) * 4 + r) * 64 + lane] = acc[mt][r];
        __syncthreads();
#pragma unroll
        for (int r = 0; r < 4; ++r) {
            float sa = 0.f, sb = 0.f;
#pragma unroll
            for (int ww = 0; ww < 8; ++ww) { const float v = red[((ww * 8 + w) * 4 + r) * 64 + lane]; if (MODE == 1 && ww >= 4) sb += v; else sa += v; }
            const int row = 16 * w + 4 * fq + r, col = 16 * it + fr;
            if (MODE == 0) {
                const size_t o = (size_t)(MP + row) * LD1 + col;
                const float val = sa + PF[col];
                ((bf16_t*)OUT)[o] = (bf16_t)(cvt_pk_bf16(bf2f(P0[o]) * sigmoidf_(val) * bf2f(((const bf16_t*)OUT)[o]), 0.f) & 0xffffu);
            } else if (MODE == 1) {
                const size_t o = (size_t)(MP + row) * LD2 + col;
                const float v = (sa * bf2f(P0[o]) + sb) * bf2f(P1[o]);
                ((bf16_t*)OUT)[o] = (bf16_t)(cvt_pk_bf16(v, 0.f) & 0xffffu);
            } else {
                ((float*)OUT)[(size_t)row * DM + col] = PF[(size_t)row * DM + col] + sa;
            }
        }
        __syncthreads();
    }
}

__global__ void __launch_bounds__(512, 2) mk_fwd(Args args) {
    extern __shared__ __attribute__((aligned(16))) unsigned char lds_raw[];
    Frame F;
    F.lds = (LAS unsigned char*)lds_raw;
    F.wave = __builtin_amdgcn_readfirstlane((int)threadIdx.x >> 6); F.lane = lane_id_fresh(); F.tid = F.wave * 64 + F.lane;
#define LEADER (F.wave == 0 && lane_id_fresh() == 0)
#define REFRESH() do { F.lane = lane_id_fresh(); F.tid = F.wave * 64 + F.lane; } while (0)
    { const KArgs ka_ = kargs_fresh(); F.out = (float*)(GAS1 float*)ka_->out; F.ws = (unsigned char*)(GAS1 unsigned char*)ka_->ws; }
#if USE_CG_SYNC
    cg::grid_group grid = cg::this_grid();
#endif
#define WSB(off) (ws_fresh(F.ws) + (off))
#define XN ((bf16_t*)WSB(WS_XN))
#define U ((bf16_t*)WSB(WS_U))
#define ZA ((bf16_t*)WSB(WS_ZA))
#define Qb ((bf16_t*)WSB(WS_Q))
#define ZB ((bf16_t*)WSB(WS_ZB))
#define Kb ((bf16_t*)WSB(WS_K))
#define Vb ((bf16_t*)WSB(WS_V))
#define GA ((bf16_t*)WSB(WS_GA))
#define GB ((bf16_t*)WSB(WS_GB))
#define Sst ((float*)WSB(WS_S))
#define DUMMY ((bf16_t*)WSB(WS_DUMMY))
    int lo, hi; { const KArgs ka_ = kargs_fresh(); lo = ka_->ph_lo; hi = ka_->ph_hi; }
    volatile LAS unsigned* misc = (volatile LAS unsigned*)(F.lds + MISC_OFF);
    if (F.tid < 16) misc[F.tid] = 0u;
    __syncthreads();
#define X_BAR (XcdBarrier{(unsigned*)(WSB(WS_CTL)), xb_xcc_id(), misc, (unsigned)gridDim.x})
    if (hi - lo > 1) (void)xcd_barrier_post((unsigned*)(WSB(WS_CTL)), misc, (unsigned)gridDim.x, LEADER);
#ifndef PH_MASK
#define PH_MASK 0xff
#endif
#define IN(k) (((PH_MASK >> (k)) & 1) && lo <= (k) && (k) < hi)
#if USE_CG_SYNC
#define SEAM(k) do { if (IN(k) && IN((k) + 1)) { if ((k) == 0) grid.sync(); else xcd_barrier((unsigned*)(WSB(WS_CTL)), xb_xcc_id(), misc, (unsigned)gridDim.x, LEADER); } } while (0)
#else
#define SEAM(k) do { if (IN(k) && IN((k) + 1)) xcd_barrier((unsigned*)(WSB(WS_CTL)), xb_xcc_id(), misc, (unsigned)gridDim.x, LEADER); } while (0)
#endif

    if (IN(0) && PROBE == 20) { p0_prologue<7>(F); __syncthreads(); }
    if (IN(0) && PROBE == 23) { p0_prologue<1>(F); __syncthreads(); }
    if (IN(0)) p0_prologue<7>(F);
    SEAM(0);
    if (IN(1)) {
        {
            pg8::Gemm g{XN, XN, (const bf16_t*)(WSB(WS_WIN)), LD2, LD2, DM, 1 << 20, MROWS / 256, INB_TILES, 0, 0, 0};
            pg8::StaticOrder S; S.init(g.nM, g.nN, ((int)gridDim.x), (int)blockIdx.x, IN8_TILES, MP / 256, 1, 0, WGM_IN16);
            EpiIn E{U, ZA, Qb, ZB, Kb, Vb, GA, GB, ((const float*)(GAS1 const float*)(kargs_fresh()->in[18])), ((const float*)(GAS1 const float*)(kargs_fresh()->in[19])), F.out, false, 0};
            pg8::gemm_phase<EpiIn, true>(F.lds, g, S, E, F.wave);
        }
        {
            pg8::Gemm g{(const bf16_t*)(WSB(WS_XN8)), (const bf16_t*)(WSB(WS_XN8)), (const bf16_t*)(WSB(WS_W8IN)), LD8B / 2, LD8B / 2, 1024, 1 << 20, MP / 256, IN8_TILES, 0, 0, 0};
            pg8::StaticOrder S; S.init(g.nM, g.nN, ((int)gridDim.x), (int)blockIdx.x, 0, 0, 0, 0, WGM_IN8);
            EpiIn E{U, ZA, Qb, ZB, Kb, Vb, GA, GB, ((const float*)(GAS1 const float*)(kargs_fresh()->in[18])), ((const float*)(GAS1 const float*)(kargs_fresh()->in[19])), F.out, false, 17};
            pg8::gemm_phase8<EpiIn, true, E8_X, E8_W>(F.lds, g, S, E, F.wave);
        }
        {
            const int nunits = (MROWS / 256) * INB_TILES + IN8_TILES, G_ = (int)gridDim.x, full = nunits / G_, rem = nunits - full * G_;
            REFRESH();
            if (rem == 0) p1_late_weights(F, (int)blockIdx.x, G_);
            else if ((int)blockIdx.x >= rem) p1_late_weights(F, (int)blockIdx.x - rem, G_ - rem);
            __syncthreads();
        }
    }
    if (IN(1) && PROBE == 9) {
        pg8::Gemm g{XN, XN, (const bf16_t*)(WSB(WS_WIN)), LD2, LD2, DM, 1 << 20, MROWS / 256, NIN / 256, 0, 0, 0};
        pg8::StaticOrder S; S.init(g.nM, g.nN, ((int)gridDim.x), (int)blockIdx.x);
        EpiNull E{(float*)DUMMY};
        pg8::gemm_phase<EpiNull, true>(F.lds, g, S, E, F.wave);
    }
    SEAM(1);
    if (IN(2)) {
        REFRESH();
        if (PROBE == 21) ssm_phase<false>(F, ((const float*)(GAS1 const float*)(kargs_fresh()->in[15])), U, U, Sst, nullptr, nullptr, nullptr);
        ssm_phase<false>(F, ((const float*)(GAS1 const float*)(kargs_fresh()->in[15])), U, U, Sst, nullptr, nullptr, nullptr);
        for (int c2 = blockIdx.x; c2 < 256; c2 += ((int)gridDim.x)) if (((c2 >> 3) & 3) == 3) {
            const int gs = c2 & 7, b = c2 >> 5; const size_t so = (size_t)(b * 64 + gs * 8 + F.wave) * 64;
            ssm_unit<true>(F, ((const float*)(GAS1 const float*)(kargs_fresh()->in[15])), U, U, MP + 16 * b, 16, gs, ((const float*)(GAS1 const float*)(kargs_fresh()->in[4])) + so, ((const float*)(GAS1 const float*)(kargs_fresh()->in[5])) + so, F.out + O_SRE + so, F.out + O_SIM + so);
        }
        constexpr int NAU = NBATCH * NCHUNK * 2 + NBATCH * 2;
        int au0, austep, aulim;
        if (((int)gridDim.x) == 256) { const int c = blockIdx.x, bs = c >> 3;
            if ((bs & 3) == 3) { au0 = ((c >> 5) << 3) + (c & 7); austep = 64; aulim = ATT_S3 * 64; }
            else { au0 = ATT_S3 * 64 + ((((bs >> 2) * 3 + (bs & 3)) << 3) + (c & 7)); austep = 192; aulim = NAU; } }
        else { au0 = blockIdx.x; austep = ((int)gridDim.x); aulim = NAU; }
        for (int rep_ = (PROBE == 24 ? 0 : 1); rep_ < 2; ++rep_)
        for (int it = au0; it < aulim; it += austep) {
            if (rep_ == 0 && it >= NBATCH * NCHUNK * 2) continue;
            AttnUnit A;
            if (it < NBATCH * NCHUNK * 2) {
                const int kvh = it & 1, bc = it >> 1, c = bc & 63;
#pragma unroll
                for (int s = 0; s < 3; ++s) { const int cc = c - 2 + s; A.nkeys[s] = cc >= 0 ? 64 : 0; A.kvrow[s] = cc >= 0 ? (bc - 2 + s) * 64 : 0; }
                A.ck = nullptr; A.cv = nullptr; A.qrow0 = bc * 64; A.nq = 64; A.kvh = kvh;
            } else {
                const int r = it - NBATCH * NCHUNK * 2, kvh = r & 1, b = r >> 1;
                A.nkeys[0] = 64; A.nkeys[1] = 64; A.nkeys[2] = 16; A.kvrow[0] = -1; A.kvrow[1] = -1; A.kvrow[2] = MP + 16 * b;
                A.ck = ((const float*)(GAS1 const float*)(kargs_fresh()->in[2])) + (size_t)b * 128 * 128; A.cv = ((const float*)(GAS1 const float*)(kargs_fresh()->in[3])) + (size_t)b * 128 * 128; A.qrow0 = MP + 16 * b; A.nq = 16; A.kvh = kvh;
            }
            attn_unit(F, ((const float*)(GAS1 const float*)(kargs_fresh()->in[20])), ((const float*)(GAS1 const float*)(kargs_fresh()->in[18])), ((const float*)(GAS1 const float*)(kargs_fresh()->in[19])), A, Qb, WSB(WS_BR8), Kb, Vb, ZB);
        }
    }
    do { if (IN(2) && IN(4)) xcd_barrier((unsigned*)(WSB(WS_CTL)), xb_xcc_id(), misc, (unsigned)gridDim.x, LEADER); } while (0);
    if (IN(4)) {
        REFRESH();
        if (PROBE == 225) ssm_phase<true, 5>(F, ((const float*)(GAS1 const float*)(kargs_fresh()->in[15])), U, (bf16_t*)WSB(WS_MX8), Sst, F.out + O_PRE, F.out + O_PIM, WSB(WS_G8));
        if (PROBE == 226) ssm_phase<true, 6>(F, ((const float*)(GAS1 const float*)(kargs_fresh()->in[15])), U, (bf16_t*)WSB(WS_MX8), Sst, F.out + O_PRE, F.out + O_PIM, WSB(WS_G8));
        if (PROBE == 227) ssm_phase<true, 7>(F, ((const float*)(GAS1 const float*)(kargs_fresh()->in[15])), U, (bf16_t*)WSB(WS_MX8), Sst, F.out + O_PRE, F.out + O_PIM, WSB(WS_G8));
        if (PROBE == 228) ssm_phase<true, 8>(F, ((const float*)(GAS1 const float*)(kargs_fresh()->in[15])), U, (bf16_t*)WSB(WS_MX8), Sst, F.out + O_PRE, F.out + O_PIM, WSB(WS_G8));
        if (PROBE == 221) ssm_phase<true, 1>(F, ((const float*)(GAS1 const float*)(kargs_fresh()->in[15])), U, (bf16_t*)WSB(WS_MX8), Sst, F.out + O_PRE, F.out + O_PIM, WSB(WS_G8));
        if (PROBE == 222) ssm_phase<true, 2>(F, ((const float*)(GAS1 const float*)(kargs_fresh()->in[15])), U, (bf16_t*)WSB(WS_MX8), Sst, F.out + O_PRE, F.out + O_PIM, WSB(WS_G8));
        if (PROBE == 22) ssm_phase<true>(F, ((const float*)(GAS1 const float*)(kargs_fresh()->in[15])), U, (bf16_t*)WSB(WS_MX8), Sst, F.out + O_PRE, F.out + O_PIM, WSB(WS_G8));
        ssm_phase<true>(F, ((const float*)(GAS1 const float*)(kargs_fresh()->in[15])), U, U, Sst, F.out + O_PRE, F.out + O_PIM, WSB(WS_G8));
    }
    SEAM(4);
#define GSEAM(k) do { if (IN(k) && IN((k) + 1)) xcd_barrier((unsigned*)(WSB(WS_CTL)) + (1 + G_GRP) * XCD_BAR_WORDS, xb_xcc_id(), misc + 2, (unsigned)G_SIZE, LEADER); } while (0)
    const bool G_TWO = false;
    const int G_GRP = __builtin_amdgcn_readfirstlane(G_TWO ? ((int)(blockIdx.x >> 3) & 1) : 0), G_SIZE = __builtin_amdgcn_readfirstlane(G_TWO ? (int)(gridDim.x >> 1) : (int)gridDim.x);
    const int G_RANK = __builtin_amdgcn_readfirstlane(G_TWO ? (int)(((blockIdx.x >> 4) << 3) | (blockIdx.x & 7)) : (int)blockIdx.x);
    const int G_PM0 = __builtin_amdgcn_readfirstlane(G_TWO ? G_GRP * (MP / 512) : 0), G_NM = __builtin_amdgcn_readfirstlane(G_TWO ? MP / 512 : MP / 256);
    if (IN(5)) {
        REFRESH();
        if (IN(6)) (void)xcd_barrier_post((unsigned*)(WSB(WS_CTL)) + (1 + G_GRP) * XCD_BAR_WORDS, misc + 2, (unsigned)G_SIZE, LEADER);
        if (G_TWO && G_GRP == 1 && IN(4)) { const unsigned long long t0 = __builtin_amdgcn_s_memrealtime(); while (__builtin_amdgcn_s_memrealtime() - t0 < 0ull) __builtin_amdgcn_s_sleep(16); }
        if (G_GRP == 0) sample_gemm<0>(F, U, U, LD1, (const bf16_t*)(WSB(WS_WGLU)), LD1, 1024, 1024, U, nullptr, ((const float*)(GAS1 const float*)(kargs_fresh()->in[17])), ZA, G_RANK, G_SIZE);
        pg8::Gemm g{(const bf16_t*)(WSB(WS_G8)), (const bf16_t*)(WSB(WS_G8)), (const bf16_t*)(WSB(WS_W8GLU)), LD8A / 2, LD8A / 2, 512, 1 << 20, G_NM, 4, 0, E8_G, E8_W};
        pg8::StaticOrder S; S.init(g.nM, g.nN, G_SIZE, G_RANK, 0, 0, 0, G_PM0, WGM_P5);
        EpiGlu E{WSB(0), ((const float*)(GAS1 const float*)(kargs_fresh()->in[17]))};
        pg8::gemm_phase8<EpiGlu, true, E8_G, E8_W>(F.lds, g, S, E, F.wave);
    }
    GSEAM(5);
    if (IN(6)) {
        REFRESH();
        if (G_GRP == 0) sample_gemm<1>(F, ZA, Qb, LD1, (const bf16_t*)(WSB(WS_WOUT)), LD2, 2048, 2048, GA, GB, nullptr, XN, G_RANK, G_SIZE);
        pg8::Gemm g{(const bf16_t*)(WSB(WS_BR8)), (const bf16_t*)(WSB(WS_BR8)) + 512, (const bf16_t*)(WSB(WS_W8OUT)), LD8B / 2, LD8B / 2, 1024, 8, G_NM, 8, 0, E8_BR, E8_W};
        pg8::StaticOrder S; S.init(g.nM, g.nN, G_SIZE, G_RANK, 0, 0, 0, G_PM0, WGM_P67);
        EpiOut E{WSB(0)};
        pg8::gemm_phase8<EpiOut, true, E8_BR, E8_W>(F.lds, g, S, E, F.wave);
    }
    GSEAM(6);
    if (IN(7)) {
        REFRESH();
        if (G_GRP == 0) sample_gemm<2>(F, XN, XN, LD2, (const bf16_t*)(WSB(WS_WO)), LD2, 2048, 2048, nullptr, nullptr, ((const float*)(GAS1 const float*)(kargs_fresh()->in[1])), F.out + O_YS, G_RANK, G_SIZE);
        pg8::Gemm g{(const bf16_t*)(WSB(WS_MX8)), (const bf16_t*)(WSB(WS_MX8)), (const bf16_t*)(WSB(WS_W8O)), LD8B / 2, LD8B / 2, 1024, 1 << 20, G_NM, 8, 0, E8_MX, E8_W};
        pg8::StaticOrder S; S.init(g.nM, g.nN, G_SIZE, G_RANK, 0, 0, 0, G_PM0, WGM_P67);
        EpiRes E{WSB(0), ((const float*)(GAS1 const float*)(kargs_fresh()->in[6])), F.out};
        pg8::gemm_phase8<EpiRes, true, E8_MX, E8_W>(F.lds, g, S, E, F.wave);
    }
#undef GSEAM
#undef X_BAR
#undef LEADER
#undef REFRESH
#undef IN
#undef SEAM
#undef WSB
#undef XN
#undef U
#undef ZA
#undef Qb
#undef ZB
#undef Kb
#undef Vb
#undef GA
#undef GB
#undef Sst
#undef DUMMY
}

extern "C" void kernel_launch(void* const* d_in, const int* in_sizes, int n_in, void* d_out, int out_size, void* d_ws, size_t ws_size, hipStream_t stream) {
    static int grid = 0;
    if (grid == 0) {
        if (n_in != 25 || ws_size < WS_END) { fprintf(stderr, "kernel_launch: unexpected n_in %d / ws %zu\n", n_in, ws_size); grid = -1; return; }
        int dev = 0, cus = 0, per_cu = 0;
        hipGetDevice(&dev); hipDeviceGetAttribute(&cus, hipDeviceAttributeMultiprocessorCount, dev);
        hipFuncSetAttribute((const void*)mk_fwd, hipFuncAttributeMaxDynamicSharedMemorySize, LDS_BYTES);
        hipOccupancyMaxActiveBlocksPerMultiprocessor(&per_cu, (const void*)mk_fwd, 512, LDS_BYTES);
        if (per_cu < 1) { fprintf(stderr, "kernel_launch: occupancy query says %d blocks/CU\n", per_cu); per_cu = 1; }
        (void)hipGetLastError();
        grid = cus;
    }
    if (grid < 0) return;
    if (hipMemsetAsync((char*)d_ws + WS_CTL, 0, 65536, stream) != hipSuccess) { fprintf(stderr, "kernel_launch: memset of the barrier words failed\n"); return; }
    Args a{};
    for (int i = 0; i < 25; ++i) a.in[i] = (const float*)d_in[i];
    a.out = (float*)d_out; a.ws = (unsigned char*)d_ws;
    constexpr int NPH = 8;
    if (MK_N_LAUNCHES == 1) {
        a.ph_lo = 0; a.ph_hi = NPH;
        void* kargs[] = {&a};
        hipError_t e = hipLaunchCooperativeKernel((const void*)mk_fwd, dim3(grid), dim3(512), kargs, LDS_BYTES, stream);
        if (e != hipSuccess) fprintf(stderr, "cooperative launch failed: %s (grid %d)\n", hipGetErrorString(e), grid);
    } else {
        for (int p = 0; p < NPH; ++p) { a.ph_lo = p; a.ph_hi = p + 1; hipLaunchKernelGGL(mk_fwd, dim3(grid), dim3(512), LDS_BYTES, stream, a); }
    }
}
```

```cpp
#include <hip/hip_runtime.h>
#include <hip/hip_cooperative_groups.h>
#include <cstdio>
#include <cstdint>
namespace cg = cooperative_groups;

#ifndef ATT_S3
#define ATT_S3 7
#endif
#ifndef PROBE
#define PROBE 0
#endif
#ifndef USE_CG_SYNC
#define USE_CG_SYNC 0
#endif
#ifndef STAGGER
#define STAGGER 0
#endif
#ifndef WGM_IN16
#define WGM_IN16 4
#endif
#ifndef WGM_IN8
#define WGM_IN8 4
#endif
#ifndef WGM_P5
#define WGM_P5 4
#endif
#ifndef WGM_P67
#define WGM_P67 4
#endif
#ifndef MK_N_LAUNCHES
#define MK_N_LAUNCHES 1
#endif

#define LAS __attribute__((address_space(3)))
typedef unsigned short bf16_t;
typedef short bf16x8 __attribute__((ext_vector_type(8)));
typedef short s16x4 __attribute__((ext_vector_type(4)));
typedef float f32x4 __attribute__((ext_vector_type(4)));
typedef float f32x2 __attribute__((ext_vector_type(2)));
typedef float f32x16 __attribute__((ext_vector_type(16)));
typedef unsigned u32x4 __attribute__((ext_vector_type(4)));
typedef unsigned u32x2 __attribute__((ext_vector_type(2)));
typedef int v8i32 __attribute__((ext_vector_type(8)));
typedef int i32x4 __attribute__((ext_vector_type(4)));
typedef short bf16x16 __attribute__((ext_vector_type(16)));

constexpr int DM = 2048, SEQ = 4096, NBATCH = 8, MP = NBATCH * SEQ, MS = 128, MROWS = 33024;
constexpr int NIN = 8448, NCHUNK = 64, NGRP = 64, NSTATE = 64;
constexpr float EPSN = 1e-6f, LOG2E = 1.4426950408889634f, QSCALE = 0.125f * 1.4426950408889634f;
constexpr size_t O_YP = 0, O_YS = 67108864, O_PRE = 67371008, O_PIM = 67403776, O_PK = 67436544, O_PV = 67567616, O_SRE = 67698688, O_SIM = 67731456, O_SK = 67764224, O_SV = 67780608;
constexpr size_t MiB = 1u << 20;
constexpr int LD1 = 1024 + 64, LD2 = 2048 + 64;
constexpr size_t WS_CTL = 0, WS_WIN = 1 * MiB, WS_WGLU = 36 * MiB, WS_WOUT = 39 * MiB, WS_WO = 48 * MiB, WS_CONST = 57 * MiB, WS_XN = 58 * MiB, WS_U = 192 * MiB, WS_ZA = 261 * MiB,
                 WS_Q = 330 * MiB, WS_ZB = 399 * MiB, WS_K = 468 * MiB, WS_V = 477 * MiB, WS_GA = 486 * MiB, WS_GB = 620 * MiB, WS_S = 754 * MiB, WS_W8GLU = 755 * MiB, WS_W8OUT = 757 * MiB, WS_W8O = 762 * MiB,
                 WS_G8 = 767 * MiB, WS_BR8 = 804 * MiB, WS_MX8 = 873 * MiB, WS_XN8 = 873 * MiB  , WS_W8IN = 942 * MiB, WS_DUMMY = 873 * MiB, WS_END = 957 * MiB;
#ifndef FP8_ZB
#define FP8_ZB 1
#endif
constexpr int IN8_TILES = 28, INB_TILES = 5;
__host__ __device__ constexpr int in8_tile(int j) { return j < 8 ? 4 + j : 5 + j; }
constexpr int LD8A = 1024 + 128, LD8B = 2048 + 128;
constexpr float F8_W = 64.f, F8_G = 8.f, F8_BR = 16.f, F8_MX = 64.f, F8_X = 8.f;
constexpr int E8_W = (127 - 6) * 0x01010101, E8_G = (127 - 3) * 0x01010101, E8_BR = (127 - 4) * 0x01010101, E8_MX = (127 - 6) * 0x01010101, E8_X = (127 - 3) * 0x01010101;
constexpr size_t C_LAM = 0, C_LAM64 = 32768, C_BF = 65536, C_CF = 327680, C_BT = 589824, C_RS = 606208;
constexpr int LDS_BYTES = 163840, MISC_OFF = 163840 - 64, PRE_OFF = 131072;

typedef __bf16 bf16x2_t __attribute__((ext_vector_type(2)));
__device__ __forceinline__ unsigned cvt_pk_bf16(float lo, float hi) { const bf16x2_t r = __builtin_convertvector((f32x2){lo, hi}, bf16x2_t); return __builtin_bit_cast(unsigned, r); }
__device__ __forceinline__ unsigned cvt_pk_bf16_nv(float lo, float hi) { return cvt_pk_bf16(lo, hi); }
__device__ __forceinline__ unsigned cvt_pk_bf16_b(float lo, float hi) { const bf16x2_t r = __builtin_convertvector((f32x2){lo, hi}, bf16x2_t); return __builtin_bit_cast(unsigned, r); }
__device__ __forceinline__ unsigned pk4_fp8(float a, float b, float c, float d) {
    a = fminf(fmaxf(a, -448.f), 448.f); b = fminf(fmaxf(b, -448.f), 448.f); c = fminf(fmaxf(c, -448.f), 448.f); d = fminf(fmaxf(d, -448.f), 448.f);
    int w = __builtin_amdgcn_cvt_pk_fp8_f32(a, b, 0, false); w = __builtin_amdgcn_cvt_pk_fp8_f32(c, d, w, true); return (unsigned)w; }
__device__ __forceinline__ float bf2f(unsigned short b) { return __uint_as_float((unsigned)b << 16); }
__device__ __forceinline__ float bflo(unsigned w) { return __uint_as_float(w << 16); }
__device__ __forceinline__ float bfhi(unsigned w) { return __uint_as_float(w & 0xffff0000u); }
__device__ __forceinline__ float sigmoidf_(float x) { return __builtin_amdgcn_rcpf(1.0f + __builtin_amdgcn_exp2f(-LOG2E * x)); }
__device__ __forceinline__ float siluf_(float x) { return x * sigmoidf_(x); }
__device__ __forceinline__ float geluf_(float v) {
    const float av = fabsf(v), t = __builtin_amdgcn_rcpf(av * 0.2316418882f + 1.0f);
    float q = t * 0.5307027145f + (-0.7265760135f); q = q * t + 0.7107068705f; q = q * t + (-0.142248368f); q = q * t + 0.127414796f; q = q * t;
    const float e = __builtin_amdgcn_exp2f((v * v) * (-0.72134752044f));
    const float m = v * (q * e);
    return v < 0.f ? m : v - m;
}

#define GAS1 __attribute__((address_space(1)))
__device__ __forceinline__ unsigned char* ws_fresh(unsigned char* p) { GAS1 unsigned char* g = (GAS1 unsigned char*)p; asm volatile("" : "+s"(g)); return (unsigned char*)g; }
__device__ __forceinline__ int lane_id_fresh() { int l; asm volatile("v_mbcnt_lo_u32_b32 %0, -1, 0\n\tv_mbcnt_hi_u32_b32 %0, -1, %0" : "=v"(l)); return l; }
namespace pg8 {
constexpr int BM = 256, BK = 64, HALF = 128, HTB = HALF * BK * 2, STAGE_BYTES = 8 * HTB, NXCD = 8;
__host__ __device__ __forceinline__ int lds_byte(int r, int c) { const int st = (r >> 4) * 2 + (c >> 5), rr = r & 15, cc = c & 31, ob = rr * 64 + cc * 2; return st * 1024 + (ob ^ (((ob >> 9) & 1) << 5)); }
__host__ __device__ __forceinline__ void stage_rc(int b, int& R, int& C) { const int st = b / 1024, sb = b % 1024, swz = sb ^ (((sb >> 9) & 1) << 5); R = (st >> 1) * 16 + swz / 64; C = (st & 1) * 32 + (swz % 64) / 2; }
__host__ __device__ __forceinline__ int perm32(int rho) { const int n = rho >> 4, i = rho & 15; return 8 * (i >> 2) + 4 * n + (i & 3); }
struct Unit { int pm, pn; };
struct Gemm { const bf16_t* A; const bf16_t* A2; const bf16_t* Bt; int lda, ldb, K, ksplit, nM, nN, fold, scaleA, scaleB; };
struct StaticOrder {
    int nM, nN, nwg, G, c, nx, xpm, inmap, pm0, WGM;
    __device__ void init(int nM_, int nN_, int G_, int c_, int nx_ = 0, int xpm_ = 0, int inmap_ = 0, int pm0_ = 0, int wgm_ = 4) { nM = nM_; nN = nN_; nwg = nM * nN; G = G_; c = c_; nx = nx_; xpm = xpm_; inmap = inmap_; pm0 = pm0_; WGM = wgm_; }
    __device__ bool next(int i, Unit& u) const {
        const int L = i * G + c; if (L >= nwg) { if (L >= nwg + nx) return false; const int j = (int)(L - nwg); u.pm = xpm; u.pn = j < 8 ? 4 + j : 5 + j; return true; }
        int wgid = L; { const int q = nwg / NXCD, r = nwg % NXCD, xcd = wgid % NXCD, off = wgid / NXCD; wgid = (xcd < r ? xcd * (q + 1) : r * (q + 1) + (xcd - r) * q) + off; }
        const int nig = WGM * nN, gid = wgid / nig, fm = gid * WGM, gsz = (nM - fm) < WGM ? (nM - fm) : WGM;
        u.pm = pm0 + fm + ((wgid % nig) % gsz); u.pn = (wgid % nig) / gsz; if (inmap && u.pn >= 4) u.pn += 8; return true;
    }
};

template <class Epi, bool ALIGN_EPI>
__device__ __forceinline__ void gemm_phase(LAS unsigned char* lds, const Gemm g, const StaticOrder& S, const Epi& E, int wid_in) {
    const int wid = wid_in, lane = lane_id_fresh(), tid = wid * 64 + lane, wr = wid >> 2, wc = wid & 3, fr = lane & 15, fq = lane >> 4;
    const int K = g.K, nt = K / BK, lda = g.lda, ldb = g.ldb;
    unsigned voffA[2], voffB[2];
#pragma unroll
    for (int i = 0; i < 2; ++i) { int R, C; stage_rc(tid * 16 + i * 8192, R, C); const int Rb = Epi::PERM ? ((R & ~31) + perm32(R & 31)) : R;
        voffA[i] = (unsigned)(R * lda + C) * 2u; voffB[i] = (unsigned)(Rb * ldb + C) * 2u; }
    const size_t kstep = (size_t)(BK * 2);
    const size_t hstepA = (size_t)HALF * lda * 2, tstepA = 2 * hstepA;
    const size_t hstepB = (size_t)HALF * ldb * 2, tstepB = 2 * hstepB;
    const unsigned ldsw = (unsigned)wid * 1024u;
    const int aoff = lds_byte(wr * 64 + fr, fq * 8), boff = lds_byte(wc * 32 + fr, fq * 8);
    const char* Alo = (const char*)g.A; const char* Ahi = (const char*)g.A2 - (size_t)g.ksplit * kstep;
#define PG8_APAN(pm, t) (((t) < g.ksplit ? Alo : Ahi) + (size_t)(g.fold ? 0 : (pm)) * tstepA + (size_t)(t) * kstep)
#define PG8_SA(b, h) (((b) * 2 + (h)) * HTB)
#define PG8_SB(b, h) ((4 + (b) * 2 + (h)) * HTB)
#define PG8_STAGE(bufoff, gbase, voff) do { _Pragma("unroll") for (int _i = 0; _i < 2; ++_i) \
        __builtin_amdgcn_global_load_lds((const unsigned*)((const char*)(gbase) + (voff)[_i]), (LAS unsigned*)(lds + (bufoff) + ldsw + _i * 8192), 16, 0, 0); } while (0)
#define PG8_LDA(dst, b, h) do { _Pragma("unroll") for (int m = 0; m < 4; ++m) _Pragma("unroll") for (int k = 0; k < 2; ++k) dst[m][k] = *(const LAS bf16x8*)(lds + PG8_SA(b, h) + aoff + m * 2048 + k * 1024); } while (0)
#define PG8_LDB(dst, b, h) do { _Pragma("unroll") for (int n = 0; n < 2; ++n) _Pragma("unroll") for (int k = 0; k < 2; ++k) dst[n][k] = *(const LAS bf16x8*)(lds + PG8_SB(b, h) + boff + n * 2048 + k * 1024); } while (0)
#define PG8_MMA(ai, bj, At, Bt) do { __builtin_amdgcn_s_setprio(1); _Pragma("unroll") for (int m = 0; m < 4; ++m) _Pragma("unroll") for (int n = 0; n < 2; ++n) _Pragma("unroll") for (int k = 0; k < 2; ++k) \
        acc[ai][bj][m][n] = __builtin_amdgcn_mfma_f32_16x16x32_bf16(Bt[n][k], At[m][k], acc[ai][bj][m][n], 0, 0, 0); __builtin_amdgcn_s_setprio(0); } while (0)
#define PG8_WAIT_V(n) asm volatile("s_waitcnt vmcnt(" #n ")" ::: "memory")
#define PG8_WAIT_L(n) asm volatile("s_waitcnt lgkmcnt(" #n ")" ::: "memory")
#define PG8_BAR __builtin_amdgcn_s_barrier()
#define PG8_SCHED __builtin_amdgcn_sched_barrier(0)
    Unit cur, nxt; int ui = 0;
    if (!S.next(0, cur)) return;
    f32x4 acc[2][2][4][2];
#pragma unroll
    for (int a = 0; a < 2; ++a)
#pragma unroll
        for (int b = 0; b < 2; ++b)
#pragma unroll
            for (int m = 0; m < 4; ++m)
#pragma unroll
                for (int n = 0; n < 2; ++n) acc[a][b][m][n] = (f32x4){0.f, 0.f, 0.f, 0.f};
    bf16x8 At[4][2], B0[2][2], B1[2][2];
    const char* cA = PG8_APAN(cur.pm, 0); const char* cB = (const char*)g.Bt + (size_t)(g.fold ? 0 : cur.pn) * tstepB;
    PG8_STAGE(PG8_SB(0, 0), cB, voffB); PG8_STAGE(PG8_SB(0, 1), cB + hstepB, voffB); PG8_STAGE(PG8_SA(0, 0), cA, voffA); PG8_STAGE(PG8_SA(0, 1), cA + hstepA, voffA);
    if (wr == 1) PG8_BAR;
    PG8_WAIT_V(2); PG8_BAR;
    PG8_STAGE(PG8_SB(1, 0), cB + kstep, voffB); PG8_STAGE(PG8_SA(1, 0), cA + kstep, voffA); PG8_STAGE(PG8_SB(1, 1), cB + hstepB + kstep, voffB);
    PG8_WAIT_V(6); PG8_BAR;
    for (;;) {
        const bool has_next = S.next(ui + 1, nxt);
        const char* nA = has_next ? PG8_APAN(nxt.pm, 0) : cA; const char* nB = has_next ? (const char*)g.Bt + (size_t)(g.fold ? 0 : nxt.pn) * tstepB : cB;
        for (int t = 0; t < nt; t += 2) {
            if constexpr (Epi::HAS_MID) { if (t == g.ksplit) E.mid(acc, cur, wr, wc, fr, fq); }
            const bool last = (t == nt - 2);
            const char* a1 = PG8_APAN(cur.pm, t + 1);
            const char* a2 = last ? nA : PG8_APAN(cur.pm, t + 2); const char* b2 = last ? nB : cB + (size_t)(t + 2) * kstep;
            const char* a3 = a2 + kstep; const char* b3 = b2 + kstep;
            PG8_LDB(B0, 0, 0); PG8_LDB(B1, 0, 1); PG8_SCHED; PG8_LDA(At, 0, 0); PG8_STAGE(PG8_SA(1, 1), a1 + hstepA, voffA);
            PG8_WAIT_V(8); PG8_WAIT_L(0); PG8_BAR; PG8_MMA(0, 0, At, B0); PG8_MMA(0, 1, At, B1); PG8_BAR; PG8_SCHED;
            PG8_LDA(At, 0, 1); PG8_STAGE(PG8_SB(0, 0), b2, voffB); PG8_STAGE(PG8_SB(0, 1), b2 + hstepB, voffB); PG8_STAGE(PG8_SA(0, 0), a2, voffA);
            PG8_WAIT_V(8); PG8_WAIT_L(0); PG8_BAR; PG8_MMA(1, 0, At, B0); PG8_MMA(1, 1, At, B1); PG8_BAR; PG8_SCHED;
            PG8_LDB(B0, 1, 0); PG8_LDB(B1, 1, 1); PG8_SCHED; PG8_LDA(At, 1, 0); PG8_STAGE(PG8_SA(0, 1), a2 + hstepA, voffA);
            PG8_WAIT_V(8); PG8_WAIT_L(0); PG8_BAR; PG8_MMA(0, 0, At, B0); PG8_MMA(0, 1, At, B1); PG8_BAR; PG8_SCHED;
            PG8_LDA(At, 1, 1); PG8_STAGE(PG8_SB(1, 0), b3, voffB); PG8_STAGE(PG8_SB(1, 1), b3 + hstepB, voffB); PG8_STAGE(PG8_SA(1, 0), a3, voffA);
            PG8_WAIT_V(8); PG8_WAIT_L(0); PG8_BAR; PG8_MMA(1, 0, At, B0); PG8_MMA(1, 1, At, B1); PG8_BAR; PG8_SCHED;
        }
        if constexpr (ALIGN_EPI) { if (wr == 0) PG8_BAR; }
        E(acc, cur, wr, wc, fr, fq);
        if (!has_next) break;
#pragma unroll
        for (int a = 0; a < 2; ++a)
#pragma unroll
            for (int b = 0; b < 2; ++b)
#pragma unroll
                for (int m = 0; m < 4; ++m)
#pragma unroll
                    for (int n = 0; n < 2; ++n) acc[a][b][m][n] = (f32x4){0.f, 0.f, 0.f, 0.f};
        cur = nxt; cA = nA; cB = nB; ++ui;
        if constexpr (ALIGN_EPI) { if (wr == 1) PG8_BAR; }
    }
    PG8_WAIT_V(0);
    if constexpr (!ALIGN_EPI) { if (wr == 0) PG8_BAR; }
    PG8_BAR;
#undef PG8_APAN
#undef PG8_SA
#undef PG8_SB
#undef PG8_STAGE
#undef PG8_LDA
#undef PG8_LDB
#undef PG8_MMA
#undef PG8_WAIT_V
#undef PG8_WAIT_L
#undef PG8_BAR
#undef PG8_SCHED
}
template <class Epi, bool ALIGN_EPI, int SCA, int SCB>
__device__ __forceinline__ void gemm_phase8(LAS unsigned char* lds, const Gemm g, const StaticOrder& S, const Epi& E, int wid_in) {
    const int wid = wid_in, lane = lane_id_fresh(), tid = wid * 64 + lane, wr = wid >> 2, wc = wid & 3, fr = lane & 15, fq = lane >> 4;
    const int K = g.K, nt = K / BK, lda = g.lda, ldb = g.ldb;
    unsigned voffA[2], voffB[2];
#pragma unroll
    for (int i = 0; i < 2; ++i) { int R, C; stage_rc(tid * 16 + i * 8192, R, C); const int Rb = Epi::PERM ? ((R & ~31) + perm32(R & 31)) : R;
        voffA[i] = (unsigned)(R * lda + C) * 2u; voffB[i] = (unsigned)(Rb * ldb + C) * 2u; }
    const unsigned kstep = (unsigned)(BK * 2);
    const unsigned hstepA = (unsigned)HALF * lda * 2, tstepA = 2 * hstepA;
    const unsigned hstepB = (unsigned)HALF * ldb * 2, tstepB = 2 * hstepB;
    const unsigned ldsw = (unsigned)wid * 1024u;
    const int aoff0 = lds_byte(wr * 64 + fr, fq * 16), boff0 = lds_byte(wc * 32 + fr, fq * 16);
    constexpr int aoff1d = 16, boff1d = 16;
    const char* Abase = (const char*)g.A; const char* Bbase = (const char*)g.Bt;
#define PG8_APAN(pm, t) ((unsigned)(pm) * tstepA + (unsigned)(t) * kstep)
#define PG8_SA(b, h) (((b) * 2 + (h)) * HTB)
#define PG8_SB(b, h) ((4 + (b) * 2 + (h)) * HTB)
#define PG8_STAGE(bufoff, gbase, voff) do { _Pragma("unroll") for (int _i = 0; _i < 2; ++_i) \
        { unsigned vo_ = (voff)[_i]; asm volatile("" : "+v"(vo_));   \
        __builtin_amdgcn_global_load_lds((const unsigned*)(gbase + vo_), (LAS unsigned*)(lds + (bufoff) + ldsw + _i * 8192), 16, 0, 0); } } while (0)
#define PG8_GA(off) (Abase + (size_t)(off))
#define PG8_GB(off) (Bbase + (size_t)(off))
#define PG8_LDA(dst, b, h) do { _Pragma("unroll") for (int m = 0; m < 4; ++m) { const i32x4 lo_ = *(const LAS i32x4*)(lds + PG8_SA(b, h) + aoff0 + m * 2048), hi_ = *(const LAS i32x4*)(lds + PG8_SA(b, h) + aoff0 + aoff1d + m * 2048); dst[m] = __builtin_shufflevector(lo_, hi_, 0, 1, 2, 3, 4, 5, 6, 7); } } while (0)
#define PG8_LDB(dst, b, h) do { _Pragma("unroll") for (int n = 0; n < 2; ++n) { const i32x4 lo_ = *(const LAS i32x4*)(lds + PG8_SB(b, h) + boff0 + n * 2048), hi_ = *(const LAS i32x4*)(lds + PG8_SB(b, h) + boff0 + boff1d + n * 2048); dst[n] = __builtin_shufflevector(lo_, hi_, 0, 1, 2, 3, 4, 5, 6, 7); } } while (0)
#define PG8_MMA(ai, bj, At, Bt) do { __builtin_amdgcn_s_setprio(1); _Pragma("unroll") for (int m = 0; m < 4; ++m) _Pragma("unroll") for (int n = 0; n < 2; ++n) \
        acc[ai][bj][m][n] = __builtin_amdgcn_mfma_scale_f32_16x16x128_f8f6f4(Bt[n], At[m], acc[ai][bj][m][n], 0, 0, 0, SCB, 0, SCA); __builtin_amdgcn_s_setprio(0); } while (0)
#define PG8_WAIT_V(n) asm volatile("s_waitcnt vmcnt(" #n ")" ::: "memory")
#define PG8_WAIT_L(n) asm volatile("s_waitcnt lgkmcnt(" #n ")" ::: "memory")
#define PG8_BAR __builtin_amdgcn_s_barrier()
#define PG8_SCHED __builtin_amdgcn_sched_barrier(0)
    Unit cur, nxt; int ui = 0;
    if (!S.next(0, cur)) return;
    f32x4 acc[2][2][4][2];
#pragma unroll
    for (int a = 0; a < 2; ++a)
#pragma unroll
        for (int b = 0; b < 2; ++b)
#pragma unroll
            for (int m = 0; m < 4; ++m)
#pragma unroll
                for (int n = 0; n < 2; ++n) acc[a][b][m][n] = (f32x4){0.f, 0.f, 0.f, 0.f};
    v8i32 At[4], B0[2], B1[2];
    unsigned cA = PG8_APAN(cur.pm, 0), cB = (unsigned)cur.pn * tstepB;
    PG8_STAGE(PG8_SB(0, 0), PG8_GB(cB), voffB); PG8_STAGE(PG8_SB(0, 1), PG8_GB(cB + hstepB), voffB); PG8_STAGE(PG8_SA(0, 0), PG8_GA(cA), voffA); PG8_STAGE(PG8_SA(0, 1), PG8_GA(cA + hstepA), voffA);
    if (wr == 1) PG8_BAR;
    PG8_WAIT_V(2); PG8_BAR;
    PG8_STAGE(PG8_SB(1, 0), PG8_GB(cB + kstep), voffB); PG8_STAGE(PG8_SA(1, 0), PG8_GA(cA + kstep), voffA); PG8_STAGE(PG8_SB(1, 1), PG8_GB(cB + hstepB + kstep), voffB);
    PG8_WAIT_V(6); PG8_BAR;
    for (;;) {
        const bool has_next = S.next(ui + 1, nxt);
        const unsigned nA = has_next ? PG8_APAN(nxt.pm, 0) : cA, nB = has_next ? (unsigned)nxt.pn * tstepB : cB;
#pragma unroll 1
        for (int t = 0; t < nt; t += 2) {
            if constexpr (Epi::HAS_MID) { if (t == g.ksplit) { const int l_ = lane_id_fresh(); E.mid(acc, cur, wr, wc, l_ & 15, l_ >> 4); } }
            const bool last = (t == nt - 2);
            const unsigned a1 = cA + (unsigned)(t + 1) * kstep;
            const unsigned a2 = last ? nA : cA + (unsigned)(t + 2) * kstep, b2 = last ? nB : cB + (unsigned)(t + 2) * kstep;
            const unsigned a3 = a2 + kstep, b3 = b2 + kstep;
            if constexpr (Epi::HAS_PRE) { if (last) { const int l_ = lane_id_fresh(); E.prefetch(lds + PRE_OFF + ldsw, cur, wr, wc, l_ & 15, l_ >> 4); }
                                          else if (Epi::HAS_MID && t + 2 == g.ksplit) { const int l_ = lane_id_fresh(); E.prefetch_mid(lds + PRE_OFF + ldsw, cur, wr, wc, l_ & 15, l_ >> 4); } }
            PG8_LDB(B0, 0, 0); PG8_LDB(B1, 0, 1); PG8_SCHED; PG8_LDA(At, 0, 0); PG8_STAGE(PG8_SA(1, 1), PG8_GA(a1 + hstepA), voffA);
            PG8_WAIT_V(8); PG8_WAIT_L(0); PG8_BAR; PG8_MMA(0, 0, At, B0); PG8_MMA(0, 1, At, B1); PG8_BAR; PG8_SCHED;
            PG8_LDA(At, 0, 1); PG8_STAGE(PG8_SB(0, 0), PG8_GB(b2), voffB); PG8_STAGE(PG8_SB(0, 1), PG8_GB(b2 + hstepB), voffB); PG8_STAGE(PG8_SA(0, 0), PG8_GA(a2), voffA);
            PG8_WAIT_V(8); PG8_WAIT_L(0); PG8_BAR; PG8_MMA(1, 0, At, B0); PG8_MMA(1, 1, At, B1); PG8_BAR; PG8_SCHED;
            PG8_LDB(B0, 1, 0); PG8_LDB(B1, 1, 1); PG8_SCHED; PG8_LDA(At, 1, 0); PG8_STAGE(PG8_SA(0, 1), PG8_GA(a2 + hstepA), voffA);
            PG8_WAIT_V(8); PG8_WAIT_L(0); PG8_BAR; PG8_MMA(0, 0, At, B0); PG8_MMA(0, 1, At, B1); PG8_BAR; PG8_SCHED;
            PG8_LDA(At, 1, 1); PG8_STAGE(PG8_SB(1, 0), PG8_GB(b3), voffB); PG8_STAGE(PG8_SB(1, 1), PG8_GB(b3 + hstepB), voffB); PG8_STAGE(PG8_SA(1, 0), PG8_GA(a3), voffA);
            PG8_WAIT_V(8); PG8_WAIT_L(0); PG8_BAR; PG8_MMA(1, 0, At, B0); PG8_MMA(1, 1, At, B1); PG8_BAR; PG8_SCHED;
        }
        if constexpr (ALIGN_EPI) { if (wr == 0) PG8_BAR; }
        { const int l_ = lane_id_fresh(); E(acc, cur, wr, wc, l_ & 15, l_ >> 4); }
        if (!has_next) break;
#pragma unroll
        for (int a = 0; a < 2; ++a)
#pragma unroll
            for (int b = 0; b < 2; ++b)
#pragma unroll
                for (int m = 0; m < 4; ++m)
#pragma unroll
                    for (int n = 0; n < 2; ++n) acc[a][b][m][n] = (f32x4){0.f, 0.f, 0.f, 0.f};
        cur = nxt; cA = nA; cB = nB; ++ui;
        if constexpr (ALIGN_EPI) { if (wr == 1) PG8_BAR; }
    }
    PG8_WAIT_V(0);
    if constexpr (!ALIGN_EPI) { if (wr == 0) PG8_BAR; }
    PG8_BAR;
#undef PG8_APAN
#undef PG8_GA
#undef PG8_GB
#undef PG8_SA
#undef PG8_SB
#undef PG8_STAGE
#undef PG8_LDA
#undef PG8_LDB
#undef PG8_MMA
#undef PG8_WAIT_V
#undef PG8_WAIT_L
#undef PG8_BAR
#undef PG8_SCHED
}
}

typedef const f32x4 (&AccRef)[2][2][4][2];
typedef f32x4 (&AccMut)[2][2][4][2];

__device__ __forceinline__ u32x2 pack8_fp8(f32x4 a, f32x4 b, float s) { u32x2 w; w.x = pk4_fp8(a[0] * s, a[1] * s, a[2] * s, a[3] * s); w.y = pk4_fp8(b[0] * s, b[1] * s, b[2] * s, b[3] * s); return w; }
__device__ __forceinline__ u32x4 pack8(f32x4 a, f32x4 b) { u32x4 w; w.x = cvt_pk_bf16(a[0], a[1]); w.y = cvt_pk_bf16(a[2], a[3]); w.z = cvt_pk_bf16(b[0], b[1]); w.w = cvt_pk_bf16(b[2], b[3]); return w; }

__device__ __forceinline__ unsigned opaque(unsigned x) { asm volatile("" : "+v"(x)); return x; }

#define EPI_PREFETCH3(base_off, ldrow) do { _Pragma("unroll") for (int j = 0; j < 3; ++j) { unsigned vo_ = (base_off) + (unsigned)((j >> 1) * 16) * (unsigned)((ldrow) * 2) + (unsigned)((j & 1) * 256); asm volatile("" : "+v"(vo_)); \
            __builtin_amdgcn_global_load_lds((const unsigned*)(ws + vo_), (LAS unsigned*)(dstw + j * 8192), 16, 0, 0); } } while (0)
#define EPI_PRE_PTR() ((const LAS unsigned char*)(uintptr_t)(PRE_OFF + ((wr * 4 + wc) * 64 + fq * 16 + fr) * 16))
struct EpiIn {
    static constexpr bool PERM = true, HAS_MID = false, HAS_PRE = false;
    bf16_t *U, *ZA, *Q, *ZB, *Kb, *Vb, *GA, *GB; const float *qg, *kg; float* out; bool nostore; int pn_off;
    __device__ __forceinline__ void operator()(AccRef acc, const pg8::Unit& u, int wr, int wc, int fr, int fq) const {
        const int pn = pn_off ? (u.pn < 8 ? 4 + u.pn : 5 + u.pn) : u.pn, row0 = u.pm * 256 + wr * 64 + fr, lc0 = 64 * wc + 8 * fq;
        if (pn == 12) {
            const bool isk = wc < 2; const int hd = wc & 1;
            f32x4 gq[2][2];
#pragma unroll
            for (int bj = 0; bj < 2; ++bj)
#pragma unroll
                for (int n = 0; n < 2; ++n) gq[bj][n] = isk ? *(const f32x4*)(kg + 32 * bj + 8 * fq + 4 * n) : (f32x4){1.f, 1.f, 1.f, 1.f};
            char* dst = (char*)(isk ? Kb : Vb); float* opk = out + (isk ? O_PK : O_PV); float* osk = out + (isk ? O_SK : O_SV);
            const unsigned off0 = ((unsigned)row0 * 128u + 64u * hd + 8u * fq) * 2u;
#pragma unroll
            for (int ai = 0; ai < 2; ++ai)
#pragma unroll
                for (int m = 0; m < 4; ++m) {
                    const int row = row0 + ai * 128 + m * 16;
                    const unsigned o = opaque(off0 + (unsigned)(ai * 128 + m * 16) * 256u);
                    float r = 1.f;
                    if (isk) { float ss = 0.f;
#pragma unroll
                        for (int bj = 0; bj < 2; ++bj)
#pragma unroll
                            for (int n = 0; n < 2; ++n) { const f32x4 x = acc[ai][bj][m][n]; ss += (x[0] * x[0] + x[1] * x[1]) + (x[2] * x[2] + x[3] * x[3]); }
                        ss += __shfl_xor(ss, 16); ss += __shfl_xor(ss, 32);
                        r = __builtin_amdgcn_rsqf(ss * (1.0f / 64.0f) + EPSN); }
                    float* fo = nullptr;
                    if (row < MP) { const int t = row & (SEQ - 1); if (t >= SEQ - 128) fo = opk + ((size_t)((row >> 12) * 128 + (t - (SEQ - 128))) * 2 + hd) * 64; }
                    else if (row < MP + MS) { fo = osk + ((size_t)(row - MP) * 2 + hd) * 64; }
#pragma unroll
                    for (int bj = 0; bj < 2; ++bj) {
                        const f32x4 v0 = acc[ai][bj][m][0] * r * gq[bj][0], v1 = acc[ai][bj][m][1] * r * gq[bj][1];
                        if (!nostore) *(u32x4*)(dst + o + 64 * bj) = pack8(v0, v1);
                        if (fo && !nostore) { *(f32x4*)(fo + 32 * bj + 8 * fq) = v0; *(f32x4*)(fo + 32 * bj + 8 * fq + 4) = v1; }
                    }
                }
            return;
        }
        if (pn >= 8 && pn < 12) {
            f32x4 gq[2][2];
#pragma unroll
            for (int bj = 0; bj < 2; ++bj)
#pragma unroll
                for (int n = 0; n < 2; ++n) gq[bj][n] = *(const f32x4*)(qg + 32 * bj + 8 * fq + 4 * n) * QSCALE;
            const unsigned off0 = ((unsigned)row0 * (unsigned)LD1 + (unsigned)((pn - 8) * 256 + lc0)) * 2u;
#pragma unroll
            for (int ai = 0; ai < 2; ++ai)
#pragma unroll
                for (int m = 0; m < 4; ++m) {
                    const unsigned o = opaque(off0 + (unsigned)(ai * 128 + m * 16) * (unsigned)(LD1 * 2)); float ss = 0.f;
#pragma unroll
                    for (int bj = 0; bj < 2; ++bj)
#pragma unroll
                        for (int n = 0; n < 2; ++n) { const f32x4 x = acc[ai][bj][m][n]; ss += (x[0] * x[0] + x[1] * x[1]) + (x[2] * x[2] + x[3] * x[3]); }
                    ss += __shfl_xor(ss, 16); ss += __shfl_xor(ss, 32);
                    const float r = __builtin_amdgcn_rsqf(ss * (1.0f / 64.0f) + EPSN);
#pragma unroll
                    for (int bj = 0; bj < 2; ++bj)
                        { const u32x4 pk = pack8(acc[ai][bj][m][0] * r * gq[bj][0], acc[ai][bj][m][1] * r * gq[bj][1]); if (!nostore) *(u32x4*)((char*)Q + o + 64 * bj) = pk; else asm volatile("" :: "v"(pk)); }
                }
            return;
        }
        if (pn >= 17) {
            const unsigned off0 = ((unsigned)row0 * (unsigned)LD2 + (unsigned)((pn - 17) * 128 + 32 * wc + 8 * fq)) * 2u;
#pragma unroll
            for (int ai = 0; ai < 2; ++ai)
#pragma unroll
                for (int m = 0; m < 4; ++m) {
                    const unsigned o = opaque(off0 + (unsigned)(ai * 128 + m * 16) * (unsigned)(LD2 * 2));
                    f32x4 r0, r1, i0, i1;
#pragma unroll
                    for (int i = 0; i < 4; ++i) {
                        const float a0 = 1.0f + __builtin_amdgcn_exp2f(fminf(acc[ai][0][m][0][i], 86.5f)), a1 = 1.0f + __builtin_amdgcn_exp2f(fminf(acc[ai][0][m][1][i], 86.5f));
                        const float b0 = 1.0f + __builtin_amdgcn_exp2f(fminf(acc[ai][1][m][0][i], 86.5f)), b1 = 1.0f + __builtin_amdgcn_exp2f(fminf(acc[ai][1][m][1][i], 86.5f));
                        r0[i] = b0 * __builtin_amdgcn_rcpf(a0); r1[i] = b1 * __builtin_amdgcn_rcpf(a1); i0[i] = __builtin_amdgcn_rcpf(b0); i1[i] = __builtin_amdgcn_rcpf(b1);
                    }
                    const u32x4 pr = pack8(r0, r1), pi = pack8(i0, i1);
                    if (!nostore) { *(u32x4*)((char*)GA + o) = pr; *(u32x4*)((char*)GB + o) = pi; } else asm volatile("" :: "v"(pr), "v"(pi));
                }
            return;
        }
        char* dst; unsigned ld, cb; int kind;
        if (pn < 4) { dst = (char*)U; ld = LD1; cb = pn * 256; kind = 0; }
        else if (pn < 8) { dst = (char*)ZA; ld = LD1; cb = (pn - 4) * 256; kind = 1; }
        else { dst = (char*)ZB; ld = LD1; cb = (pn - 13) * 256; kind = 1; }
        const unsigned off0 = ((unsigned)row0 * ld + cb + (unsigned)lc0) * 2u;
#define EPI_IN_LOOP(BODY) _Pragma("unroll") for (int ai = 0; ai < 2; ++ai) _Pragma("unroll") for (int m = 0; m < 4; ++m) { \
            const unsigned o = opaque(off0 + (unsigned)(ai * 128 + m * 16) * ld * 2u); \
            _Pragma("unroll") for (int bj = 0; bj < 2; ++bj) { f32x4 v0 = acc[ai][bj][m][0], v1 = acc[ai][bj][m][1]; BODY; \
                const u32x4 pk = pack8(v0, v1); if (!nostore) *(u32x4*)(dst + o + 64 * bj) = pk; else asm volatile("" :: "v"(pk)); } }
        if (kind == 0) { EPI_IN_LOOP((void)0) }
        else { EPI_IN_LOOP(_Pragma("unroll") for (int i = 0; i < 4; ++i) { v0[i] = siluf_(v0[i]); v1[i] = siluf_(v1[i]); }) }
#undef EPI_IN_LOOP
    }
};

struct EpiGlu {
    static constexpr bool PERM = true, HAS_MID = false, HAS_PRE = true;
    unsigned char* ws; const float* bias;
    __device__ __forceinline__ void prefetch_mid(LAS unsigned char*, const pg8::Unit&, int, int, int, int) const {}
    __device__ __forceinline__ void prefetch(LAS unsigned char* dstw, const pg8::Unit& u, int wr, int wc, int fr, int fq) const {
        const int row0 = u.pm * 256 + wr * 64 + fr, col0 = u.pn * 256 + wc * 32 + 8 * fq;
        EPI_PREFETCH3(((unsigned)row0 * (unsigned)LD1 + (unsigned)col0) * 2u + (unsigned)WS_U, LD1);
    }
    __device__ __forceinline__ void operator()(AccRef acc, const pg8::Unit& u, int wr, int wc, int fr, int fq) const {
        const int row0 = u.pm * 256 + wr * 64 + fr, col0 = u.pn * 256 + wc * 32 + 8 * fq;
        f32x4 bv[2][2];
#pragma unroll
        for (int bj = 0; bj < 2; ++bj)
#pragma unroll
            for (int n = 0; n < 2; ++n) bv[bj][n] = *(const f32x4*)(bias + col0 + bj * 128 + 4 * n);
        const unsigned off0 = ((unsigned)row0 * (unsigned)LD1 + (unsigned)col0) * 2u + (unsigned)WS_U, off8 = (unsigned)row0 * (unsigned)LD8B + (unsigned)col0 + (unsigned)WS_BR8;
#pragma unroll
        for (int ai = 0; ai < 2; ++ai)
        { constexpr int mh = 0;
            u32x4 gw[4][2];
#pragma unroll
            for (int mm = 0; mm < 4; ++mm) { const unsigned o = opaque(off0 + (unsigned)(ai * 128 + (mh * 2 + mm) * 16) * (unsigned)(LD1 * 2));
#pragma unroll
                for (int bj = 0; bj < 2; ++bj) { if (ai == 0 && 2 * mm + bj < 3) gw[mm][bj] = *(const LAS u32x4*)(EPI_PRE_PTR() + (2 * mm + bj) * 8192); else gw[mm][bj] = *(const u32x4*)(ws + o + bj * 256); } }
            asm volatile("" ::: "memory");
#pragma unroll
            for (int mm = 0; mm < 4; ++mm) { const int m = mh * 2 + mm;
#pragma unroll
                for (int bj = 0; bj < 2; ++bj) {
                    const u32x4 g4 = gw[mm][bj];
                    const f32x4 a0 = acc[ai][bj][m][0] + bv[bj][0], a1 = acc[ai][bj][m][1] + bv[bj][1];
                    f32x4 o0, o1;
                    o0[0] = bflo(g4.x) * sigmoidf_(a0[0]); o0[1] = bfhi(g4.x) * sigmoidf_(a0[1]);
                    o0[2] = bflo(g4.y) * sigmoidf_(a0[2]); o0[3] = bfhi(g4.y) * sigmoidf_(a0[3]);
                    o1[0] = bflo(g4.z) * sigmoidf_(a1[0]); o1[1] = bfhi(g4.z) * sigmoidf_(a1[1]);
                    o1[2] = bflo(g4.w) * sigmoidf_(a1[2]); o1[3] = bfhi(g4.w) * sigmoidf_(a1[3]);
                    *(u32x2*)(ws + opaque(off8 + (unsigned)(ai * 128 + m * 16) * (unsigned)LD8B) + bj * 128) = pack8_fp8(o0, o1, F8_BR);
                } }
            asm volatile("" ::: "memory");
        }
    }
};

struct EpiOut {
    static constexpr bool PERM = true, HAS_MID = true, HAS_PRE = true;
    unsigned char* ws;
    __device__ __forceinline__ void prefetch_mid(LAS unsigned char* dstw, const pg8::Unit& u, int wr, int wc, int fr, int fq) const {
        const int row0 = u.pm * 256 + wr * 64 + fr, col0 = u.pn * 256 + wc * 32 + 8 * fq;
        EPI_PREFETCH3(((unsigned)row0 * (unsigned)LD2 + (unsigned)col0) * 2u + (unsigned)WS_GA, LD2);
    }
    __device__ __forceinline__ void prefetch(LAS unsigned char* dstw, const pg8::Unit& u, int wr, int wc, int fr, int fq) const {
        const int row0 = u.pm * 256 + wr * 64 + fr, col0 = u.pn * 256 + wc * 32 + 8 * fq;
        EPI_PREFETCH3(((unsigned)row0 * (unsigned)LD2 + (unsigned)col0) * 2u + (unsigned)WS_GB, LD2);
    }
    __device__ __forceinline__ void mid(AccMut acc, const pg8::Unit& u, int wr, int wc, int fr, int fq) const {
        const int row0 = u.pm * 256 + wr * 64 + fr, col0 = u.pn * 256 + wc * 32 + 8 * fq;
        const unsigned off0 = ((unsigned)row0 * (unsigned)LD2 + (unsigned)col0) * 2u + (unsigned)WS_GA;
#pragma unroll
        for (int ai = 0; ai < 2; ++ai)
        {
            u32x4 av[4][2];
#pragma unroll
            for (int mm = 0; mm < 4; ++mm) { const unsigned o = opaque(off0 + (unsigned)(ai * 128 + mm * 16) * (unsigned)(LD2 * 2));
#pragma unroll
                for (int bj = 0; bj < 2; ++bj) { if (ai == 0 && 2 * mm + bj < 3) av[mm][bj] = *(const LAS u32x4*)(EPI_PRE_PTR() + (2 * mm + bj) * 8192); else av[mm][bj] = *(const u32x4*)(ws + o + bj * 256); } }
            asm volatile("" ::: "memory");
#pragma unroll
            for (int mm = 0; mm < 4; ++mm)
#pragma unroll
                for (int bj = 0; bj < 2; ++bj) {
                    const u32x4 a = av[mm][bj];
                    f32x4 r0, r1;
                    r0[0] = bflo(a.x); r0[1] = bfhi(a.x); r0[2] = bflo(a.y); r0[3] = bfhi(a.y);
                    r1[0] = bflo(a.z); r1[1] = bfhi(a.z); r1[2] = bflo(a.w); r1[3] = bfhi(a.w);
                    acc[ai][bj][mm][0] *= r0; acc[ai][bj][mm][1] *= r1;
                }
            asm volatile("" ::: "memory");
        }
    }
    __device__ __forceinline__ void operator()(AccRef acc, const pg8::Unit& u, int wr, int wc, int fr, int fq) const {
        const int row0 = u.pm * 256 + wr * 64 + fr, col0 = u.pn * 256 + wc * 32 + 8 * fq;
        const unsigned off0 = ((unsigned)row0 * (unsigned)LD2 + (unsigned)col0) * 2u + (unsigned)WS_GB, off8 = (unsigned)row0 * (unsigned)LD8B + (unsigned)col0 + (unsigned)WS_MX8;
#pragma unroll
        for (int ai = 0; ai < 2; ++ai) {
            u32x4 bv[4][2];
#pragma unroll
            for (int m = 0; m < 4; ++m) { const unsigned o = opaque(off0 + (unsigned)(ai * 128 + m * 16) * (unsigned)(LD2 * 2));
#pragma unroll
                for (int bj = 0; bj < 2; ++bj) { if (ai == 0 && 2 * m + bj < 3) bv[m][bj] = *(const LAS u32x4*)(EPI_PRE_PTR() + (2 * m + bj) * 8192); else bv[m][bj] = *(const u32x4*)(ws + o + bj * 256); } }
            asm volatile("" ::: "memory");
#pragma unroll
            for (int m = 0; m < 4; ++m)
#pragma unroll
                for (int bj = 0; bj < 2; ++bj) {
                    const u32x4 b = bv[m][bj];
                    f32x4 g0, g1; g0[0] = bflo(b.x); g0[1] = bfhi(b.x); g0[2] = bflo(b.y); g0[3] = bfhi(b.y);
                    g1[0] = bflo(b.z); g1[1] = bfhi(b.z); g1[2] = bflo(b.w); g1[3] = bfhi(b.w);
                    *(u32x2*)(ws + opaque(off8 + (unsigned)(ai * 128 + m * 16) * (unsigned)LD8B) + bj * 128) = pack8_fp8(acc[ai][bj][m][0] * g0, acc[ai][bj][m][1] * g1, F8_MX);
                }
            asm volatile("" ::: "memory");
        }
    }
};

struct EpiRes {
    static constexpr bool PERM = true, HAS_MID = false, HAS_PRE = true;
    unsigned char* ws; const float* gain; float* out;
    __device__ __forceinline__ void prefetch_mid(LAS unsigned char*, const pg8::Unit&, int, int, int, int) const {}
    __device__ __forceinline__ void prefetch(LAS unsigned char* dstw, const pg8::Unit& u, int wr, int wc, int fr, int fq) const {
        const int row0 = u.pm * 256 + wr * 64 + fr, col0 = u.pn * 256 + wc * 32 + 8 * fq;
        const unsigned offx = ((unsigned)row0 * (unsigned)LD2 + (unsigned)col0) * 2u + (unsigned)WS_XN;
#pragma unroll
        for (int j = 0; j < 3; ++j) { unsigned vo_ = offx + (unsigned)((j >> 1) * 16) * (unsigned)(LD2 * 2) + (unsigned)((j & 1) * 256); asm volatile("" : "+v"(vo_));
            __builtin_amdgcn_global_load_lds((const unsigned*)(ws + vo_), (LAS unsigned*)(dstw + j * 8192), 16, 0, 0); }
    }
    __device__ __forceinline__ void operator()(AccRef acc, const pg8::Unit& u, int wr, int wc, int fr, int fq) const {
        const int row0 = u.pm * 256 + wr * 64 + fr, col0 = u.pn * 256 + wc * 32 + 8 * fq;
        const LAS unsigned char* pre = (const LAS unsigned char*)(uintptr_t)(PRE_OFF + ((wr * 4 + wc) * 64 + fq * 16 + fr) * 16);
        f32x4 ig[2][2];
#pragma unroll
        for (int bj = 0; bj < 2; ++bj)
#pragma unroll
            for (int n = 0; n < 2; ++n) { const f32x4 gq = *(const f32x4*)(gain + col0 + bj * 128 + 4 * n);
#pragma unroll
                for (int i = 0; i < 4; ++i) ig[bj][n][i] = __builtin_amdgcn_rcpf(gq[i]); }
        char* ob = (char*)(out + O_YP);
        const unsigned offx = ((unsigned)row0 * (unsigned)LD2 + (unsigned)col0) * 2u + (unsigned)WS_XN, offy = ((unsigned)row0 * (unsigned)DM + (unsigned)col0) * 4u;
#pragma unroll
        for (int ai = 0; ai < 2; ++ai) {
            u32x4 xv[4][2]; float rr[4];
#pragma unroll
            for (int m = 0; m < 4; ++m) { const unsigned o = opaque(offx + (unsigned)(ai * 128 + m * 16) * (unsigned)(LD2 * 2));
                rr[m] = *(const float*)(ws + (unsigned)(WS_CONST + C_RS) + (unsigned)(row0 + ai * 128 + m * 16) * 4u);
#pragma unroll
                for (int bj = 0; bj < 2; ++bj) { if (ai == 0 && 2 * m + bj < 3) xv[m][bj] = *(const LAS u32x4*)(pre + (2 * m + bj) * 8192); else xv[m][bj] = __builtin_nontemporal_load((const u32x4*)(ws + o + bj * 256)); } }
            asm volatile("" ::: "memory");
#pragma unroll
            for (int m = 0; m < 4; ++m) { const unsigned o = opaque(offy + (unsigned)(ai * 128 + m * 16) * (unsigned)(DM * 4));
#pragma unroll
                for (int bj = 0; bj < 2; ++bj) {
                    const u32x4 x8 = xv[m][bj]; const float r = rr[m];
                    f32x4 x0, x1; x0[0] = bflo(x8.x); x0[1] = bfhi(x8.x); x0[2] = bflo(x8.y); x0[3] = bfhi(x8.y); x1[0] = bflo(x8.z); x1[1] = bfhi(x8.z); x1[2] = bflo(x8.w); x1[3] = bfhi(x8.w);
                    *(f32x4*)(ob + o + bj * 512) = x0 * r * ig[bj][0] + acc[ai][bj][m][0];
                    *(f32x4*)(ob + o + bj * 512 + 16) = x1 * r * ig[bj][1] + acc[ai][bj][m][1];
                } }
            asm volatile("" ::: "memory");
        }
    }
};

struct EpiNull {
    static constexpr bool PERM = true, HAS_MID = false, HAS_PRE = false; float* sink;
    __device__ __forceinline__ void operator()(AccRef acc, const pg8::Unit& u, int wr, int wc, int fr, int fq) const {
        f32x4 s = (f32x4){0.f, 0.f, 0.f, 0.f};
#pragma unroll
        for (int ai = 0; ai < 2; ++ai)
#pragma unroll
            for (int bj = 0; bj < 2; ++bj)
#pragma unroll
                for (int m = 0; m < 4; ++m)
#pragma unroll
                    for (int n = 0; n < 2; ++n) s += acc[ai][bj][m][n];
        if (s[0] + s[1] + s[2] + s[3] == 12345.678f) sink[fr] = s[0];
    }
};

#define XB_TMO      128
#define XB_XCNT(j)  (256  + 64 * (j))
#define XB_XSUB(j)  (1280 + 64 * (j))
#define XB_XGEN(j)  (2304 + 64 * (j))
#define XB_TOP      3328
#define XB_TOPGEN   3392
#define XCD_BAR_WORDS 3456
#define XB_SPIN_CAP (1u << 18)
__device__ __forceinline__ unsigned xb_ld(unsigned* p)              { return __hip_atomic_load(p, __ATOMIC_RELAXED, __HIP_MEMORY_SCOPE_AGENT); }
__device__ __forceinline__ unsigned xb_add(unsigned* p, unsigned v) { return __hip_atomic_fetch_add(p, v, __ATOMIC_RELAXED, __HIP_MEMORY_SCOPE_AGENT); }
__device__ __forceinline__ unsigned xb_xcc_id() { return (unsigned)__builtin_amdgcn_s_getreg((3 << 11) | 20) & 0xFu; }
#define XB_SPIN(cond, bar) do { unsigned _sp = 0; while (cond) { __builtin_amdgcn_s_sleep(1); \
    if ((++_sp & 255u) == 0u) { if (xb_ld(&(bar)[XB_TMO])) break; if (_sp > XB_SPIN_CAP) { atomicAdd(&(bar)[XB_TMO], 1u); break; } } } } while (0)
struct XcdBarrier { unsigned* bar; unsigned x; volatile LAS unsigned* st; unsigned expect; };
__device__ __forceinline__ XcdBarrier xcd_barrier_post(unsigned* bar, volatile LAS unsigned* st, unsigned expect, bool leader) {
    XcdBarrier b; b.bar = bar; b.x = xb_xcc_id(); b.st = st; b.expect = expect;
    if (leader) (void)xb_add(&bar[XB_XCNT(b.x)], 1u);
    return b;
}
__device__ __forceinline__ void xcd_barrier_complete(unsigned* bar, unsigned x, unsigned G, unsigned& nloc, unsigned& nx) {
    unsigned sum, cnt, mine, sp = 0u;
    for (;;) {
        sum = 0u; cnt = 0u; mine = 0u;
#pragma unroll
        for (unsigned j = 0; j < 16; ++j) { const unsigned c = xb_ld(&bar[XB_XCNT(j)]); sum += c; cnt += (c > 0u) ? 1u : 0u; mine = (j == x) ? c : mine; }
        if (sum == G) break;
        __builtin_amdgcn_s_sleep(1);
        if ((++sp & 255u) == 0u) { if (xb_ld(&bar[XB_TMO])) break; if (sp > XB_SPIN_CAP) { atomicAdd(&bar[XB_TMO], 1u); break; } }
    }
    nloc = mine > 0u ? mine : 1u; nx = cnt > 0u ? cnt : 1u;
}
__device__ __forceinline__ void xcd_barrier(unsigned* bbar, unsigned bx, volatile LAS unsigned* bst, unsigned bexpect, bool leader) {
    struct { unsigned* bar; unsigned x; volatile LAS unsigned* st; unsigned expect; } b = {bbar, bx, bst, bexpect};
    asm volatile("s_waitcnt vmcnt(0)" ::: "memory");
    __syncthreads();
    if (leader) {
        unsigned* bar = b.bar;
        __builtin_amdgcn_s_waitcnt(0);
        unsigned nloc = b.st[0], nx = b.st[1];
        if (nloc == 0u) { xcd_barrier_complete(bar, b.x, b.expect, nloc, nx); b.st[0] = nloc; b.st[1] = nx; }
        const unsigned old = xb_add(&bar[XB_XSUB(b.x)], 1u);
        const unsigned gen = old / nloc;
        if (old + 1u == (gen + 1u) * nloc) {
            __builtin_amdgcn_fence(__ATOMIC_RELEASE, "agent");
            asm volatile("s_waitcnt vmcnt(0)" ::: "memory");
            const unsigned og = xb_add(&bar[XB_TOP], 1u);
            const unsigned tg = og / nx;
            if (og + 1u == (tg + 1u) * nx) xb_add(&bar[XB_TOPGEN], 1u);
            else XB_SPIN(xb_ld(&bar[XB_TOPGEN]) == tg, bar);
            __builtin_amdgcn_fence(__ATOMIC_ACQUIRE, "agent");
            xb_add(&bar[XB_XGEN(b.x)], 1u);
            asm volatile("s_waitcnt vmcnt(0)" ::: "memory");
        } else {
            XB_SPIN(xb_ld(&bar[XB_XGEN(b.x)]) == gen, bar);
            __builtin_amdgcn_fence(__ATOMIC_ACQUIRE, "agent");
            asm volatile("s_waitcnt vmcnt(0)" ::: "memory");
        }
    }
    __syncthreads();
}

__device__ __forceinline__ void xcd_stagger(unsigned xcc, unsigned ticks_per_step) {
    const unsigned long long t0 = __builtin_amdgcn_s_memrealtime(), want = (unsigned long long)((xcc & 3u) * ticks_per_step);
    while (__builtin_amdgcn_s_memrealtime() - t0 < want) __builtin_amdgcn_s_sleep(16);
}

struct Args {
    const float* in[25]; float* out; unsigned char* ws; int ph_lo, ph_hi;
};
typedef const __attribute__((address_space(4))) Args* KArgs;
__device__ __forceinline__ KArgs kargs_fresh() { KArgs p = (KArgs)__builtin_amdgcn_kernarg_segment_ptr(); asm volatile("" : "+s"(p)); return p; }
struct Frame {
    LAS unsigned char* lds; int tid, lane, wave;
    float* out; unsigned char* ws;
};
__device__ __forceinline__ float wave_sum(float v) {
#pragma unroll
    for (int o = 1; o < 64; o <<= 1) v += __shfl_xor(v, o);
    return v;
}

template <bool SIGMA>
__device__ __forceinline__ void p0_transpose_item(const float* W, int N, bf16_t* WT, int ldk, int koff, LAS float* scr, int item, int lane, unsigned char* WT8 = nullptr, int ldk8 = 0) {
    const int nblk = N / 32, kb = item / nblk, nb = item % nblk, k0 = 64 * kb, n0 = 32 * nb;
#pragma unroll 8
    for (int i = 0; i < 32; ++i) { const int kk = 2 * i + (lane >> 5); scr[kk * 33 + (lane & 31)] = W[(size_t)(k0 + kk) * N + n0 + (lane & 31)]; }
    asm volatile("s_waitcnt lgkmcnt(0)" ::: "memory");
    const int c = lane & 7;
#pragma unroll
    for (int j = 0; j < 4; ++j) { const int n = (lane >> 3) + 8 * j; const LAS float* s = scr + (8 * c) * 33 + n;
        const float sc = (SIGMA && n0 + n >= 4352) ? -LOG2E : 1.0f;
        u32x4 o; o.x = cvt_pk_bf16(s[0 * 33] * sc, s[1 * 33] * sc); o.y = cvt_pk_bf16(s[2 * 33] * sc, s[3 * 33] * sc); o.z = cvt_pk_bf16(s[4 * 33] * sc, s[5 * 33] * sc); o.w = cvt_pk_bf16(s[6 * 33] * sc, s[7 * 33] * sc);
        int nl = n0 + n;
        if (SIGMA) { if (nl >= 4352) { const int c_ = (nl - 4352) & 2047, gate_ = (nl - 4352) >> 11; nl = (17 + (c_ >> 7)) * 256 + 128 * gate_ + (c_ & 127); }
            else { const int lc = nl & 255, wcc = lc >> 6, bjj = (lc >> 5) & 1, jj = lc & 31; nl = (nl & ~255) + 128 * bjj + 32 * wcc + jj; } }
        *(u32x4*)(WT + (size_t)nl * ldk + koff + k0 + 8 * c) = o;
        if (SIGMA) { if (n0 >= 3328 || (n0 >= 1024 && n0 < 3072)) { const int nl8 = n0 >= 3072 ? nl - 3328 + 2048 : nl - 1024; u32x2 o8; o8.x = pk4_fp8(s[0 * 33] * (sc * F8_W), s[1 * 33] * (sc * F8_W), s[2 * 33] * (sc * F8_W), s[3 * 33] * (sc * F8_W)); o8.y = pk4_fp8(s[4 * 33] * (sc * F8_W), s[5 * 33] * (sc * F8_W), s[6 * 33] * (sc * F8_W), s[7 * 33] * (sc * F8_W));
            *(u32x2*)(WT8 + (size_t)nl8 * ldk8 + koff + k0 + 8 * c) = o8; } }
        else if (WT8) { u32x2 o8; o8.x = pk4_fp8(s[0 * 33] * F8_W, s[1 * 33] * F8_W, s[2 * 33] * F8_W, s[3 * 33] * F8_W); o8.y = pk4_fp8(s[4 * 33] * F8_W, s[5 * 33] * F8_W, s[6 * 33] * F8_W, s[7 * 33] * F8_W);
            *(u32x2*)(WT8 + (size_t)nl * ldk8 + koff + k0 + 8 * c) = o8; } }
    asm volatile("s_waitcnt lgkmcnt(0)" ::: "memory");
}
template <int NOST = 0>
__device__ __forceinline__ void p0_norm_row(const float* xrow, const f32x4 (&gv)[8], bf16_t* orow, unsigned char* orow8, float* rs, int lane, LAS unsigned char* rp) {
    const f32x4* xr = (const f32x4*)xrow + lane;
    f32x4 v[8]; float s = 0.f;
#pragma unroll
    for (int j = 0; j < 8; ++j) { v[j] = __builtin_nontemporal_load(xr + 64 * j); s += (v[j][0] * v[j][0] + v[j][1] * v[j][1]) + (v[j][2] * v[j][2] + v[j][3] * v[j][3]); }
    const float rms = sqrtf(wave_sum(s) * (1.0f / DM) + EPSN), rstd = 1.0f / rms;
    if (rs && lane == 0) *rs = rms;
#pragma unroll
    for (int j = 0; j < 8; ++j) { const f32x4 y = v[j] * rstd * gv[j]; u32x2 w; w.x = cvt_pk_bf16(y[0], y[1]); w.y = cvt_pk_bf16(y[2], y[3]); *(LAS u32x2*)(rp + 8 * lane + 512 * j) = w;
        if (orow8) *(LAS unsigned*)(rp + 4096 + 4 * lane + 256 * j) = pk4_fp8(y[0] * F8_X, y[1] * F8_X, y[2] * F8_X, y[3] * F8_X); }
    asm volatile("" ::: "memory");
    if (NOST != 1) {
#pragma unroll
        for (int i = 0; i < 4; ++i) { const u32x4 t = *(const LAS u32x4*)(rp + 16 * lane + 1024 * i); *(u32x4*)((char*)orow + 16 * lane + 1024 * i) = t; } }
    if (orow8 && NOST == 0) {
#pragma unroll
        for (int i = 0; i < 2; ++i) { const u32x4 t = *(const LAS u32x4*)(rp + 4096 + 16 * lane + 1024 * i); *(u32x4*)(orow8 + 16 * lane + 1024 * i) = t; } }
    asm volatile("" ::: "memory");
}
template <int PARTS>
__device__ __forceinline__ void p0_prologue(Frame& F) {
    const KArgs ARp = kargs_fresh();
#define AR (*ARp)
    LAS float* scr = (LAS float*)(F.lds + F.wave * 16384);
    const float* w_in = ((const float*)(GAS1 const float*)AR.in[7]); const float* w_glu = ((const float*)(GAS1 const float*)AR.in[16]); const float* w_oa = ((const float*)(GAS1 const float*)AR.in[22]); const float* w_ob = ((const float*)(GAS1 const float*)AR.in[23]); const float* w_o = ((const float*)(GAS1 const float*)AR.in[24]);
    bf16_t* WIN = (bf16_t*)(F.ws + WS_WIN); bf16_t* WGLU = (bf16_t*)(F.ws + WS_WGLU); bf16_t* WOUT = (bf16_t*)(F.ws + WS_WOUT); bf16_t* WO = (bf16_t*)(F.ws + WS_WO);
    constexpr int I_IN = (DM / 64) * (NIN / 32), I_GLU = (1024 / 64) * (1024 / 32), I_OA = (1024 / 64) * (DM / 32), I_O = (DM / 64) * (DM / 32);
    (void)w_glu; (void)w_oa; (void)w_ob; (void)w_o; (void)WGLU; (void)WOUT; (void)WO; (void)I_GLU; (void)I_OA; (void)I_O;
    if (PARTS & 1) for (int it = ((int)blockIdx.x * 8 + F.wave); it < I_IN; it += ((int)gridDim.x * 8))
        p0_transpose_item<true>(w_in, NIN, WIN, LD2, 0, scr, it, F.lane, F.ws + WS_W8IN, LD8B);
    if (PARTS & 2) { f32x4 gv[8];
#pragma unroll
      for (int j = 0; j < 8; ++j) gv[j] = ((const f32x4*)((const float*)(GAS1 const float*)AR.in[6]))[F.lane + 64 * j];
      bf16_t* XN = (bf16_t*)(F.ws + WS_XN);
      for (int m = ((int)blockIdx.x * 8 + F.wave); m < MROWS; m += ((int)gridDim.x * 8)) {
          if (m < MP) p0_norm_row<(PARTS >> 3) & 3>(((const float*)(GAS1 const float*)AR.in[0]) + (size_t)m * DM, gv, XN + (size_t)m * LD2, F.ws + WS_XN8 + (size_t)m * LD8B, (float*)(F.ws + WS_CONST + C_RS) + m, F.lane, (LAS unsigned char*)scr);
          else if (m < MP + MS) p0_norm_row(((const float*)(GAS1 const float*)AR.in[1]) + (size_t)(m - MP) * DM, gv, XN + (size_t)m * LD2, nullptr, nullptr, F.lane, (LAS unsigned char*)scr);
          else { u32x2* o8 = (u32x2*)(XN + (size_t)m * LD2) + F.lane;
#pragma unroll
              for (int j = 0; j < 8; ++j) o8[64 * j] = (u32x2){0u, 0u}; }
      } }
    const int gt = (PARTS & 4) ? blockIdx.x * 512 + F.tid : (1 << 30);
    if (gt < NGRP * NSTATE) {
        const int g = gt >> 6, p = gt & 63;
        const double are = (double)((const float*)(GAS1 const float*)AR.in[8])[gt], aim = (double)((const float*)(GAS1 const float*)AR.in[9])[gt], dt = exp((double)((const float*)(GAS1 const float*)AR.in[10])[g]);
        const double mag = exp(are * dt), ang = aim * dt, lre = mag * cos(ang), lim = mag * sin(ang);
        const double den = are * are + aim * aim, cr = ((lre - 1.0) * are + lim * aim) / den, ci = (lim * are - (lre - 1.0) * aim) / den;
        float* LAM = (float*)(F.ws + WS_CONST + C_LAM); float* LAM64 = (float*)(F.ws + WS_CONST + C_LAM64);
        LAM[2 * gt] = (float)lre; LAM[2 * gt + 1] = (float)lim;
        double pr = lre, pi = lim;
#pragma unroll 1
        for (int i = 0; i < 10; ++i) { const double nr = pr * pr - pi * pi, ni = 2.0 * pr * pi; pr = nr; pi = ni; }
        LAM64[2 * gt] = (float)pr; LAM64[2 * gt + 1] = (float)pi;
        bf16_t* BF = (bf16_t*)(F.ws + WS_CONST + C_BF); bf16_t* CF = (bf16_t*)(F.ws + WS_CONST + C_CF);
        const float* bre = ((const float*)(GAS1 const float*)AR.in[11]) + (size_t)gt * 16; const float* bim = ((const float*)(GAS1 const float*)AR.in[12]) + (size_t)gt * 16;
#pragma unroll 1
        for (int c = 0; c < 16; ++c) {
            const double br = (double)bre[c], bi = (double)bim[c];
            const float bbr = (float)(cr * br - ci * bi), bbi = (float)(cr * bi + ci * br);
            const int q = c >> 2, jj = c & 3;
            { const int row = p, pt = row >> 4, ps = row & 15; BF[((size_t)(g * 8 + pt) * 64 + 16 * q + ps) * 4 + jj] = (bf16_t)(cvt_pk_bf16(bbr, 0.f) & 0xffffu); }
            { const int row = 64 + p, pt = row >> 4, ps = row & 15; BF[((size_t)(g * 8 + pt) * 64 + 16 * q + ps) * 4 + jj] = (bf16_t)(cvt_pk_bf16(bbi, 0.f) & 0xffffu); }
            const float cre = ((const float*)(GAS1 const float*)AR.in[13])[(size_t)(g * 16 + c) * 64 + p], cim = ((const float*)(GAS1 const float*)AR.in[14])[(size_t)(g * 16 + c) * 64 + p];
            const int ks = p >> 4, qq = (p >> 2) & 3, jb = 2 * (p & 3);
            CF[((size_t)(g * 4 + ks) * 64 + 16 * qq + c) * 8 + jb] = (bf16_t)(cvt_pk_bf16(cre, 0.f) & 0xffffu);
            CF[((size_t)(g * 4 + ks) * 64 + 16 * qq + c) * 8 + jb + 1] = (bf16_t)(cvt_pk_bf16(-cim, 0.f) & 0xffffu);
        }
    }
    if (gt < 16 * 256) {
        const int h = gt >> 8, idx = gt & 255; float v = 0.f;
        if (idx < 255) { const int rel = idx - 191; int n = -rel; const int ret = n < 0 ? 16 : 0; n = n < 0 ? -n : n;
            const int large = 8 + (n >= 12) + (n >= 16) + (n >= 23) + (n >= 32) + (n >= 46) + (n >= 64) + (n >= 91);
            const int bucket = ret + (n < 8 ? n : large); v = ((const float*)(GAS1 const float*)AR.in[21])[bucket * 16 + h] * LOG2E; }
        ((float*)(F.ws + WS_CONST + C_BT))[gt] = v;
    }
}

#undef AR
__device__ __forceinline__ void p1_late_weights(Frame& F, int rank, int nrank) {
    const KArgs ARp = kargs_fresh();
    LAS float* scr = (LAS float*)(F.lds + F.wave * 16384);
    const float* w_glu = (const float*)(GAS1 const float*)ARp->in[16]; const float* w_oa = (const float*)(GAS1 const float*)ARp->in[22];
    const float* w_ob = (const float*)(GAS1 const float*)ARp->in[23]; const float* w_o = (const float*)(GAS1 const float*)ARp->in[24];
    bf16_t* WGLU = (bf16_t*)(F.ws + WS_WGLU); bf16_t* WOUT = (bf16_t*)(F.ws + WS_WOUT); bf16_t* WO = (bf16_t*)(F.ws + WS_WO);
    constexpr int I_GLU = (1024 / 64) * (1024 / 32), I_OA = (1024 / 64) * (DM / 32), I_O = (DM / 64) * (DM / 32);
    for (int it = rank * 8 + F.wave; it < I_GLU + 2 * I_OA + I_O; it += nrank * 8) {
        int r = it;
        if (r < I_GLU) { p0_transpose_item<false>(w_glu, 1024, WGLU, LD1, 0, scr, r, F.lane, F.ws + WS_W8GLU, LD8A); continue; } r -= I_GLU;
        if (r < I_OA) { p0_transpose_item<false>(w_oa, DM, WOUT, LD2, 0, scr, r, F.lane, F.ws + WS_W8OUT, LD8B); continue; } r -= I_OA;
        if (r < I_OA) { p0_transpose_item<false>(w_ob, DM, WOUT, LD2, 1024, scr, r, F.lane, F.ws + WS_W8OUT, LD8B); continue; } r -= I_OA;
        p0_transpose_item<false>(w_o, DM, WO, LD2, 0, scr, r, F.lane, F.ws + WS_W8O, LD8B);
    }
}

constexpr int SSM_UROW = 272, SSM_UT = 64 * SSM_UROW, SSM_BU = 128 * 80, SSM_HC = 16 * 272;
template <bool FULL>
__device__ __forceinline__ void ssm_unit(Frame& F, const float* ssm_d, const bf16_t* U, bf16_t* Uo, int rowbase, int T, int gs, const float* hin_re, const float* hin_im, float* hout_re, float* hout_im) {
    LAS unsigned char* ut = F.lds;
    LAS unsigned char* bu = F.lds + SSM_UT + F.wave * SSM_BU;
    LAS unsigned char* hc = F.lds + SSM_UT + 8 * SSM_BU + F.wave * SSM_HC;
    const int lane = F.lane, w = F.wave, fr = lane & 15, fq = lane >> 4, g = gs * 8 + w;
#pragma unroll
    for (int i = 0; i < 2; ++i) { const int idx = F.tid + 512 * i, row = idx >> 4, ch = idx & 15;
        u32x4 v = (u32x4){0u, 0u, 0u, 0u};
        if (row < T) v = *(const u32x4*)(U + (size_t)(rowbase + row) * LD1 + gs * 128 + ch * 8);
        *(LAS u32x4*)(ut + row * SSM_UROW + ch * 16) = v; }
    const f32x2 lam = ((const f32x2*)(F.ws + WS_CONST + C_LAM))[g * 64 + lane];
    u32x2 bfr[8];
#pragma unroll
    for (int pt = 0; pt < 8; ++pt) bfr[pt] = ((const u32x2*)(F.ws + WS_CONST + C_BF))[(size_t)(g * 8 + pt) * 64 + lane];
    u32x4 cfr[4]; float dsk = 0.f;
    if (FULL) {
#pragma unroll
        for (int ks = 0; ks < 4; ++ks) cfr[ks] = ((const u32x4*)(F.ws + WS_CONST + C_CF))[(size_t)(g * 4 + ks) * 64 + lane];
        dsk = ssm_d[g * 16 + fr];
    }
    float hre = 0.f, him = 0.f;
    if (FULL && hin_re) { hre = hin_re[lane]; him = hin_im[lane]; }
    __syncthreads();
    const int nsb = T >> 4;
    for (int sb = 0; sb < nsb; ++sb) {
        const s16x4 af = __builtin_bit_cast(s16x4, *(const LAS u32x2*)(ut + (16 * sb + fr) * SSM_UROW + w * 32 + fq * 8));
#pragma unroll
        for (int pt = 0; pt < 8; ++pt) {
            const f32x4 d = __builtin_amdgcn_mfma_f32_16x16x16bf16_1k(af, __builtin_bit_cast(s16x4, bfr[pt]), (f32x4){0.f, 0.f, 0.f, 0.f}, 0, 0, 0);
            *(LAS f32x4*)(bu + (16 * pt + fr) * 80 + fq * 16) = d;
        }
        asm volatile("s_waitcnt lgkmcnt(0)" ::: "memory");
        f32x4 br[4], bi[4];
#pragma unroll
        for (int k = 0; k < 4; ++k) { br[k] = *(const LAS f32x4*)(bu + lane * 80 + k * 16); bi[k] = *(const LAS f32x4*)(bu + (64 + lane) * 80 + k * 16); }
#pragma unroll
        for (int t = 0; t < 16; ++t) {
            const float nre = lam.x * hre - lam.y * him + br[t >> 2][t & 3];
            const float nim = lam.x * him + lam.y * hre + bi[t >> 2][t & 3];
            hre = nre; him = nim;
            if (FULL) *(LAS unsigned*)(hc + t * 272 + lane * 4) = cvt_pk_bf16(hre, him);
        }
        if (FULL) {
            asm volatile("s_waitcnt lgkmcnt(0)" ::: "memory");
            f32x4 y = (f32x4){0.f, 0.f, 0.f, 0.f};
#pragma unroll
            for (int ks = 0; ks < 4; ++ks) {
                const bf16x8 a = *(const LAS bf16x8*)(hc + fr * 272 + ks * 64 + fq * 16);
                y = __builtin_amdgcn_mfma_f32_16x16x32_bf16(a, __builtin_bit_cast(bf16x8, cfr[ks]), y, 0, 0, 0);
            }
#pragma unroll
            for (int r = 0; r < 4; ++r) {
                LAS unsigned short* up = (LAS unsigned short*)(ut + (16 * sb + 4 * fq + r) * SSM_UROW + w * 32 + fr * 2);
                const float uv = bf2f(*up);
                *up = (unsigned short)(cvt_pk_bf16(geluf_(y[r] + dsk * uv), 0.f) & 0xffffu);
            }
            asm volatile("s_waitcnt lgkmcnt(0)" ::: "memory");
        }
    }
    if (hout_re) { hout_re[lane] = hre; hout_im[lane] = him; }
    if (FULL) {
        __syncthreads();
#pragma unroll
        for (int i = 0; i < 2; ++i) { const int idx = F.tid + 512 * i, row = idx >> 4, ch = idx & 15;
            if (row < T) *(u32x4*)(Uo + (size_t)(rowbase + row) * LD1 + gs * 128 + ch * 8) = *(const LAS u32x4*)(ut + row * SSM_UROW + ch * 16); }
    }
    __syncthreads();
}

template <bool FULL, int VAR = 0>
__device__ __forceinline__ void ssm_phase(Frame& F, const float* ssm_d, const bf16_t* U, bf16_t* Uo, float* Sseg, float* outre, float* outim, unsigned char* G8) {
    LAS unsigned char* ut = F.lds;
    LAS unsigned char* bu = F.lds + SSM_UT + F.wave * SSM_BU;
    LAS unsigned char* hc = F.lds + SSM_UT + 8 * SSM_BU + F.wave * SSM_HC;
    const int lane = F.lane, w = F.wave, fr = lane & 15, fq = lane >> 4;
    const int trow = F.tid >> 4, tch = F.tid & 15;
    for (int item = blockIdx.x; item < NBATCH * 4 * 8; item += ((int)gridDim.x)) {
        const int gs = item & 7, bs = item >> 3, b = bs >> 2, seg = bs & 3, g = gs * 8 + w;
        if (!FULL && seg == 3) continue;
        const f32x2 lam = ((const f32x2*)(F.ws + WS_CONST + C_LAM))[g * 64 + lane];
        u32x2 bfr[8];
#pragma unroll
        for (int pt = 0; pt < 8; ++pt) bfr[pt] = ((const u32x2*)(F.ws + WS_CONST + C_BF))[(size_t)(g * 8 + pt) * 64 + lane];
        u32x4 cfr[4]; float dsk = 0.f;
        float hre = 0.f, him = 0.f;
        if (FULL) {
#pragma unroll
            for (int ks = 0; ks < 4; ++ks) cfr[ks] = ((const u32x4*)(F.ws + WS_CONST + C_CF))[(size_t)(g * 4 + ks) * 64 + lane];
            dsk = ssm_d[g * 16 + fr];
            const f32x2 lk = ((const f32x2*)(F.ws + WS_CONST + C_LAM64))[g * 64 + lane];
            for (int sp = 0; sp < seg; ++sp) { const float* sp_ = Sseg + ((size_t)((b * 4 + sp) * NGRP + g)) * 128 + lane; const float sre = sp_[0], sim = sp_[64];
                const float nre = lk.x * hre - lk.y * him + sre, nim = lk.x * him + lk.y * hre + sim; hre = nre; him = nim; }
        }
        f32x2 hh = {hre, him}; const f32x2 lrr = {lam.x, lam.x}, lix = {-lam.y, lam.y};
        const int bj0 = b * 64 + seg * 16;
        u32x4 pre0, pre1;
        { const bf16_t* up = U + (size_t)(bj0 * 64 + trow) * LD1 + gs * 128 + tch * 8; pre0 = *(const u32x4*)up; pre1 = *(const u32x4*)(up + (size_t)32 * LD1); }
        for (int k = 0; k < 16; ++k) {
            const int bj = bj0 + k;
            *(LAS u32x4*)(ut + trow * SSM_UROW + tch * 16) = pre0;
            *(LAS u32x4*)(ut + (trow + 32) * SSM_UROW + tch * 16) = pre1;
            __syncthreads();
            if (k < 15) { const bf16_t* up = U + (size_t)((bj + 1) * 64 + trow) * LD1 + gs * 128 + tch * 8; pre0 = *(const u32x4*)up; pre1 = *(const u32x4*)(up + (size_t)32 * LD1); }
            u32x4 za0 = (u32x4){0u, 0u, 0u, 0u}, za1 = za0;
            if (FULL) { const bf16_t* zp = U + (size_t)(WS_ZA - WS_U) / 2 + (size_t)(bj * 64 + trow) * LD1 + gs * 128 + tch * 8; za0 = *(const u32x4*)zp; za1 = *(const u32x4*)(zp + (size_t)32 * LD1); }
#define SSM_FENCE() asm volatile("" ::: "memory")
            f32x4 dA[8];
#define SSM_A_MFMA(sb_) do { const s16x4 af_ = __builtin_bit_cast(s16x4, *(const LAS u32x2*)(ut + (16 * (sb_) + fr) * SSM_UROW + w * 32 + fq * 8)); \
                _Pragma("unroll") for (int pt = 0; pt < 8; ++pt) dA[pt] = __builtin_amdgcn_mfma_f32_16x16x16bf16_1k(af_, __builtin_bit_cast(s16x4, bfr[pt]), (f32x4){0.f, 0.f, 0.f, 0.f}, 0, 0, 0); } while (0)
#define SSM_SWAP32(x_, y_) do { const auto r_ = __builtin_amdgcn_permlane32_swap(__float_as_uint(x_), __float_as_uint(y_), false, false); x_ = __uint_as_float(r_[0]); y_ = __uint_as_float(r_[1]); } while (0)
#define SSM_SWAP16(x_, y_) do { const auto r_ = __builtin_amdgcn_permlane16_swap(__float_as_uint(x_), __float_as_uint(y_), false, false); x_ = __uint_as_float(r_[0]); y_ = __uint_as_float(r_[1]); } while (0)
#define SSM_TRANSPOSE() do { _Pragma("unroll") for (int c_ = 0; c_ < 2; ++c_) _Pragma("unroll") for (int r_i = 0; r_i < 4; ++r_i) { \
                float x0 = dA[4 * c_][r_i], x1 = dA[4 * c_ + 1][r_i], x2 = dA[4 * c_ + 2][r_i], x3 = dA[4 * c_ + 3][r_i]; \
                SSM_SWAP32(x0, x2); SSM_SWAP32(x1, x3); SSM_SWAP16(x0, x1); SSM_SWAP16(x2, x3); \
                bN[4 * c_][r_i] = x0; bN[4 * c_ + 1][r_i] = x1; bN[4 * c_ + 2][r_i] = x2; bN[4 * c_ + 3][r_i] = x3; } } while (0)
            f32x4 bN[8];
            if (VAR != 5) {
            SSM_A_MFMA(0); SSM_TRANSPOSE();
            bf16x8 ca[4];
#pragma unroll
            for (int sb = 0; sb < 4; ++sb) {
                f32x4 bv[8];
#pragma unroll
                for (int kk = 0; kk < 8; ++kk) bv[kk] = bN[kk];
                if (FULL && sb > 0 && VAR != 6 && VAR != 7) {
#pragma unroll
                    for (int ks = 0; ks < 4; ++ks) ca[ks] = *(const LAS bf16x8*)(hc + fr * 272 + ks * 64 + fq * 16);
                }
                SSM_FENCE();
                if (sb < 3) SSM_A_MFMA(sb + 1);
                f32x4 y = (f32x4){0.f, 0.f, 0.f, 0.f};
                if (FULL && sb > 0 && VAR != 6 && VAR != 7) {
#pragma unroll
                    for (int ks = 0; ks < 4; ++ks) y = __builtin_amdgcn_mfma_f32_16x16x32_bf16(ca[ks], __builtin_bit_cast(bf16x8, cfr[ks]), y, 0, 0, 0);
                }
                SSM_FENCE();
#pragma unroll
                for (int t = 0; t < 16; ++t) {
                    const float bre_ = bv[t >> 2][t & 3], bim_ = bv[4 + (t >> 2)][t & 3];
                    if (VAR != 1) { const float nre_ = __builtin_fmaf(lrr.x, hh.x, __builtin_fmaf(lix.x, hh.y, bre_)), nim_ = __builtin_fmaf(lrr.x, hh.y, __builtin_fmaf(lix.y, hh.x, bim_));
                    hh.x = nre_; hh.y = nim_; } else { hh.x += bre_; hh.y += bim_ * 0.5f; }
                    if (FULL && VAR != 7) *(LAS unsigned*)(hc + t * 272 + lane * 4) = cvt_pk_bf16_nv(hh.x, hh.y);
                }
                SSM_FENCE();
                if (sb < 3) SSM_TRANSPOSE();
                if (FULL && sb > 0 && VAR != 6 && VAR != 7) {
#pragma unroll
                    for (int r = 0; r < 4; ++r) {
                        LAS unsigned short* up = (LAS unsigned short*)(ut + (16 * (sb - 1) + 4 * fq + r) * SSM_UROW + w * 32 + fr * 2);
                        const float uv = bf2f(*up);
                        *up = (unsigned short)(cvt_pk_bf16_nv((VAR == 2 ? (y[r] + dsk * uv) : geluf_(y[r] + dsk * uv)), 0.f) & 0xffffu);
                    }
                    SSM_FENCE();
                }
            }
            if (FULL && VAR != 6 && VAR != 7) {
                f32x4 y = (f32x4){0.f, 0.f, 0.f, 0.f};
#pragma unroll
                for (int ks = 0; ks < 4; ++ks) {
                    const bf16x8 a = *(const LAS bf16x8*)(hc + fr * 272 + ks * 64 + fq * 16);
                    y = __builtin_amdgcn_mfma_f32_16x16x32_bf16(a, __builtin_bit_cast(bf16x8, cfr[ks]), y, 0, 0, 0);
                }
#pragma unroll
                for (int r = 0; r < 4; ++r) {
                    LAS unsigned short* up = (LAS unsigned short*)(ut + (16 * 3 + 4 * fq + r) * SSM_UROW + w * 32 + fr * 2);
                    const float uv = bf2f(*up);
                    *up = (unsigned short)(cvt_pk_bf16_nv((VAR == 2 ? (y[r] + dsk * uv) : geluf_(y[r] + dsk * uv)), 0.f) & 0xffffu);
                }
                SSM_FENCE();
            }
            }
#undef SSM_A_MFMA
#undef SSM_TRANSPOSE
#undef SSM_SWAP32
#undef SSM_SWAP16
            if (FULL) {
                __syncthreads();
                bf16_t* op = Uo + (size_t)(bj * 64 + trow) * LD1 + gs * 128 + tch * 8;
                const u32x4 g0 = *(const LAS u32x4*)(ut + trow * SSM_UROW + tch * 16), g1 = *(const LAS u32x4*)(ut + (trow + 32) * SSM_UROW + tch * 16);
                { u32x4 z0, z1;
                  z0.x = cvt_pk_bf16(bflo(g0.x) * bflo(za0.x), bfhi(g0.x) * bfhi(za0.x)); z0.y = cvt_pk_bf16(bflo(g0.y) * bflo(za0.y), bfhi(g0.y) * bfhi(za0.y));
                  z0.z = cvt_pk_bf16(bflo(g0.z) * bflo(za0.z), bfhi(g0.z) * bfhi(za0.z)); z0.w = cvt_pk_bf16(bflo(g0.w) * bflo(za0.w), bfhi(g0.w) * bfhi(za0.w));
                  z1.x = cvt_pk_bf16(bflo(g1.x) * bflo(za1.x), bfhi(g1.x) * bfhi(za1.x)); z1.y = cvt_pk_bf16(bflo(g1.y) * bflo(za1.y), bfhi(g1.y) * bfhi(za1.y));
                  z1.z = cvt_pk_bf16(bflo(g1.z) * bflo(za1.z), bfhi(g1.z) * bfhi(za1.z)); z1.w = cvt_pk_bf16(bflo(g1.w) * bflo(za1.w), bfhi(g1.w) * bfhi(za1.w));
                  *(u32x4*)op = z0; *(u32x4*)(op + (size_t)32 * LD1) = z1; }
                unsigned char* o8 = G8 + (size_t)(bj * 64 + trow) * LD8A + gs * 128 + tch * 8;
                u32x2 e0, e1;
                e0.x = pk4_fp8(bflo(g0.x) * F8_G, bfhi(g0.x) * F8_G, bflo(g0.y) * F8_G, bfhi(g0.y) * F8_G); e0.y = pk4_fp8(bflo(g0.z) * F8_G, bfhi(g0.z) * F8_G, bflo(g0.w) * F8_G, bfhi(g0.w) * F8_G);
                e1.x = pk4_fp8(bflo(g1.x) * F8_G, bfhi(g1.x) * F8_G, bflo(g1.y) * F8_G, bfhi(g1.y) * F8_G); e1.y = pk4_fp8(bflo(g1.z) * F8_G, bfhi(g1.z) * F8_G, bflo(g1.w) * F8_G, bfhi(g1.w) * F8_G);
                *(u32x2*)o8 = e0; *(u32x2*)(o8 + (size_t)32 * LD8A) = e1;
            }
            __syncthreads();
        }
        if (!FULL) { float* so = Sseg + ((size_t)((b * 4 + seg) * NGRP + g)) * 128 + lane; so[0] = hh.x; so[64] = hh.y; }
        if (FULL && seg == 3) { outre[(size_t)(b * 64 + g) * 64 + lane] = hh.x; outim[(size_t)(b * 64 + g) * 64 + lane] = hh.y; }
    }
}

constexpr int AT_K = 0, AT_V = 24576, AT_BT = 49152, AT_BTC = 8192 + 64, AT_OST = AT_BT + 4 * AT_BTC;
__device__ __forceinline__ int crow(int r, int hi) { return (r & 3) + 8 * (r >> 2) + 4 * hi; }
struct AttnUnit {
    int kvrow[3];
    const float* ck; const float* cv;
    int nkeys[3];
    int qrow0, nq, kvh;
};
__device__ __forceinline__ void attn_unit(Frame& F, const float* sinks, const float* qgain, const float* kgain, const AttnUnit& A, bf16_t* Q, unsigned char* BR8, const bf16_t* Kb, const bf16_t* Vb, const bf16_t* ZB) {
    const int lane = F.lane, w = F.wave, r32 = lane & 31, hi = lane >> 5, h = A.kvh * 8 + w;
    LAS unsigned char* lds = F.lds;
    bf16x8 qr[4];
    { const bf16_t* Qw = Q + (size_t)(A.qrow0 + r32) * LD1 + h * 64;
#pragma unroll
      for (int d0 = 0; d0 < 4; ++d0) qr[d0] = *(const bf16x8*)(Qw + d0 * 16 + hi * 8); }
#pragma unroll
    for (int s = 0; s < 3; ++s) {
        if (A.nkeys[s] == 0) continue;
        u32x4 kw = (u32x4){0u, 0u, 0u, 0u}, vw = (u32x4){0u, 0u, 0u, 0u};
        const int vrow = 16 * (w & 3) + (lane >> 2);
        if (A.kvrow[s] >= 0) {
            const size_t krow = (size_t)A.kvrow[s];
            if (lane < A.nkeys[s]) kw = *(const u32x4*)(Kb + (krow + lane) * 128 + A.kvh * 64 + w * 8);
            if (vrow < A.nkeys[s]) vw = *(const u32x4*)(Vb + (krow + vrow) * 128 + A.kvh * 64 + (w >> 2) * 32 + (lane & 3) * 8);
        } else {
            const float* kp = A.ck + ((size_t)(64 * s + lane) * 2 + A.kvh) * 64 + w * 8;
            const f32x4 k0 = *(const f32x4*)kp, k1 = *(const f32x4*)(kp + 4); kw = pack8(k0, k1);
            const float* vp = A.cv + ((size_t)(64 * s + vrow) * 2 + A.kvh) * 64 + (w >> 2) * 32 + (lane & 3) * 8;
            const f32x4 v0 = *(const f32x4*)vp, v1 = *(const f32x4*)(vp + 4); vw = pack8(v0, v1);
        }
        *(LAS u32x4*)(lds + AT_K + s * 8192 + w * 1024 + lane * 16) = kw;
        *(LAS u32x4*)(lds + AT_V + s * 8192 + w * 1024 + lane * 16) = vw;
    }
#pragma unroll
    for (int i = 0; i < 4; ++i) { const int idx = F.tid + 512 * i; ((LAS float*)(lds + AT_BT))[idx] = ((const float*)(F.ws + WS_CONST + C_BT))[A.kvh * 2048 + idx]; }
    __syncthreads();
    const float sink = sinks[h] * LOG2E;
    LAS float* btw = (LAS float*)(lds + AT_BT) + w * 256;
    float mref;
    { float gq = fabsf(qgain[lane]), gk = fabsf(kgain[lane]), bm = fmaxf(fmaxf(btw[lane], btw[lane + 64]), fmaxf(btw[lane + 128], lane + 192 < 255 ? btw[lane + 192] : -INFINITY));
#pragma unroll
      for (int o_ = 1; o_ < 64; o_ <<= 1) { gq = fmaxf(gq, __shfl_xor(gq, o_)); gk = fmaxf(gk, __shfl_xor(gk, o_)); bm = fmaxf(bm, __shfl_xor(bm, o_)); }
      mref = fmaxf(sink, 8.0f * LOG2E * gq * gk * 1.0001f + bm); }
    asm volatile("s_waitcnt lgkmcnt(0)" ::: "memory");
    { float tv[4];
#pragma unroll
      for (int i = 0; i < 4; ++i) tv[i] = btw[lane + 64 * i] - mref;
      asm volatile("" ::: "memory");
#pragma unroll
      for (int i = 0; i < 4; ++i)
#pragma unroll
          for (int j = 0; j < 4; ++j) { const int pos = lane + 64 * i - j; if (pos >= 0) ((LAS float*)((LAS unsigned char*)btw + j * AT_BTC))[pos] = tv[i]; } }
    asm volatile("s_waitcnt lgkmcnt(0)" ::: "memory");
    const int sft = (3 - r32) & 3;
    const LAS float* bt = (const LAS float*)((const LAS unsigned char*)btw + sft * AT_BTC) + (63 - r32 + 4 * hi - sft);
    const float esink = __builtin_amdgcn_exp2f(sink - mref), oscale = (A.nq == 16) ? 1.0f : F8_BR;
    const int nqt = (A.nq + 31) >> 5;
    for (int qt = 0; qt < nqt; ++qt) {
        f32x16 p[6];
        const int qoff = 32 * qt + r32;
#pragma unroll
        for (int kt = 0; kt < 6; ++kt) {
            const int s = kt >> 1, nk = A.nkeys[s] - 32 * (kt & 1);
            if (nk <= 0) {
#pragma unroll
                for (int r = 0; r < 16; ++r) p[kt][r] = -INFINITY;
                continue;
            }
            f32x16 c;
#pragma unroll
            for (int g4 = 0; g4 < 4; ++g4) { const f32x4 bv4 = *(const LAS f32x4*)(bt + 32 * kt + 8 * g4 - 32 * qt);
                c[4 * g4] = bv4[0]; c[4 * g4 + 1] = bv4[1]; c[4 * g4 + 2] = bv4[2]; c[4 * g4 + 3] = bv4[3]; }
            const LAS unsigned char* kb = lds + AT_K + s * 8192 + hi * 1024 + r32 * 16 + (kt & 1) * 512;
#pragma unroll
            for (int d0 = 0; d0 < 4; ++d0) c = __builtin_amdgcn_mfma_f32_32x32x16_bf16(*(const LAS bf16x8*)(kb + d0 * 2048), qr[d0], c, 0, 0, 0);
            if (nk < 32) {
#pragma unroll
                for (int r = 0; r < 16; ++r) if (crow(r, hi) >= nk) c[r] = -INFINITY;
            }
            p[kt] = c;
        }
        if (qt + 1 < nqt) { const bf16_t* Qw = Q + (size_t)(A.qrow0 + 32 * (qt + 1) + r32) * LD1 + h * 64;
#pragma unroll
            for (int d0 = 0; d0 < 4; ++d0) qr[d0] = *(const bf16x8*)(Qw + d0 * 16 + hi * 8); }
        u32x4 zbv[4];
#pragma unroll
        for (int kt = 0; kt < 6; ++kt)
#pragma unroll
            for (int r = 0; r < 16; ++r) p[kt][r] = __builtin_amdgcn_exp2f(p[kt][r]);
        f32x16 o[2]; o[0] = (f32x16){}; o[1] = (f32x16){};
        f32x16 ls;
#pragma unroll
        for (int r = 0; r < 16; ++r) ls[r] = esink;
        const bf16x8 ones8 = (bf16x8){(short)0x3F80, (short)0x3F80, (short)0x3F80, (short)0x3F80, (short)0x3F80, (short)0x3F80, (short)0x3F80, (short)0x3F80};
        const int vb0 = ((lane >> 4) & 1) * 32 + (lane & 3) * 8 + (4 * hi + ((lane & 15) >> 2)) * 64;
#pragma unroll
        for (int kt = 0; kt < 6; ++kt) {
            const int s = kt >> 1;
            if (kt == 4) {
#pragma unroll
                for (int i = 0; i < 4; ++i) zbv[i] = *(const u32x4*)(ZB + (size_t)(A.qrow0 + 32 * qt + i * 8 + (lane >> 3)) * LD1 + h * 64 + (lane & 7) * 8); }
            if (A.nkeys[s] - 32 * (kt & 1) <= 0) continue;
#pragma unroll
            for (int ss = 0; ss < 2; ++ss) {
                u32x4 pw; pw.x = cvt_pk_bf16_b(p[kt][8 * ss + 0], p[kt][8 * ss + 1]); pw.y = cvt_pk_bf16_b(p[kt][8 * ss + 2], p[kt][8 * ss + 3]);
                pw.z = cvt_pk_bf16_b(p[kt][8 * ss + 4], p[kt][8 * ss + 5]); pw.w = cvt_pk_bf16_b(p[kt][8 * ss + 6], p[kt][8 * ss + 7]);
                const int ks = 2 * (kt & 1) + ss;
                ls = __builtin_amdgcn_mfma_f32_32x32x16_bf16(__builtin_bit_cast(bf16x8, pw), ones8, ls, 0, 0, 0);
#pragma unroll
                for (int d0 = 0; d0 < 2; ++d0) {
                    const LAS unsigned char* vp = lds + AT_V + s * 8192 + d0 * 4096 + ks * 1024 + vb0;
                    const s16x4 lo = __builtin_bit_cast(s16x4, __builtin_amdgcn_ds_read_tr16_b64_v4i16((LAS s16x4*)vp));
                    const s16x4 hi4 = __builtin_bit_cast(s16x4, __builtin_amdgcn_ds_read_tr16_b64_v4i16((LAS s16x4*)(vp + 512)));
                    const bf16x8 vf = (bf16x8){lo[0], lo[1], lo[2], lo[3], hi4[0], hi4[1], hi4[2], hi4[3]};
                    o[d0] = __builtin_amdgcn_mfma_f32_32x32x16_bf16(__builtin_bit_cast(bf16x8, pw), vf, o[d0], 0, 0, 0);
                }
            }
        }
        asm volatile("" ::: "memory");
        LAS bf16_t* stg = (LAS bf16_t*)(lds + AT_OST) + w * 2048;
#pragma unroll
        for (int r = 0; r < 16; ++r) { const int orow = crow(r, hi); const float rl = __builtin_amdgcn_rcpf(ls[r]) * oscale;
            const unsigned pk = cvt_pk_bf16(o[0][r] * rl, o[1][r] * rl);
            stg[orow * 64 + r32] = (bf16_t)(pk & 0xffffu); stg[orow * 64 + 32 + r32] = (bf16_t)(pk >> 16); }
        asm volatile("s_waitcnt lgkmcnt(0)" ::: "memory");
#pragma unroll
        for (int i = 0; i < 4; ++i) { const int row = i * 8 + (lane >> 3), ch = lane & 7;
            if (32 * qt + row < A.nq) {
                const size_t off = (size_t)(A.qrow0 + 32 * qt + row) * LD1 + h * 64 + ch * 8;
                const u32x4 ov = *(const LAS u32x4*)(stg + row * 64 + ch * 8), zv = zbv[i];
                if (A.nq == 16) {
                    u32x4 res; res.x = cvt_pk_bf16(bflo(ov.x) * bflo(zv.x), bfhi(ov.x) * bfhi(zv.x)); res.y = cvt_pk_bf16(bflo(ov.y) * bflo(zv.y), bfhi(ov.y) * bfhi(zv.y));
                    res.z = cvt_pk_bf16(bflo(ov.z) * bflo(zv.z), bfhi(ov.z) * bfhi(zv.z)); res.w = cvt_pk_bf16(bflo(ov.w) * bflo(zv.w), bfhi(ov.w) * bfhi(zv.w));
                    *(u32x4*)(Q + off) = res;
                } else {
                    u32x2 e; e.x = pk4_fp8(bflo(ov.x) * bflo(zv.x), bfhi(ov.x) * bfhi(zv.x), bflo(ov.y) * bflo(zv.y), bfhi(ov.y) * bfhi(zv.y));
                    e.y = pk4_fp8(bflo(ov.z) * bflo(zv.z), bfhi(ov.z) * bfhi(zv.z), bflo(ov.w) * bflo(zv.w), bfhi(ov.w) * bfhi(zv.w));
                    *(u32x2*)(BR8 + (size_t)(A.qrow0 + 32 * qt + row) * LD8B + 1024 + h * 64 + ch * 8) = e; } } }
        asm volatile("s_waitcnt lgkmcnt(0)" ::: "memory");
    }
    __syncthreads();
}

template <int MODE>
__device__ __forceinline__ void sample_gemm(Frame& F, const bf16_t* A, const bf16_t* A2, int lda, const bf16_t* Wt, int ldb, int K, int N,
                                            const bf16_t* P0, const bf16_t* P1, const float* PF, void* OUT, int it0, int itstep) {
    const int lane = F.lane, w = F.wave, fr = lane & 15, fq = lane >> 4;
    LAS float* red = (LAS float*)F.lds;
    const int kper = K / 8, nks = kper / 32;
    for (int it = it0; it < N / 16; it += itstep) {
        const int k0 = w * kper;
        const bf16_t* Ab = (MODE == 1 && w >= 4) ? A2 + (size_t)MP * lda + (k0 - 1024) : A + (size_t)MP * lda + k0;
        const bf16_t* Bb = Wt + (size_t)(16 * it + fr) * ldb + k0 + 8 * fq;
        f32x4 acc[8];
#pragma unroll
        for (int mt = 0; mt < 8; ++mt) acc[mt] = (f32x4){0.f, 0.f, 0.f, 0.f};
        for (int ks = 0; ks < nks; ++ks) {
            const bf16x8 bfrag = *(const bf16x8*)(Bb + ks * 32);
#pragma unroll
            for (int mt = 0; mt < 8; ++mt) {
                const bf16x8 afrag = *(const bf16x8*)(Ab + (size_t)(16 * mt + fr) * lda + ks * 32 + 8 * fq);
                acc[mt] = __builtin_amdgcn_mfma_f32_16x16x32_bf16(afrag, bfrag, acc[mt], 0, 0, 0);
            }
        }
#pragma unroll
        for (int mt = 0; mt < 8; ++mt)
#pragma unroll
            for (int r = 0; r < 4; ++r) red[((w * 8 + mt) * 4 + r) * 64 + lane] = acc[mt][r];
        __syncthreads();
#pragma unroll
        for (int r = 0; r < 4; ++r) {
            float sa = 0.f, sb = 0.f;
#pragma unroll
            for (int ww = 0; ww < 8; ++ww) { const float v = red[((ww * 8 + w) * 4 + r) * 64 + lane]; if (MODE == 1 && ww >= 4) sb += v; else sa += v; }
            const int row = 16 * w + 4 * fq + r, col = 16 * it + fr;
            if (MODE == 0) {
                const size_t o = (size_t)(MP + row) * LD1 + col;
                const float val = sa + PF[col];
                ((bf16_t*)OUT)[o] = (bf16_t)(cvt_pk_bf16(bf2f(P0[o]) * sigmoidf_(val) * bf2f(((const bf16_t*)OUT)[o]), 0.f) & 0xffffu);
            } else if (MODE == 1) {
                const size_t o = (size_t)(MP + row) * LD2 + col;
                const float v = (sa * bf2f(P0[o]) + sb) * bf2f(P1[o]);
                ((bf16_t*)OUT)[o] = (bf16_t)(cvt_pk_bf16(v, 0.f) & 0xffffu);
            } else {
                ((float*)OUT)[(size_t)row * DM + col] = PF[(size_t)row * DM + col] + sa;
            }
        }
        __syncthreads();
    }
}

__global__ void __launch_bounds__(512, 2) mk_fwd(Args args) {
    extern __shared__ __attribute__((aligned(16))) unsigned char lds_raw[];
    Frame F;
    F.lds = (LAS unsigned char*)lds_raw;
    F.wave = __builtin_amdgcn_readfirstlane((int)threadIdx.x >> 6); F.lane = lane_id_fresh(); F.tid = F.wave * 64 + F.lane;
#define LEADER (F.wave == 0 && lane_id_fresh() == 0)
#define REFRESH() do { F.lane = lane_id_fresh(); F.tid = F.wave * 64 + F.lane; } while (0)
    { const KArgs ka_ = kargs_fresh(); F.out = (float*)(GAS1 float*)ka_->out; F.ws = (unsigned char*)(GAS1 unsigned char*)ka_->ws; }
#if USE_CG_SYNC
    cg::grid_group grid = cg::this_grid();
#endif
#define WSB(off) (ws_fresh(F.ws) + (off))
#define XN ((bf16_t*)WSB(WS_XN))
#define U ((bf16_t*)WSB(WS_U))
#define ZA ((bf16_t*)WSB(WS_ZA))
#define Qb ((bf16_t*)WSB(WS_Q))
#define ZB ((bf16_t*)WSB(WS_ZB))
#define Kb ((bf16_t*)WSB(WS_K))
#define Vb ((bf16_t*)WSB(WS_V))
#define GA ((bf16_t*)WSB(WS_GA))
#define GB ((bf16_t*)WSB(WS_GB))
#define Sst ((float*)WSB(WS_S))
#define DUMMY ((bf16_t*)WSB(WS_DUMMY))
    int lo, hi; { const KArgs ka_ = kargs_fresh(); lo = ka_->ph_lo; hi = ka_->ph_hi; }
    volatile LAS unsigned* misc = (volatile LAS unsigned*)(F.lds + MISC_OFF);
    if (F.tid < 16) misc[F.tid] = 0u;
    __syncthreads();
#define X_BAR (XcdBarrier{(unsigned*)(WSB(WS_CTL)), xb_xcc_id(), misc, (unsigned)gridDim.x})
    if (hi - lo > 1) (void)xcd_barrier_post((unsigned*)(WSB(WS_CTL)), misc, (unsigned)gridDim.x, LEADER);
#ifndef PH_MASK
#define PH_MASK 0xff
#endif
#define IN(k) (((PH_MASK >> (k)) & 1) && lo <= (k) && (k) < hi)
#if USE_CG_SYNC
#define SEAM(k) do { if (IN(k) && IN((k) + 1)) { if ((k) == 0) grid.sync(); else xcd_barrier((unsigned*)(WSB(WS_CTL)), xb_xcc_id(), misc, (unsigned)gridDim.x, LEADER); } } while (0)
#else
#define SEAM(k) do { if (IN(k) && IN((k) + 1)) xcd_barrier((unsigned*)(WSB(WS_CTL)), xb_xcc_id(), misc, (unsigned)gridDim.x, LEADER); } while (0)
#endif

    if (IN(0) && PROBE == 20) { p0_prologue<7>(F); __syncthreads(); }
    if (IN(0) && PROBE == 23) { p0_prologue<1>(F); __syncthreads(); }
    if (IN(0) && PROBE == 26) { p0_prologue<2>(F); __syncthreads(); }
    if (IN(0) && PROBE == 27) { p0_prologue<2 + 8>(F); __syncthreads(); }
    if (IN(0) && PROBE == 28) { p0_prologue<2 + 16>(F); __syncthreads(); }
    if (IN(0)) p0_prologue<7>(F);
    SEAM(0);
    if (IN(1)) {
        {
            pg8::Gemm g{XN, XN, (const bf16_t*)(WSB(WS_WIN)), LD2, LD2, DM, 1 << 20, MROWS / 256, INB_TILES, 0, 0, 0};
            pg8::StaticOrder S; S.init(g.nM, g.nN, ((int)gridDim.x), (int)blockIdx.x, IN8_TILES, MP / 256, 1, 0, WGM_IN16);
            EpiIn E{U, ZA, Qb, ZB, Kb, Vb, GA, GB, ((const float*)(GAS1 const float*)(kargs_fresh()->in[18])), ((const float*)(GAS1 const float*)(kargs_fresh()->in[19])), F.out, false, 0};
            pg8::gemm_phase<EpiIn, true>(F.lds, g, S, E, F.wave);
        }
        {
            pg8::Gemm g{(const bf16_t*)(WSB(WS_XN8)), (const bf16_t*)(WSB(WS_XN8)), (const bf16_t*)(WSB(WS_W8IN)), LD8B / 2, LD8B / 2, 1024, 1 << 20, MP / 256, IN8_TILES, 0, 0, 0};
            pg8::StaticOrder S; S.init(g.nM, g.nN, ((int)gridDim.x), (int)blockIdx.x, 0, 0, 0, 0, WGM_IN8);
            EpiIn E{U, ZA, Qb, ZB, Kb, Vb, GA, GB, ((const float*)(GAS1 const float*)(kargs_fresh()->in[18])), ((const float*)(GAS1 const float*)(kargs_fresh()->in[19])), F.out, false, 17};
            pg8::gemm_phase8<EpiIn, true, E8_X, E8_W>(F.lds, g, S, E, F.wave);
        }
        {
            const int nunits = (MROWS / 256) * INB_TILES + IN8_TILES, G_ = (int)gridDim.x, full = nunits / G_, rem = nunits - full * G_;
            REFRESH();
            if (rem == 0) p1_late_weights(F, (int)blockIdx.x, G_);
            else if ((int)blockIdx.x >= rem) p1_late_weights(F, (int)blockIdx.x - rem, G_ - rem);
            __syncthreads();
        }
    }
    if (IN(1) && PROBE == 9) {
        pg8::Gemm g{XN, XN, (const bf16_t*)(WSB(WS_WIN)), LD2, LD2, DM, 1 << 20, MROWS / 256, NIN / 256, 0, 0, 0};
        pg8::StaticOrder S; S.init(g.nM, g.nN, ((int)gridDim.x), (int)blockIdx.x);
        EpiNull E{(float*)DUMMY};
        pg8::gemm_phase<EpiNull, true>(F.lds, g, S, E, F.wave);
    }
    SEAM(1);
    if (IN(2)) {
        REFRESH();
        if (PROBE == 21) ssm_phase<false>(F, ((const float*)(GAS1 const float*)(kargs_fresh()->in[15])), U, U, Sst, nullptr, nullptr, nullptr);
        ssm_phase<false>(F, ((const float*)(GAS1 const float*)(kargs_fresh()->in[15])), U, U, Sst, nullptr, nullptr, nullptr);
        for (int c2 = blockIdx.x; c2 < 256; c2 += ((int)gridDim.x)) if (((c2 >> 3) & 3) == 3) {
            const int gs = c2 & 7, b = c2 >> 5; const size_t so = (size_t)(b * 64 + gs * 8 + F.wave) * 64;
            ssm_unit<true>(F, ((const float*)(GAS1 const float*)(kargs_fresh()->in[15])), U, U, MP + 16 * b, 16, gs, ((const float*)(GAS1 const float*)(kargs_fresh()->in[4])) + so, ((const float*)(GAS1 const float*)(kargs_fresh()->in[5])) + so, F.out + O_SRE + so, F.out + O_SIM + so);
        }
        constexpr int NAU = NBATCH * NCHUNK * 2 + NBATCH * 2;
        int au0, austep, aulim;
        if (((int)gridDim.x) == 256) { const int c = blockIdx.x, bs = c >> 3;
            if ((bs & 3) == 3) { au0 = ((c >> 5) << 3) + (c & 7); austep = 64; aulim = ATT_S3 * 64; }
            else { au0 = ATT_S3 * 64 + ((((bs >> 2) * 3 + (bs & 3)) << 3) + (c & 7)); austep = 192; aulim = NAU; } }
        else { au0 = blockIdx.x; austep = ((int)gridDim.x); aulim = NAU; }
        for (int rep_ = (PROBE == 24 ? 0 : 1); rep_ < 2; ++rep_)
        for (int it = au0; it < aulim; it += austep) {
            if (rep_ == 0 && it >= NBATCH * NCHUNK * 2) continue;
            AttnUnit A;
            if (it < NBATCH * NCHUNK * 2) {
                const int kvh = it & 1, bc = it >> 1, c = bc & 63;
#pragma unroll
                for (int s = 0; s < 3; ++s) { const int cc = c - 2 + s; A.nkeys[s] = cc >= 0 ? 64 : 0; A.kvrow[s] = cc >= 0 ? (bc - 2 + s) * 64 : 0; }
                A.ck = nullptr; A.cv = nullptr; A.qrow0 = bc * 64; A.nq = 64; A.kvh = kvh;
            } else {
                const int r = it - NBATCH * NCHUNK * 2, kvh = r & 1, b = r >> 1;
                A.nkeys[0] = 64; A.nkeys[1] = 64; A.nkeys[2] = 16; A.kvrow[0] = -1; A.kvrow[1] = -1; A.kvrow[2] = MP + 16 * b;
                A.ck = ((const float*)(GAS1 const float*)(kargs_fresh()->in[2])) + (size_t)b * 128 * 128; A.cv = ((const float*)(GAS1 const float*)(kargs_fresh()->in[3])) + (size_t)b * 128 * 128; A.qrow0 = MP + 16 * b; A.nq = 16; A.kvh = kvh;
            }
            attn_unit(F, ((const float*)(GAS1 const float*)(kargs_fresh()->in[20])), ((const float*)(GAS1 const float*)(kargs_fresh()->in[18])), ((const float*)(GAS1 const float*)(kargs_fresh()->in[19])), A, Qb, WSB(WS_BR8), Kb, Vb, ZB);
        }
    }
    do { if (IN(2) && IN(4)) xcd_barrier((unsigned*)(WSB(WS_CTL)), xb_xcc_id(), misc, (unsigned)gridDim.x, LEADER); } while (0);
    if (IN(4)) {
        REFRESH();
        if (PROBE == 225) ssm_phase<true, 5>(F, ((const float*)(GAS1 const float*)(kargs_fresh()->in[15])), U, (bf16_t*)WSB(WS_MX8), Sst, F.out + O_PRE, F.out + O_PIM, WSB(WS_G8));
        if (PROBE == 226) ssm_phase<true, 6>(F, ((const float*)(GAS1 const float*)(kargs_fresh()->in[15])), U, (bf16_t*)WSB(WS_MX8), Sst, F.out + O_PRE, F.out + O_PIM, WSB(WS_G8));
        if (PROBE == 227) ssm_phase<true, 7>(F, ((const float*)(GAS1 const float*)(kargs_fresh()->in[15])), U, (bf16_t*)WSB(WS_MX8), Sst, F.out + O_PRE, F.out + O_PIM, WSB(WS_G8));
        if (PROBE == 228) ssm_phase<true, 8>(F, ((const float*)(GAS1 const float*)(kargs_fresh()->in[15])), U, (bf16_t*)WSB(WS_MX8), Sst, F.out + O_PRE, F.out + O_PIM, WSB(WS_G8));
        if (PROBE == 221) ssm_phase<true, 1>(F, ((const float*)(GAS1 const float*)(kargs_fresh()->in[15])), U, (bf16_t*)WSB(WS_MX8), Sst, F.out + O_PRE, F.out + O_PIM, WSB(WS_G8));
        if (PROBE == 222) ssm_phase<true, 2>(F, ((const float*)(GAS1 const float*)(kargs_fresh()->in[15])), U, (bf16_t*)WSB(WS_MX8), Sst, F.out + O_PRE, F.out + O_PIM, WSB(WS_G8));
        if (PROBE == 22) ssm_phase<true>(F, ((const float*)(GAS1 const float*)(kargs_fresh()->in[15])), U, (bf16_t*)WSB(WS_MX8), Sst, F.out + O_PRE, F.out + O_PIM, WSB(WS_G8));
        ssm_phase<true>(F, ((const float*)(GAS1 const float*)(kargs_fresh()->in[15])), U, U, Sst, F.out + O_PRE, F.out + O_PIM, WSB(WS_G8));
    }
    SEAM(4);
#define GSEAM(k) do { if (IN(k) && IN((k) + 1)) xcd_barrier((unsigned*)(WSB(WS_CTL)) + (1 + G_GRP) * XCD_BAR_WORDS, xb_xcc_id(), misc + 2, (unsigned)G_SIZE, LEADER); } while (0)
    const bool G_TWO = false;
    const int G_GRP = __builtin_amdgcn_readfirstlane(G_TWO ? ((int)(blockIdx.x >> 3) & 1) : 0), G_SIZE = __builtin_amdgcn_readfirstlane(G_TWO ? (int)(gridDim.x >> 1) : (int)gridDim.x);
    const int G_RANK = __builtin_amdgcn_readfirstlane(G_TWO ? (int)(((blockIdx.x >> 4) << 3) | (blockIdx.x & 7)) : (int)blockIdx.x);
    const int G_PM0 = __builtin_amdgcn_readfirstlane(G_TWO ? G_GRP * (MP / 512) : 0), G_NM = __builtin_amdgcn_readfirstlane(G_TWO ? MP / 512 : MP / 256);
    if (IN(5)) {
        REFRESH();
        if (IN(6)) (void)xcd_barrier_post((unsigned*)(WSB(WS_CTL)) + (1 + G_GRP) * XCD_BAR_WORDS, misc + 2, (unsigned)G_SIZE, LEADER);
        if (G_TWO && G_GRP == 1 && IN(4)) { const unsigned long long t0 = __builtin_amdgcn_s_memrealtime(); while (__builtin_amdgcn_s_memrealtime() - t0 < 0ull) __builtin_amdgcn_s_sleep(16); }
        if (G_GRP == 0) sample_gemm<0>(F, U, U, LD1, (const bf16_t*)(WSB(WS_WGLU)), LD1, 1024, 1024, U, nullptr, ((const float*)(GAS1 const float*)(kargs_fresh()->in[17])), ZA, G_RANK, G_SIZE);
        pg8::Gemm g{(const bf16_t*)(WSB(WS_G8)), (const bf16_t*)(WSB(WS_G8)), (const bf16_t*)(WSB(WS_W8GLU)), LD8A / 2, LD8A / 2, 512, 1 << 20, G_NM, 4, 0, E8_G, E8_W};
        pg8::StaticOrder S; S.init(g.nM, g.nN, G_SIZE, G_RANK, 0, 0, 0, G_PM0, WGM_P5);
        EpiGlu E{WSB(0), ((const float*)(GAS1 const float*)(kargs_fresh()->in[17]))};
        pg8::gemm_phase8<EpiGlu, true, E8_G, E8_W>(F.lds, g, S, E, F.wave);
    }
    GSEAM(5);
    if (IN(6)) {
        REFRESH();
        if (G_GRP == 0) sample_gemm<1>(F, ZA, Qb, LD1, (const bf16_t*)(WSB(WS_WOUT)), LD2, 2048, 2048, GA, GB, nullptr, XN, G_RANK, G_SIZE);
        pg8::Gemm g{(const bf16_t*)(WSB(WS_BR8)), (const bf16_t*)(WSB(WS_BR8)) + 512, (const bf16_t*)(WSB(WS_W8OUT)), LD8B / 2, LD8B / 2, 1024, 8, G_NM, 8, 0, E8_BR, E8_W};
        pg8::StaticOrder S; S.init(g.nM, g.nN, G_SIZE, G_RANK, 0, 0, 0, G_PM0, WGM_P67);
        EpiOut E{WSB(0)};
        pg8::gemm_phase8<EpiOut, true, E8_BR, E8_W>(F.lds, g, S, E, F.wave);
    }
    GSEAM(6);
    if (IN(7)) {
        REFRESH();
        if (G_GRP == 0) sample_gemm<2>(F, XN, XN, LD2, (const bf16_t*)(WSB(WS_WO)), LD2, 2048, 2048, nullptr, nullptr, ((const float*)(GAS1 const float*)(kargs_fresh()->in[1])), F.out + O_YS, G_RANK, G_SIZE);
        pg8::Gemm g{(const bf16_t*)(WSB(WS_MX8)), (const bf16_t*)(WSB(WS_MX8)), (const bf16_t*)(WSB(WS_W8O)), LD8B / 2, LD8B / 2, 1024, 1 << 20, G_NM, 8, 0, E8_MX, E8_W};
        pg8::StaticOrder S; S.init(g.nM, g.nN, G_SIZE, G_RANK, 0, 0, 0, G_PM0, WGM_P67);
        EpiRes E{WSB(0), ((const float*)(GAS1 const float*)(kargs_fresh()->in[6])), F.out};
        pg8::gemm_phase8<EpiRes, true, E8_MX, E8_W>(F.lds, g, S, E, F.wave);
    }
#undef GSEAM
#undef X_BAR
#undef LEADER
#undef REFRESH
#undef IN
#undef SEAM
#undef WSB
#undef XN
#undef U
#undef ZA
#undef Qb
#undef ZB
#undef Kb
#undef Vb
#undef GA
#undef GB
#undef Sst
#undef DUMMY
}

extern "C" void kernel_launch(void* const* d_in, const int* in_sizes, int n_in, void* d_out, int out_size, void* d_ws, size_t ws_size, hipStream_t stream) {
    static int grid = 0;
    if (grid == 0) {
        if (n_in != 25 || ws_size < WS_END) { fprintf(stderr, "kernel_launch: unexpected n_in %d / ws %zu\n", n_in, ws_size); grid = -1; return; }
        int dev = 0, cus = 0, per_cu = 0;
        hipGetDevice(&dev); hipDeviceGetAttribute(&cus, hipDeviceAttributeMultiprocessorCount, dev);
        hipFuncSetAttribute((const void*)mk_fwd, hipFuncAttributeMaxDynamicSharedMemorySize, LDS_BYTES);
        hipOccupancyMaxActiveBlocksPerMultiprocessor(&per_cu, (const void*)mk_fwd, 512, LDS_BYTES);
        if (per_cu < 1) { fprintf(stderr, "kernel_launch: occupancy query says %d blocks/CU\n", per_cu); per_cu = 1; }
        (void)hipGetLastError();
        grid = cus;
    }
    if (grid < 0) return;
    if (hipMemsetAsync((char*)d_ws + WS_CTL, 0, 65536, stream) != hipSuccess) { fprintf(stderr, "kernel_launch: memset of the barrier words failed\n"); return; }
    Args a{};
    for (int i = 0; i < 25; ++i) a.in[i] = (const float*)d_in[i];
    a.out = (float*)d_out; a.ws = (unsigned char*)d_ws;
    constexpr int NPH = 8;
    if (MK_N_LAUNCHES == 1) {
        a.ph_lo = 0; a.ph_hi = NPH;
        void* kargs[] = {&a};
        hipError_t e = hipLaunchCooperativeKernel((const void*)mk_fwd, dim3(grid), dim3(512), kargs, LDS_BYTES, stream);
        if (e != hipSuccess) fprintf(stderr, "cooperative launch failed: %s (grid %d)\n", hipGetErrorString(e), grid);
    } else {
        for (int p = 0; p < NPH; ++p) { a.ph_lo = p; a.ph_hi = p + 1; hipLaunchKernelGGL(mk_fwd, dim3(grid), dim3(512), LDS_BYTES, stream, a); }
    }
}
```

```cpp
#include <hip/hip_runtime.h>
#include <hip/hip_cooperative_groups.h>
#include <cstdio>
#include <cstdint>
namespace cg = cooperative_groups;

#ifndef ATT_S3
#define ATT_S3 7
#endif
#ifndef PROBE
#define PROBE 0
#endif
#ifndef USE_CG_SYNC
#define USE_CG_SYNC 0
#endif
#ifndef STAGGER
#define STAGGER 0
#endif
#ifndef WGM_IN16
#define WGM_IN16 4
#endif
#ifndef WGM_IN8
#define WGM_IN8 4
#endif
#ifndef WGM_P5
#define WGM_P5 4
#endif
#ifndef WGM_P67
#define WGM_P67 4
#endif
#ifndef MK_N_LAUNCHES
#define MK_N_LAUNCHES 1
#endif

#define LAS __attribute__((address_space(3)))
typedef unsigned short bf16_t;
typedef short bf16x8 __attribute__((ext_vector_type(8)));
typedef short s16x4 __attribute__((ext_vector_type(4)));
typedef float f32x4 __attribute__((ext_vector_type(4)));
typedef float f32x2 __attribute__((ext_vector_type(2)));
typedef float f32x16 __attribute__((ext_vector_type(16)));
typedef unsigned u32x4 __attribute__((ext_vector_type(4)));
typedef unsigned u32x2 __attribute__((ext_vector_type(2)));
typedef int v8i32 __attribute__((ext_vector_type(8)));
typedef int i32x4 __attribute__((ext_vector_type(4)));
typedef short bf16x16 __attribute__((ext_vector_type(16)));

constexpr int DM = 2048, SEQ = 4096, NBATCH = 8, MP = NBATCH * SEQ, MS = 128, MROWS = 33024;
constexpr int NIN = 8448, NCHUNK = 64, NGRP = 64, NSTATE = 64;
constexpr float EPSN = 1e-6f, LOG2E = 1.4426950408889634f, QSCALE = 0.125f * 1.4426950408889634f;
constexpr size_t O_YP = 0, O_YS = 67108864, O_PRE = 67371008, O_PIM = 67403776, O_PK = 67436544, O_PV = 67567616, O_SRE = 67698688, O_SIM = 67731456, O_SK = 67764224, O_SV = 67780608;
constexpr size_t MiB = 1u << 20;
constexpr int LD1 = 1024 + 64, LD2 = 2048 + 64;
constexpr size_t WS_CTL = 0, WS_WIN = 1 * MiB, WS_WGLU = 36 * MiB, WS_WOUT = 39 * MiB, WS_WO = 48 * MiB, WS_CONST = 57 * MiB, WS_XN = 58 * MiB, WS_U = 192 * MiB, WS_ZA = 261 * MiB,
                 WS_Q = 330 * MiB, WS_ZB = 399 * MiB, WS_K = 468 * MiB, WS_V = 477 * MiB, WS_GA = 486 * MiB, WS_GB = 620 * MiB, WS_S = 754 * MiB, WS_W8GLU = 755 * MiB, WS_W8OUT = 757 * MiB, WS_W8O = 762 * MiB,
                 WS_G8 = 767 * MiB, WS_BR8 = 804 * MiB, WS_MX8 = 873 * MiB, WS_XN8 = 873 * MiB  , WS_W8IN = 942 * MiB, WS_DUMMY = 873 * MiB, WS_CT = 957 * MiB  , WS_END = 965 * MiB;
#ifndef FP8_ZB
#define FP8_ZB 1
#endif
constexpr int IN8_TILES = 28, INB_TILES = 5;
__host__ __device__ constexpr int in8_tile(int j) { return j < 8 ? 4 + j : 5 + j; }
constexpr int LD8A = 1024 + 128, LD8B = 2048 + 128;
constexpr float F8_W = 64.f, F8_G = 8.f, F8_BR = 16.f, F8_MX = 64.f, F8_X = 8.f;
constexpr int E8_W = (127 - 6) * 0x01010101, E8_G = (127 - 3) * 0x01010101, E8_BR = (127 - 4) * 0x01010101, E8_MX = (127 - 6) * 0x01010101, E8_X = (127 - 3) * 0x01010101;
constexpr size_t C_LAM = 0, C_LAM64 = 32768, C_BF = 65536, C_CF = 327680, C_BT = 589824, C_RS = 606208;
constexpr int LDS_BYTES = 163840, MISC_OFF = 163840 - 64, PRE_OFF = 131072;

typedef __bf16 bf16x2_t __attribute__((ext_vector_type(2)));
__device__ __forceinline__ unsigned cvt_pk_bf16(float lo, float hi) { const bf16x2_t r = __builtin_convertvector((f32x2){lo, hi}, bf16x2_t); return __builtin_bit_cast(unsigned, r); }
__device__ __forceinline__ unsigned cvt_pk_bf16_nv(float lo, float hi) { return cvt_pk_bf16(lo, hi); }
__device__ __forceinline__ unsigned cvt_pk_bf16_b(float lo, float hi) { const bf16x2_t r = __builtin_convertvector((f32x2){lo, hi}, bf16x2_t); return __builtin_bit_cast(unsigned, r); }
__device__ __forceinline__ unsigned pk4_fp8(float a, float b, float c, float d) {
    a = fminf(fmaxf(a, -448.f), 448.f); b = fminf(fmaxf(b, -448.f), 448.f); c = fminf(fmaxf(c, -448.f), 448.f); d = fminf(fmaxf(d, -448.f), 448.f);
    int w = __builtin_amdgcn_cvt_pk_fp8_f32(a, b, 0, false); w = __builtin_amdgcn_cvt_pk_fp8_f32(c, d, w, true); return (unsigned)w; }
__device__ __forceinline__ float bf2f(unsigned short b) { return __uint_as_float((unsigned)b << 16); }
__device__ __forceinline__ float bflo(unsigned w) { return __uint_as_float(w << 16); }
__device__ __forceinline__ float bfhi(unsigned w) { return __uint_as_float(w & 0xffff0000u); }
__device__ __forceinline__ float sigmoidf_(float x) { return __builtin_amdgcn_rcpf(1.0f + __builtin_amdgcn_exp2f(-LOG2E * x)); }
__device__ __forceinline__ float siluf_(float x) { return x * sigmoidf_(x); }
__device__ __forceinline__ float geluf_(float v) {
    const float av = fabsf(v), t = __builtin_amdgcn_rcpf(av * 0.2316418882f + 1.0f);
    float q = t * 0.5307027145f + (-0.7265760135f); q = q * t + 0.7107068705f; q = q * t + (-0.142248368f); q = q * t + 0.127414796f; q = q * t;
    const float e = __builtin_amdgcn_exp2f((v * v) * (-0.72134752044f));
    const float m = v * (q * e);
    return v < 0.f ? m : v - m;
}

#define GAS1 __attribute__((address_space(1)))
__device__ __forceinline__ unsigned char* ws_fresh(unsigned char* p) { GAS1 unsigned char* g = (GAS1 unsigned char*)p; asm volatile("" : "+s"(g)); return (unsigned char*)g; }
__device__ __forceinline__ void st16_wt_early(char* base, unsigned off, u32x4 v, bool wt) {
    if (wt) __builtin_amdgcn_raw_buffer_store_b128(v, __builtin_amdgcn_make_buffer_rsrc((void*)base, 0, 0x7fffffff, 0x00020000), off, 0, 16);
    else *(u32x4*)(base + off) = v;
}
#define ST_WT(T, p, v, wt) do { if (wt) __hip_atomic_store((GAS1 T*)(p), (T)(v), __ATOMIC_RELAXED, __HIP_MEMORY_SCOPE_AGENT); else *(p) = (v); } while (0)
__device__ __forceinline__ size_t ctab_off() { return WS_CT + (size_t)(((int)gridDim.x == 256) ? ((int)blockIdx.x & 7) : 0) * MiB; }
__device__ __forceinline__ int lane_id_fresh() { int l; asm volatile("v_mbcnt_lo_u32_b32 %0, -1, 0\n\tv_mbcnt_hi_u32_b32 %0, -1, %0" : "=v"(l)); return l; }
namespace pg8 {
constexpr int BM = 256, BK = 64, HALF = 128, HTB = HALF * BK * 2, STAGE_BYTES = 8 * HTB, NXCD = 8;
__host__ __device__ __forceinline__ int lds_byte(int r, int c) { const int st = (r >> 4) * 2 + (c >> 5), rr = r & 15, cc = c & 31, ob = rr * 64 + cc * 2; return st * 1024 + (ob ^ (((ob >> 9) & 1) << 5)); }
__host__ __device__ __forceinline__ void stage_rc(int b, int& R, int& C) { const int st = b / 1024, sb = b % 1024, swz = sb ^ (((sb >> 9) & 1) << 5); R = (st >> 1) * 16 + swz / 64; C = (st & 1) * 32 + (swz % 64) / 2; }
__host__ __device__ __forceinline__ int perm32(int rho) { const int n = rho >> 4, i = rho & 15; return 8 * (i >> 2) + 4 * n + (i & 3); }
struct Unit { int pm, pn; };
struct Gemm { const bf16_t* A; const bf16_t* A2; const bf16_t* Bt; int lda, ldb, K, ksplit, nM, nN, fold, scaleA, scaleB; };
struct StaticOrder {
    int nM, nN, nwg, G, c, nx, xpm, inmap, pm0, WGM;
    __device__ void init(int nM_, int nN_, int G_, int c_, int nx_ = 0, int xpm_ = 0, int inmap_ = 0, int pm0_ = 0, int wgm_ = 4) { nM = nM_; nN = nN_; nwg = nM * nN; G = G_; c = c_; nx = nx_; xpm = xpm_; inmap = inmap_; pm0 = pm0_; WGM = wgm_; }
    __device__ bool next(int i, Unit& u) const {
        const int L = i * G + c; if (L >= nwg) { if (L >= nwg + nx) return false; const int j = (int)(L - nwg); u.pm = xpm; if (inmap) { const int jj = j - 5; u.pn = j < 4 ? j : (j == 4 ? 12 : (jj < 8 ? 4 + jj : 5 + jj)); } else u.pn = j < 8 ? 4 + j : 5 + j; return true; }
        int wgid = L; { const int q = nwg / NXCD, r = nwg % NXCD, xcd = wgid % NXCD, off = wgid / NXCD; wgid = (xcd < r ? xcd * (q + 1) : r * (q + 1) + (xcd - r) * q) + off; }
        const int nig = WGM * nN, gid = wgid / nig, fm = gid * WGM, gsz = (nM - fm) < WGM ? (nM - fm) : WGM;
        u.pm = pm0 + fm + ((wgid % nig) % gsz); u.pn = (wgid % nig) / gsz; if (inmap && u.pn >= 4) u.pn += 8; return true;
    }
};

template <class Epi, bool ALIGN_EPI>
__device__ __forceinline__ void gemm_phase(LAS unsigned char* lds, const Gemm g, const StaticOrder& S, const Epi& E, int wid_in) {
    const int wid = wid_in, lane = lane_id_fresh(), tid = wid * 64 + lane, wr = wid >> 2, wc = wid & 3, fr = lane & 15, fq = lane >> 4;
    const int K = g.K, nt = K / BK, lda = g.lda, ldb = g.ldb;
    unsigned voffA[2], voffB[2];
#pragma unroll
    for (int i = 0; i < 2; ++i) { int R, C; stage_rc(tid * 16 + i * 8192, R, C); const int Rb = Epi::PERM ? ((R & ~31) + perm32(R & 31)) : R;
        voffA[i] = (unsigned)(R * lda + C) * 2u; voffB[i] = (unsigned)(Rb * ldb + C) * 2u; }
    const size_t kstep = (size_t)(BK * 2);
    const size_t hstepA = (size_t)HALF * lda * 2, tstepA = 2 * hstepA;
    const size_t hstepB = (size_t)HALF * ldb * 2, tstepB = 2 * hstepB;
    const unsigned ldsw = (unsigned)wid * 1024u;
    const int aoff = lds_byte(wr * 64 + fr, fq * 8), boff = lds_byte(wc * 32 + fr, fq * 8);
    const char* Alo = (const char*)g.A; const char* Ahi = (const char*)g.A2 - (size_t)g.ksplit * kstep;
#define PG8_APAN(pm, t) (((t) < g.ksplit ? Alo : Ahi) + (size_t)(g.fold ? 0 : (pm)) * tstepA + (size_t)(t) * kstep)
#define PG8_SA(b, h) (((b) * 2 + (h)) * HTB)
#define PG8_SB(b, h) ((4 + (b) * 2 + (h)) * HTB)
#define PG8_STAGE(bufoff, gbase, voff) do { _Pragma("unroll") for (int _i = 0; _i < 2; ++_i) \
        __builtin_amdgcn_global_load_lds((const unsigned*)((const char*)(gbase) + (voff)[_i]), (LAS unsigned*)(lds + (bufoff) + ldsw + _i * 8192), 16, 0, 0); } while (0)
#define PG8_LDA(dst, b, h) do { _Pragma("unroll") for (int m = 0; m < 4; ++m) _Pragma("unroll") for (int k = 0; k < 2; ++k) dst[m][k] = *(const LAS bf16x8*)(lds + PG8_SA(b, h) + aoff + m * 2048 + k * 1024); } while (0)
#define PG8_LDB(dst, b, h) do { _Pragma("unroll") for (int n = 0; n < 2; ++n) _Pragma("unroll") for (int k = 0; k < 2; ++k) dst[n][k] = *(const LAS bf16x8*)(lds + PG8_SB(b, h) + boff + n * 2048 + k * 1024); } while (0)
#define PG8_MMA(ai, bj, At, Bt) do { __builtin_amdgcn_s_setprio(1); _Pragma("unroll") for (int m = 0; m < 4; ++m) _Pragma("unroll") for (int n = 0; n < 2; ++n) _Pragma("unroll") for (int k = 0; k < 2; ++k) \
        acc[ai][bj][m][n] = __builtin_amdgcn_mfma_f32_16x16x32_bf16(Bt[n][k], At[m][k], acc[ai][bj][m][n], 0, 0, 0); __builtin_amdgcn_s_setprio(0); } while (0)
#define PG8_WAIT_V(n) asm volatile("s_waitcnt vmcnt(" #n ")" ::: "memory")
#define PG8_WAIT_L(n) asm volatile("s_waitcnt lgkmcnt(" #n ")" ::: "memory")
#define PG8_BAR __builtin_amdgcn_s_barrier()
#define PG8_SCHED __builtin_amdgcn_sched_barrier(0)
    Unit cur, nxt; int ui = 0;
    if (!S.next(0, cur)) return;
    f32x4 acc[2][2][4][2];
#pragma unroll
    for (int a = 0; a < 2; ++a)
#pragma unroll
        for (int b = 0; b < 2; ++b)
#pragma unroll
            for (int m = 0; m < 4; ++m)
#pragma unroll
                for (int n = 0; n < 2; ++n) acc[a][b][m][n] = (f32x4){0.f, 0.f, 0.f, 0.f};
    bf16x8 At[4][2], B0[2][2], B1[2][2];
    const char* cA = PG8_APAN(cur.pm, 0); const char* cB = (const char*)g.Bt + (size_t)(g.fold ? 0 : cur.pn) * tstepB;
    PG8_STAGE(PG8_SB(0, 0), cB, voffB); PG8_STAGE(PG8_SB(0, 1), cB + hstepB, voffB); PG8_STAGE(PG8_SA(0, 0), cA, voffA); PG8_STAGE(PG8_SA(0, 1), cA + hstepA, voffA);
    if (wr == 1) PG8_BAR;
    PG8_WAIT_V(2); PG8_BAR;
    PG8_STAGE(PG8_SB(1, 0), cB + kstep, voffB); PG8_STAGE(PG8_SA(1, 0), cA + kstep, voffA); PG8_STAGE(PG8_SB(1, 1), cB + hstepB + kstep, voffB);
    PG8_WAIT_V(6); PG8_BAR;
    for (;;) {
        const bool has_next = S.next(ui + 1, nxt);
        const char* nA = has_next ? PG8_APAN(nxt.pm, 0) : cA; const char* nB = has_next ? (const char*)g.Bt + (size_t)(g.fold ? 0 : nxt.pn) * tstepB : cB;
        for (int t = 0; t < nt; t += 2) {
            if constexpr (Epi::HAS_MID) { if (t == g.ksplit) E.mid(acc, cur, wr, wc, fr, fq); }
            const bool last = (t == nt - 2);
            const char* a1 = PG8_APAN(cur.pm, t + 1);
            const char* a2 = last ? nA : PG8_APAN(cur.pm, t + 2); const char* b2 = last ? nB : cB + (size_t)(t + 2) * kstep;
            const char* a3 = a2 + kstep; const char* b3 = b2 + kstep;
            PG8_LDB(B0, 0, 0); PG8_LDB(B1, 0, 1); PG8_SCHED; PG8_LDA(At, 0, 0); PG8_STAGE(PG8_SA(1, 1), a1 + hstepA, voffA);
            PG8_WAIT_V(8); PG8_WAIT_L(0); PG8_BAR; PG8_MMA(0, 0, At, B0); PG8_MMA(0, 1, At, B1); PG8_BAR; PG8_SCHED;
            PG8_LDA(At, 0, 1); PG8_STAGE(PG8_SB(0, 0), b2, voffB); PG8_STAGE(PG8_SB(0, 1), b2 + hstepB, voffB); PG8_STAGE(PG8_SA(0, 0), a2, voffA);
            PG8_WAIT_V(8); PG8_WAIT_L(0); PG8_BAR; PG8_MMA(1, 0, At, B0); PG8_MMA(1, 1, At, B1); PG8_BAR; PG8_SCHED;
            PG8_LDB(B0, 1, 0); PG8_LDB(B1, 1, 1); PG8_SCHED; PG8_LDA(At, 1, 0); PG8_STAGE(PG8_SA(0, 1), a2 + hstepA, voffA);
            PG8_WAIT_V(8); PG8_WAIT_L(0); PG8_BAR; PG8_MMA(0, 0, At, B0); PG8_MMA(0, 1, At, B1); PG8_BAR; PG8_SCHED;
            PG8_LDA(At, 1, 1); PG8_STAGE(PG8_SB(1, 0), b3, voffB); PG8_STAGE(PG8_SB(1, 1), b3 + hstepB, voffB); PG8_STAGE(PG8_SA(1, 0), a3, voffA);
            PG8_WAIT_V(8); PG8_WAIT_L(0); PG8_BAR; PG8_MMA(1, 0, At, B0); PG8_MMA(1, 1, At, B1); PG8_BAR; PG8_SCHED;
        }
        if constexpr (ALIGN_EPI) { if (wr == 0) PG8_BAR; }
        E(acc, cur, wr, wc, fr, fq);
        if (!has_next) break;
#pragma unroll
        for (int a = 0; a < 2; ++a)
#pragma unroll
            for (int b = 0; b < 2; ++b)
#pragma unroll
                for (int m = 0; m < 4; ++m)
#pragma unroll
                    for (int n = 0; n < 2; ++n) acc[a][b][m][n] = (f32x4){0.f, 0.f, 0.f, 0.f};
        cur = nxt; cA = nA; cB = nB; ++ui;
        if constexpr (ALIGN_EPI) { if (wr == 1) PG8_BAR; }
    }
    PG8_WAIT_V(0);
    if constexpr (!ALIGN_EPI) { if (wr == 0) PG8_BAR; }
    PG8_BAR;
#undef PG8_APAN
#undef PG8_SA
#undef PG8_SB
#undef PG8_STAGE
#undef PG8_LDA
#undef PG8_LDB
#undef PG8_MMA
#undef PG8_WAIT_V
#undef PG8_WAIT_L
#undef PG8_BAR
#undef PG8_SCHED
}
template <class Epi, bool ALIGN_EPI, int SCA, int SCB>
__device__ __forceinline__ void gemm_phase8(LAS unsigned char* lds, const Gemm g, const StaticOrder& S, const Epi& E, int wid_in) {
    const int wid = wid_in, lane = lane_id_fresh(), tid = wid * 64 + lane, wr = wid >> 2, wc = wid & 3, fr = lane & 15, fq = lane >> 4;
    const int K = g.K, nt = K / BK, lda = g.lda, ldb = g.ldb;
    unsigned voffA[2], voffB[2];
#pragma unroll
    for (int i = 0; i < 2; ++i) { int R, C; stage_rc(tid * 16 + i * 8192, R, C); const int Rb = Epi::PERM ? ((R & ~31) + perm32(R & 31)) : R;
        voffA[i] = (unsigned)(R * lda + C) * 2u; voffB[i] = (unsigned)(Rb * ldb + C) * 2u; }
    const unsigned kstep = (unsigned)(BK * 2);
    const unsigned hstepA = (unsigned)HALF * lda * 2, tstepA = 2 * hstepA;
    const unsigned hstepB = (unsigned)HALF * ldb * 2, tstepB = 2 * hstepB;
    const unsigned ldsw = (unsigned)wid * 1024u;
    const int aoff0 = lds_byte(wr * 64 + fr, fq * 16), boff0 = lds_byte(wc * 32 + fr, fq * 16);
    constexpr int aoff1d = 16, boff1d = 16;
    const char* Abase = (const char*)g.A; const char* Bbase = (const char*)g.Bt;
#define PG8_APAN(pm, t) ((unsigned)(pm) * tstepA + (unsigned)(t) * kstep)
#define PG8_SA(b, h) (((b) * 2 + (h)) * HTB)
#define PG8_SB(b, h) ((4 + (b) * 2 + (h)) * HTB)
#define PG8_STAGE(bufoff, gbase, voff) do { _Pragma("unroll") for (int _i = 0; _i < 2; ++_i) \
        { unsigned vo_ = (voff)[_i]; asm volatile("" : "+v"(vo_));   \
        __builtin_amdgcn_global_load_lds((const unsigned*)(gbase + vo_), (LAS unsigned*)(lds + (bufoff) + ldsw + _i * 8192), 16, 0, 0); } } while (0)
#define PG8_GA(off) (Abase + (size_t)(off))
#define PG8_GB(off) (Bbase + (size_t)(off))
#define PG8_LDA(dst, b, h) do { _Pragma("unroll") for (int m = 0; m < 4; ++m) { const i32x4 lo_ = *(const LAS i32x4*)(lds + PG8_SA(b, h) + aoff0 + m * 2048), hi_ = *(const LAS i32x4*)(lds + PG8_SA(b, h) + aoff0 + aoff1d + m * 2048); dst[m] = __builtin_shufflevector(lo_, hi_, 0, 1, 2, 3, 4, 5, 6, 7); } } while (0)
#define PG8_LDB(dst, b, h) do { _Pragma("unroll") for (int n = 0; n < 2; ++n) { const i32x4 lo_ = *(const LAS i32x4*)(lds + PG8_SB(b, h) + boff0 + n * 2048), hi_ = *(const LAS i32x4*)(lds + PG8_SB(b, h) + boff0 + boff1d + n * 2048); dst[n] = __builtin_shufflevector(lo_, hi_, 0, 1, 2, 3, 4, 5, 6, 7); } } while (0)
#define PG8_MMA(ai, bj, At, Bt) do { __builtin_amdgcn_s_setprio(1); _Pragma("unroll") for (int m = 0; m < 4; ++m) _Pragma("unroll") for (int n = 0; n < 2; ++n) \
        acc[ai][bj][m][n] = __builtin_amdgcn_mfma_scale_f32_16x16x128_f8f6f4(Bt[n], At[m], acc[ai][bj][m][n], 0, 0, 0, SCB, 0, SCA); __builtin_amdgcn_s_setprio(0); } while (0)
#define PG8_WAIT_V(n) asm volatile("s_waitcnt vmcnt(" #n ")" ::: "memory")
#define PG8_WAIT_L(n) asm volatile("s_waitcnt lgkmcnt(" #n ")" ::: "memory")
#define PG8_BAR __builtin_amdgcn_s_barrier()
#define PG8_SCHED __builtin_amdgcn_sched_barrier(0)
    Unit cur, nxt; int ui = 0;
    if (!S.next(0, cur)) return;
    f32x4 acc[2][2][4][2];
#pragma unroll
    for (int a = 0; a < 2; ++a)
#pragma unroll
        for (int b = 0; b < 2; ++b)
#pragma unroll
            for (int m = 0; m < 4; ++m)
#pragma unroll
                for (int n = 0; n < 2; ++n) acc[a][b][m][n] = (f32x4){0.f, 0.f, 0.f, 0.f};
    v8i32 At[4], B0[2], B1[2];
    unsigned cA = PG8_APAN(cur.pm, 0), cB = (unsigned)cur.pn * tstepB;
    PG8_STAGE(PG8_SB(0, 0), PG8_GB(cB), voffB); PG8_STAGE(PG8_SB(0, 1), PG8_GB(cB + hstepB), voffB); PG8_STAGE(PG8_SA(0, 0), PG8_GA(cA), voffA); PG8_STAGE(PG8_SA(0, 1), PG8_GA(cA + hstepA), voffA);
    if (wr == 1) PG8_BAR;
    PG8_WAIT_V(2); PG8_BAR;
    PG8_STAGE(PG8_SB(1, 0), PG8_GB(cB + kstep), voffB); PG8_STAGE(PG8_SA(1, 0), PG8_GA(cA + kstep), voffA); PG8_STAGE(PG8_SB(1, 1), PG8_GB(cB + hstepB + kstep), voffB);
    PG8_WAIT_V(6); PG8_BAR;
    for (;;) {
        const bool has_next = S.next(ui + 1, nxt);
        const unsigned nA = has_next ? PG8_APAN(nxt.pm, 0) : cA, nB = has_next ? (unsigned)nxt.pn * tstepB : cB;
#pragma unroll 1
        for (int t = 0; t < nt; t += 2) {
            if constexpr (Epi::HAS_MID) { if (t == g.ksplit) { const int l_ = lane_id_fresh(); E.mid(acc, cur, wr, wc, l_ & 15, l_ >> 4); } }
            const bool last = (t == nt - 2);
            const unsigned a1 = cA + (unsigned)(t + 1) * kstep;
            const unsigned a2 = last ? nA : cA + (unsigned)(t + 2) * kstep, b2 = last ? nB : cB + (unsigned)(t + 2) * kstep;
            const unsigned a3 = a2 + kstep, b3 = b2 + kstep;
            if constexpr (Epi::HAS_PRE) { if (last) { const int l_ = lane_id_fresh(); E.prefetch(lds + PRE_OFF + ldsw, cur, wr, wc, l_ & 15, l_ >> 4); }
                                          else if (Epi::HAS_MID && t + 2 == g.ksplit) { const int l_ = lane_id_fresh(); E.prefetch_mid(lds + PRE_OFF + ldsw, cur, wr, wc, l_ & 15, l_ >> 4); } }
            PG8_LDB(B0, 0, 0); PG8_LDB(B1, 0, 1); PG8_SCHED; PG8_LDA(At, 0, 0); PG8_STAGE(PG8_SA(1, 1), PG8_GA(a1 + hstepA), voffA);
            PG8_WAIT_V(8); PG8_WAIT_L(0); PG8_BAR; PG8_MMA(0, 0, At, B0); PG8_MMA(0, 1, At, B1); PG8_BAR; PG8_SCHED;
            PG8_LDA(At, 0, 1); PG8_STAGE(PG8_SB(0, 0), PG8_GB(b2), voffB); PG8_STAGE(PG8_SB(0, 1), PG8_GB(b2 + hstepB), voffB); PG8_STAGE(PG8_SA(0, 0), PG8_GA(a2), voffA);
            PG8_WAIT_V(8); PG8_WAIT_L(0); PG8_BAR; PG8_MMA(1, 0, At, B0); PG8_MMA(1, 1, At, B1); PG8_BAR; PG8_SCHED;
            PG8_LDB(B0, 1, 0); PG8_LDB(B1, 1, 1); PG8_SCHED; PG8_LDA(At, 1, 0); PG8_STAGE(PG8_SA(0, 1), PG8_GA(a2 + hstepA), voffA);
            PG8_WAIT_V(8); PG8_WAIT_L(0); PG8_BAR; PG8_MMA(0, 0, At, B0); PG8_MMA(0, 1, At, B1); PG8_BAR; PG8_SCHED;
            PG8_LDA(At, 1, 1); PG8_STAGE(PG8_SB(1, 0), PG8_GB(b3), voffB); PG8_STAGE(PG8_SB(1, 1), PG8_GB(b3 + hstepB), voffB); PG8_STAGE(PG8_SA(1, 0), PG8_GA(a3), voffA);
            PG8_WAIT_V(8); PG8_WAIT_L(0); PG8_BAR; PG8_MMA(1, 0, At, B0); PG8_MMA(1, 1, At, B1); PG8_BAR; PG8_SCHED;
        }
        if constexpr (ALIGN_EPI) { if (wr == 0) PG8_BAR; }
        { const int l_ = lane_id_fresh(); E(acc, cur, wr, wc, l_ & 15, l_ >> 4); }
        if (!has_next) break;
#pragma unroll
        for (int a = 0; a < 2; ++a)
#pragma unroll
            for (int b = 0; b < 2; ++b)
#pragma unroll
                for (int m = 0; m < 4; ++m)
#pragma unroll
                    for (int n = 0; n < 2; ++n) acc[a][b][m][n] = (f32x4){0.f, 0.f, 0.f, 0.f};
        cur = nxt; cA = nA; cB = nB; ++ui;
        if constexpr (ALIGN_EPI) { if (wr == 1) PG8_BAR; }
    }
    PG8_WAIT_V(0);
    if constexpr (!ALIGN_EPI) { if (wr == 0) PG8_BAR; }
    PG8_BAR;
#undef PG8_APAN
#undef PG8_GA
#undef PG8_GB
#undef PG8_SA
#undef PG8_SB
#undef PG8_STAGE
#undef PG8_LDA
#undef PG8_LDB
#undef PG8_MMA
#undef PG8_WAIT_V
#undef PG8_WAIT_L
#undef PG8_BAR
#undef PG8_SCHED
}
}

typedef const f32x4 (&AccRef)[2][2][4][2];
typedef f32x4 (&AccMut)[2][2][4][2];

__device__ __forceinline__ u32x2 pack8_fp8(f32x4 a, f32x4 b, float s) { u32x2 w; w.x = pk4_fp8(a[0] * s, a[1] * s, a[2] * s, a[3] * s); w.y = pk4_fp8(b[0] * s, b[1] * s, b[2] * s, b[3] * s); return w; }
__device__ __forceinline__ u32x4 pack8(f32x4 a, f32x4 b) { u32x4 w; w.x = cvt_pk_bf16(a[0], a[1]); w.y = cvt_pk_bf16(a[2], a[3]); w.z = cvt_pk_bf16(b[0], b[1]); w.w = cvt_pk_bf16(b[2], b[3]); return w; }

__device__ __forceinline__ unsigned opaque(unsigned x) { asm volatile("" : "+v"(x)); return x; }

__device__ __forceinline__ void st16_wt(char* base, unsigned off, u32x4 v, bool wt) {
    if (wt) __builtin_amdgcn_raw_buffer_store_b128(v, __builtin_amdgcn_make_buffer_rsrc((void*)base, 0, 0x7fffffff, 0x00020000), off, 0, 16);
    else *(u32x4*)(base + off) = v;
}
#define EPI_PREFETCH3(base_off, ldrow) do { _Pragma("unroll") for (int j = 0; j < 3; ++j) { unsigned vo_ = (base_off) + (unsigned)((j >> 1) * 16) * (unsigned)((ldrow) * 2) + (unsigned)((j & 1) * 256); asm volatile("" : "+v"(vo_)); \
            __builtin_amdgcn_global_load_lds((const unsigned*)(ws + vo_), (LAS unsigned*)(dstw + j * 8192), 16, 0, 0); } } while (0)
#define EPI_PRE_PTR() ((const LAS unsigned char*)(uintptr_t)(PRE_OFF + ((wr * 4 + wc) * 64 + fq * 16 + fr) * 16))
struct EpiIn {
    static constexpr bool PERM = true, HAS_MID = false, HAS_PRE = false;
    bf16_t *U, *ZA, *Q, *ZB, *Kb, *Vb, *GA, *GB; const float *qg, *kg; float* out; bool nostore; int pn_off;
    __device__ __forceinline__ void operator()(AccRef acc, const pg8::Unit& u, int wr, int wc, int fr, int fq) const {
        const bool wt = (u.pm == MP / 256);
        const int pn = pn_off ? (u.pn < 8 ? 4 + u.pn : 5 + u.pn) : u.pn, row0 = u.pm * 256 + wr * 64 + fr, lc0 = 64 * wc + 8 * fq;
        if (pn == 12) {
            const bool isk = wc < 2; const int hd = wc & 1;
            f32x4 gq[2][2];
#pragma unroll
            for (int bj = 0; bj < 2; ++bj)
#pragma unroll
                for (int n = 0; n < 2; ++n) gq[bj][n] = isk ? *(const f32x4*)(kg + 32 * bj + 8 * fq + 4 * n) : (f32x4){1.f, 1.f, 1.f, 1.f};
            char* dst = (char*)(isk ? Kb : Vb); float* opk = out + (isk ? O_PK : O_PV); float* osk = out + (isk ? O_SK : O_SV);
            const unsigned off0 = ((unsigned)row0 * 128u + 64u * hd + 8u * fq) * 2u;
#pragma unroll
            for (int ai = 0; ai < 2; ++ai)
#pragma unroll
                for (int m = 0; m < 4; ++m) {
                    const int row = row0 + ai * 128 + m * 16;
                    const unsigned o = opaque(off0 + (unsigned)(ai * 128 + m * 16) * 256u);
                    float r = 1.f;
                    if (isk) { float ss = 0.f;
#pragma unroll
                        for (int bj = 0; bj < 2; ++bj)
#pragma unroll
                            for (int n = 0; n < 2; ++n) { const f32x4 x = acc[ai][bj][m][n]; ss += (x[0] * x[0] + x[1] * x[1]) + (x[2] * x[2] + x[3] * x[3]); }
                        ss += __shfl_xor(ss, 16); ss += __shfl_xor(ss, 32);
                        r = __builtin_amdgcn_rsqf(ss * (1.0f / 64.0f) + EPSN); }
                    float* fo = nullptr;
                    if (row < MP) { const int t = row & (SEQ - 1); if (t >= SEQ - 128) fo = opk + ((size_t)((row >> 12) * 128 + (t - (SEQ - 128))) * 2 + hd) * 64; }
                    else if (row < MP + MS) { fo = osk + ((size_t)(row - MP) * 2 + hd) * 64; }
#pragma unroll
                    for (int bj = 0; bj < 2; ++bj) {
                        const f32x4 v0 = acc[ai][bj][m][0] * r * gq[bj][0], v1 = acc[ai][bj][m][1] * r * gq[bj][1];
                        if (!nostore) st16_wt(dst, o + 64 * bj, pack8(v0, v1), wt);
                        if (fo && !nostore) { *(f32x4*)(fo + 32 * bj + 8 * fq) = v0; *(f32x4*)(fo + 32 * bj + 8 * fq + 4) = v1; }
                    }
                }
            return;
        }
        if (pn >= 8 && pn < 12) {
            f32x4 gq[2][2];
#pragma unroll
            for (int bj = 0; bj < 2; ++bj)
#pragma unroll
                for (int n = 0; n < 2; ++n) gq[bj][n] = *(const f32x4*)(qg + 32 * bj + 8 * fq + 4 * n) * QSCALE;
            const unsigned off0 = ((unsigned)row0 * (unsigned)LD1 + (unsigned)((pn - 8) * 256 + lc0)) * 2u;
#pragma unroll
            for (int ai = 0; ai < 2; ++ai)
#pragma unroll
                for (int m = 0; m < 4; ++m) {
                    const unsigned o = opaque(off0 + (unsigned)(ai * 128 + m * 16) * (unsigned)(LD1 * 2)); float ss = 0.f;
#pragma unroll
                    for (int bj = 0; bj < 2; ++bj)
#pragma unroll
                        for (int n = 0; n < 2; ++n) { const f32x4 x = acc[ai][bj][m][n]; ss += (x[0] * x[0] + x[1] * x[1]) + (x[2] * x[2] + x[3] * x[3]); }
                    ss += __shfl_xor(ss, 16); ss += __shfl_xor(ss, 32);
                    const float r = __builtin_amdgcn_rsqf(ss * (1.0f / 64.0f) + EPSN);
#pragma unroll
                    for (int bj = 0; bj < 2; ++bj)
                        { const u32x4 pk = pack8(acc[ai][bj][m][0] * r * gq[bj][0], acc[ai][bj][m][1] * r * gq[bj][1]); if (!nostore) st16_wt((char*)Q, o + 64 * bj, pk, wt); else asm volatile("" :: "v"(pk)); }
                }
            return;
        }
        if (pn >= 17) {
            const unsigned off0 = ((unsigned)row0 * (unsigned)LD2 + (unsigned)((pn - 17) * 128 + 32 * wc + 8 * fq)) * 2u;
#pragma unroll
            for (int ai = 0; ai < 2; ++ai)
#pragma unroll
                for (int m = 0; m < 4; ++m) {
                    const unsigned o = opaque(off0 + (unsigned)(ai * 128 + m * 16) * (unsigned)(LD2 * 2));
                    f32x4 r0, r1, i0, i1;
#pragma unroll
                    for (int i = 0; i < 4; ++i) {
                        const float a0 = 1.0f + __builtin_amdgcn_exp2f(fminf(acc[ai][0][m][0][i], 86.5f)), a1 = 1.0f + __builtin_amdgcn_exp2f(fminf(acc[ai][0][m][1][i], 86.5f));
                        const float b0 = 1.0f + __builtin_amdgcn_exp2f(fminf(acc[ai][1][m][0][i], 86.5f)), b1 = 1.0f + __builtin_amdgcn_exp2f(fminf(acc[ai][1][m][1][i], 86.5f));
                        r0[i] = b0 * __builtin_amdgcn_rcpf(a0); r1[i] = b1 * __builtin_amdgcn_rcpf(a1); i0[i] = __builtin_amdgcn_rcpf(b0); i1[i] = __builtin_amdgcn_rcpf(b1);
                    }
                    const u32x4 pr = pack8(r0, r1), pi = pack8(i0, i1);
                    if (!nostore) { st16_wt((char*)GA, o, pr, wt); st16_wt((char*)GB, o, pi, wt); } else asm volatile("" :: "v"(pr), "v"(pi));
                }
            return;
        }
        char* dst; unsigned ld, cb; int kind;
        if (pn < 4) { dst = (char*)U; ld = LD1; cb = pn * 256; kind = 0; }
        else if (pn < 8) { dst = (char*)ZA; ld = LD1; cb = (pn - 4) * 256; kind = 1; }
        else { dst = (char*)ZB; ld = LD1; cb = (pn - 13) * 256; kind = 1; }
        const unsigned off0 = ((unsigned)row0 * ld + cb + (unsigned)lc0) * 2u;
#define EPI_IN_LOOP(BODY) _Pragma("unroll") for (int ai = 0; ai < 2; ++ai) _Pragma("unroll") for (int m = 0; m < 4; ++m) { \
            const unsigned o = opaque(off0 + (unsigned)(ai * 128 + m * 16) * ld * 2u); \
            _Pragma("unroll") for (int bj = 0; bj < 2; ++bj) { f32x4 v0 = acc[ai][bj][m][0], v1 = acc[ai][bj][m][1]; BODY; \
                const u32x4 pk = pack8(v0, v1); if (!nostore) st16_wt(dst, o + 64 * bj, pk, wt); else asm volatile("" :: "v"(pk)); } }
        if (kind == 0) { EPI_IN_LOOP((void)0) }
        else { EPI_IN_LOOP(_Pragma("unroll") for (int i = 0; i < 4; ++i) { v0[i] = siluf_(v0[i]); v1[i] = siluf_(v1[i]); }) }
#undef EPI_IN_LOOP
    }
};

struct EpiGlu {
    static constexpr bool PERM = true, HAS_MID = false, HAS_PRE = true;
    unsigned char* ws; const float* bias;
    __device__ __forceinline__ void prefetch_mid(LAS unsigned char*, const pg8::Unit&, int, int, int, int) const {}
    __device__ __forceinline__ void prefetch(LAS unsigned char* dstw, const pg8::Unit& u, int wr, int wc, int fr, int fq) const {
        const int row0 = u.pm * 256 + wr * 64 + fr, col0 = u.pn * 256 + wc * 32 + 8 * fq;
        EPI_PREFETCH3(((unsigned)row0 * (unsigned)LD1 + (unsigned)col0) * 2u + (unsigned)WS_U, LD1);
    }
    __device__ __forceinline__ void operator()(AccRef acc, const pg8::Unit& u, int wr, int wc, int fr, int fq) const {
        const int row0 = u.pm * 256 + wr * 64 + fr, col0 = u.pn * 256 + wc * 32 + 8 * fq;
        f32x4 bv[2][2];
#pragma unroll
        for (int bj = 0; bj < 2; ++bj)
#pragma unroll
            for (int n = 0; n < 2; ++n) bv[bj][n] = *(const f32x4*)(bias + col0 + bj * 128 + 4 * n);
        const unsigned off0 = ((unsigned)row0 * (unsigned)LD1 + (unsigned)col0) * 2u + (unsigned)WS_U, off8 = (unsigned)row0 * (unsigned)LD8B + (unsigned)col0 + (unsigned)WS_BR8;
#pragma unroll
        for (int ai = 0; ai < 2; ++ai)
        { constexpr int mh = 0;
            u32x4 gw[4][2];
#pragma unroll
            for (int mm = 0; mm < 4; ++mm) { const unsigned o = opaque(off0 + (unsigned)(ai * 128 + (mh * 2 + mm) * 16) * (unsigned)(LD1 * 2));
#pragma unroll
                for (int bj = 0; bj < 2; ++bj) { if (ai == 0 && 2 * mm + bj < 3) gw[mm][bj] = *(const LAS u32x4*)(EPI_PRE_PTR() + (2 * mm + bj) * 8192); else gw[mm][bj] = *(const u32x4*)(ws + o + bj * 256); } }
            asm volatile("" ::: "memory");
#pragma unroll
            for (int mm = 0; mm < 4; ++mm) { const int m = mh * 2 + mm;
#pragma unroll
                for (int bj = 0; bj < 2; ++bj) {
                    const u32x4 g4 = gw[mm][bj];
                    const f32x4 a0 = acc[ai][bj][m][0] + bv[bj][0], a1 = acc[ai][bj][m][1] + bv[bj][1];
                    f32x4 o0, o1;
                    o0[0] = bflo(g4.x) * sigmoidf_(a0[0]); o0[1] = bfhi(g4.x) * sigmoidf_(a0[1]);
                    o0[2] = bflo(g4.y) * sigmoidf_(a0[2]); o0[3] = bfhi(g4.y) * sigmoidf_(a0[3]);
                    o1[0] = bflo(g4.z) * sigmoidf_(a1[0]); o1[1] = bfhi(g4.z) * sigmoidf_(a1[1]);
                    o1[2] = bflo(g4.w) * sigmoidf_(a1[2]); o1[3] = bfhi(g4.w) * sigmoidf_(a1[3]);
                    *(u32x2*)(ws + opaque(off8 + (unsigned)(ai * 128 + m * 16) * (unsigned)LD8B) + bj * 128) = pack8_fp8(o0, o1, F8_BR);
                } }
            asm volatile("" ::: "memory");
        }
    }
};

struct EpiOut {
    static constexpr bool PERM = true, HAS_MID = true, HAS_PRE = true;
    unsigned char* ws;
    __device__ __forceinline__ void prefetch_mid(LAS unsigned char* dstw, const pg8::Unit& u, int wr, int wc, int fr, int fq) const {
        const int row0 = u.pm * 256 + wr * 64 + fr, col0 = u.pn * 256 + wc * 32 + 8 * fq;
        EPI_PREFETCH3(((unsigned)row0 * (unsigned)LD2 + (unsigned)col0) * 2u + (unsigned)WS_GA, LD2);
    }
    __device__ __forceinline__ void prefetch(LAS unsigned char* dstw, const pg8::Unit& u, int wr, int wc, int fr, int fq) const {
        const int row0 = u.pm * 256 + wr * 64 + fr, col0 = u.pn * 256 + wc * 32 + 8 * fq;
        EPI_PREFETCH3(((unsigned)row0 * (unsigned)LD2 + (unsigned)col0) * 2u + (unsigned)WS_GB, LD2);
    }
    __device__ __forceinline__ void mid(AccMut acc, const pg8::Unit& u, int wr, int wc, int fr, int fq) const {
        const int row0 = u.pm * 256 + wr * 64 + fr, col0 = u.pn * 256 + wc * 32 + 8 * fq;
        const unsigned off0 = ((unsigned)row0 * (unsigned)LD2 + (unsigned)col0) * 2u + (unsigned)WS_GA;
#pragma unroll
        for (int ai = 0; ai < 2; ++ai)
        {
            u32x4 av[4][2];
#pragma unroll
            for (int mm = 0; mm < 4; ++mm) { const unsigned o = opaque(off0 + (unsigned)(ai * 128 + mm * 16) * (unsigned)(LD2 * 2));
#pragma unroll
                for (int bj = 0; bj < 2; ++bj) { if (ai == 0 && 2 * mm + bj < 3) av[mm][bj] = *(const LAS u32x4*)(EPI_PRE_PTR() + (2 * mm + bj) * 8192); else av[mm][bj] = *(const u32x4*)(ws + o + bj * 256); } }
            asm volatile("" ::: "memory");
#pragma unroll
            for (int mm = 0; mm < 4; ++mm)
#pragma unroll
                for (int bj = 0; bj < 2; ++bj) {
                    const u32x4 a = av[mm][bj];
                    f32x4 r0, r1;
                    r0[0] = bflo(a.x); r0[1] = bfhi(a.x); r0[2] = bflo(a.y); r0[3] = bfhi(a.y);
                    r1[0] = bflo(a.z); r1[1] = bfhi(a.z); r1[2] = bflo(a.w); r1[3] = bfhi(a.w);
                    acc[ai][bj][mm][0] *= r0; acc[ai][bj][mm][1] *= r1;
                }
            asm volatile("" ::: "memory");
        }
    }
    __device__ __forceinline__ void operator()(AccRef acc, const pg8::Unit& u, int wr, int wc, int fr, int fq) const {
        const int row0 = u.pm * 256 + wr * 64 + fr, col0 = u.pn * 256 + wc * 32 + 8 * fq;
        const unsigned off0 = ((unsigned)row0 * (unsigned)LD2 + (unsigned)col0) * 2u + (unsigned)WS_GB, off8 = (unsigned)row0 * (unsigned)LD8B + (unsigned)col0 + (unsigned)WS_MX8;
#pragma unroll
        for (int ai = 0; ai < 2; ++ai) {
            u32x4 bv[4][2];
#pragma unroll
            for (int m = 0; m < 4; ++m) { const unsigned o = opaque(off0 + (unsigned)(ai * 128 + m * 16) * (unsigned)(LD2 * 2));
#pragma unroll
                for (int bj = 0; bj < 2; ++bj) { if (ai == 0 && 2 * m + bj < 3) bv[m][bj] = *(const LAS u32x4*)(EPI_PRE_PTR() + (2 * m + bj) * 8192); else bv[m][bj] = *(const u32x4*)(ws + o + bj * 256); } }
            asm volatile("" ::: "memory");
#pragma unroll
            for (int m = 0; m < 4; ++m)
#pragma unroll
                for (int bj = 0; bj < 2; ++bj) {
                    const u32x4 b = bv[m][bj];
                    f32x4 g0, g1; g0[0] = bflo(b.x); g0[1] = bfhi(b.x); g0[2] = bflo(b.y); g0[3] = bfhi(b.y);
                    g1[0] = bflo(b.z); g1[1] = bfhi(b.z); g1[2] = bflo(b.w); g1[3] = bfhi(b.w);
                    *(u32x2*)(ws + opaque(off8 + (unsigned)(ai * 128 + m * 16) * (unsigned)LD8B) + bj * 128) = pack8_fp8(acc[ai][bj][m][0] * g0, acc[ai][bj][m][1] * g1, F8_MX);
                }
            asm volatile("" ::: "memory");
        }
    }
};

struct EpiRes {
    static constexpr bool PERM = true, HAS_MID = false, HAS_PRE = true;
    unsigned char* ws; const float* gain; float* out;
    __device__ __forceinline__ void prefetch_mid(LAS unsigned char*, const pg8::Unit&, int, int, int, int) const {}
    __device__ __forceinline__ void prefetch(LAS unsigned char* dstw, const pg8::Unit& u, int wr, int wc, int fr, int fq) const {
        const int row0 = u.pm * 256 + wr * 64 + fr, col0 = u.pn * 256 + wc * 32 + 8 * fq;
        const unsigned offx = ((unsigned)row0 * (unsigned)LD2 + (unsigned)col0) * 2u + (unsigned)WS_XN;
#pragma unroll
        for (int j = 0; j < 3; ++j) { unsigned vo_ = offx + (unsigned)((j >> 1) * 16) * (unsigned)(LD2 * 2) + (unsigned)((j & 1) * 256); asm volatile("" : "+v"(vo_));
            __builtin_amdgcn_global_load_lds((const unsigned*)(ws + vo_), (LAS unsigned*)(dstw + j * 8192), 16, 0, 0); }
    }
    __device__ __forceinline__ void operator()(AccRef acc, const pg8::Unit& u, int wr, int wc, int fr, int fq) const {
        const int row0 = u.pm * 256 + wr * 64 + fr, col0 = u.pn * 256 + wc * 32 + 8 * fq;
        const LAS unsigned char* pre = (const LAS unsigned char*)(uintptr_t)(PRE_OFF + ((wr * 4 + wc) * 64 + fq * 16 + fr) * 16);
        f32x4 ig[2][2];
#pragma unroll
        for (int bj = 0; bj < 2; ++bj)
#pragma unroll
            for (int n = 0; n < 2; ++n) { const f32x4 gq = *(const f32x4*)(gain + col0 + bj * 128 + 4 * n);
#pragma unroll
                for (int i = 0; i < 4; ++i) ig[bj][n][i] = __builtin_amdgcn_rcpf(gq[i]); }
        char* ob = (char*)(out + O_YP);
        const unsigned offx = ((unsigned)row0 * (unsigned)LD2 + (unsigned)col0) * 2u + (unsigned)WS_XN, offy = ((unsigned)row0 * (unsigned)DM + (unsigned)col0) * 4u;
#pragma unroll
        for (int ai = 0; ai < 2; ++ai) {
            u32x4 xv[4][2]; float rr[4];
#pragma unroll
            for (int m = 0; m < 4; ++m) { const unsigned o = opaque(offx + (unsigned)(ai * 128 + m * 16) * (unsigned)(LD2 * 2));
                rr[m] = *(const float*)(ws + (unsigned)(WS_CONST + C_RS) + (unsigned)(row0 + ai * 128 + m * 16) * 4u);
#pragma unroll
                for (int bj = 0; bj < 2; ++bj) { if (ai == 0 && 2 * m + bj < 3) xv[m][bj] = *(const LAS u32x4*)(pre + (2 * m + bj) * 8192); else xv[m][bj] = __builtin_nontemporal_load((const u32x4*)(ws + o + bj * 256)); } }
            asm volatile("" ::: "memory");
#pragma unroll
            for (int m = 0; m < 4; ++m) { const unsigned o = opaque(offy + (unsigned)(ai * 128 + m * 16) * (unsigned)(DM * 4));
#pragma unroll
                for (int bj = 0; bj < 2; ++bj) {
                    const u32x4 x8 = xv[m][bj]; const float r = rr[m];
                    f32x4 x0, x1; x0[0] = bflo(x8.x); x0[1] = bfhi(x8.x); x0[2] = bflo(x8.y); x0[3] = bfhi(x8.y); x1[0] = bflo(x8.z); x1[1] = bfhi(x8.z); x1[2] = bflo(x8.w); x1[3] = bfhi(x8.w);
                    *(f32x4*)(ob + o + bj * 512) = x0 * r * ig[bj][0] + acc[ai][bj][m][0];
                    *(f32x4*)(ob + o + bj * 512 + 16) = x1 * r * ig[bj][1] + acc[ai][bj][m][1];
                } }
            asm volatile("" ::: "memory");
        }
    }
};

struct EpiNull {
    static constexpr bool PERM = true, HAS_MID = false, HAS_PRE = false; float* sink;
    __device__ __forceinline__ void operator()(AccRef acc, const pg8::Unit& u, int wr, int wc, int fr, int fq) const {
        f32x4 s = (f32x4){0.f, 0.f, 0.f, 0.f};
#pragma unroll
        for (int ai = 0; ai < 2; ++ai)
#pragma unroll
            for (int bj = 0; bj < 2; ++bj)
#pragma unroll
                for (int m = 0; m < 4; ++m)
#pragma unroll
                    for (int n = 0; n < 2; ++n) s += acc[ai][bj][m][n];
        if (s[0] + s[1] + s[2] + s[3] == 12345.678f) sink[fr] = s[0];
    }
};

#define XB_TMO      128
#define XB_XCNT(j)  (256  + 64 * (j))
#define XB_XSUB(j)  (1280 + 64 * (j))
#define XB_XGEN(j)  (2304 + 64 * (j))
#define XB_TOP      3328
#define XB_TOPGEN   3392
#define XCD_BAR_WORDS 3456
#define XB_SPIN_CAP (1u << 18)
__device__ __forceinline__ unsigned xb_ld(unsigned* p)              { return __hip_atomic_load(p, __ATOMIC_RELAXED, __HIP_MEMORY_SCOPE_AGENT); }
__device__ __forceinline__ unsigned xb_add(unsigned* p, unsigned v) { return __hip_atomic_fetch_add(p, v, __ATOMIC_RELAXED, __HIP_MEMORY_SCOPE_AGENT); }
__device__ __forceinline__ unsigned xb_xcc_id() { return (unsigned)__builtin_amdgcn_s_getreg((3 << 11) | 20) & 0xFu; }
#define XB_SPIN(cond, bar) do { unsigned _sp = 0; while (cond) { __builtin_amdgcn_s_sleep(1); \
    if ((++_sp & 255u) == 0u) { if (xb_ld(&(bar)[XB_TMO])) break; if (_sp > XB_SPIN_CAP) { atomicAdd(&(bar)[XB_TMO], 1u); break; } } } } while (0)
struct XcdBarrier { unsigned* bar; unsigned x; volatile LAS unsigned* st; unsigned expect; };
__device__ __forceinline__ XcdBarrier xcd_barrier_post(unsigned* bar, volatile LAS unsigned* st, unsigned expect, bool leader) {
    XcdBarrier b; b.bar = bar; b.x = xb_xcc_id(); b.st = st; b.expect = expect;
    if (leader) (void)xb_add(&bar[XB_XCNT(b.x)], 1u);
    return b;
}
__device__ __forceinline__ void xcd_barrier_complete(unsigned* bar, unsigned x, unsigned G, unsigned& nloc, unsigned& nx) {
    unsigned sum, cnt, mine, sp = 0u;
    for (;;) {
        sum = 0u; cnt = 0u; mine = 0u;
#pragma unroll
        for (unsigned j = 0; j < 16; ++j) { const unsigned c = xb_ld(&bar[XB_XCNT(j)]); sum += c; cnt += (c > 0u) ? 1u : 0u; mine = (j == x) ? c : mine; }
        if (sum == G) break;
        __builtin_amdgcn_s_sleep(1);
        if ((++sp & 255u) == 0u) { if (xb_ld(&bar[XB_TMO])) break; if (sp > XB_SPIN_CAP) { atomicAdd(&bar[XB_TMO], 1u); break; } }
    }
    nloc = mine > 0u ? mine : 1u; nx = cnt > 0u ? cnt : 1u;
}
__device__ __forceinline__ void xcd_barrier(unsigned* bbar, unsigned bx, volatile LAS unsigned* bst, unsigned bexpect, bool leader) {
    struct { unsigned* bar; unsigned x; volatile LAS unsigned* st; unsigned expect; } b = {bbar, bx, bst, bexpect};
    asm volatile("s_waitcnt vmcnt(0)" ::: "memory");
    __syncthreads();
    if (leader) {
        unsigned* bar = b.bar;
        __builtin_amdgcn_s_waitcnt(0);
        unsigned nloc = b.st[0], nx = b.st[1];
        if (nloc == 0u) { xcd_barrier_complete(bar, b.x, b.expect, nloc, nx); b.st[0] = nloc; b.st[1] = nx; }
        const unsigned old = xb_add(&bar[XB_XSUB(b.x)], 1u);
        const unsigned gen = old / nloc;
        if (old + 1u == (gen + 1u) * nloc) {
            __builtin_amdgcn_fence(__ATOMIC_RELEASE, "agent");
            asm volatile("s_waitcnt vmcnt(0)" ::: "memory");
            const unsigned og = xb_add(&bar[XB_TOP], 1u);
            const unsigned tg = og / nx;
            if (og + 1u == (tg + 1u) * nx) xb_add(&bar[XB_TOPGEN], 1u);
            else XB_SPIN(xb_ld(&bar[XB_TOPGEN]) == tg, bar);
            __builtin_amdgcn_fence(__ATOMIC_ACQUIRE, "agent");
            xb_add(&bar[XB_XGEN(b.x)], 1u);
            asm volatile("s_waitcnt vmcnt(0)" ::: "memory");
        } else {
            XB_SPIN(xb_ld(&bar[XB_XGEN(b.x)]) == gen, bar);
            __builtin_amdgcn_fence(__ATOMIC_ACQUIRE, "agent");
            asm volatile("s_waitcnt vmcnt(0)" ::: "memory");
        }
    }
    __syncthreads();
}

__device__ __forceinline__ void grp_barrier(unsigned* gw, unsigned target, bool colocated, bool leader) {
    asm volatile("s_waitcnt vmcnt(0)" ::: "memory");
    __syncthreads();
    if (leader) {
        if (!colocated) { __builtin_amdgcn_fence(__ATOMIC_RELEASE, "agent"); asm volatile("s_waitcnt vmcnt(0)" ::: "memory"); }
        const unsigned old = xb_add(gw, 1u);
        if (old + 1u == 32u * target) __hip_atomic_store(gw + 16, target, __ATOMIC_RELAXED, __HIP_MEMORY_SCOPE_AGENT);
        else { unsigned sp = 0u; while (xb_ld(gw + 16) < target) { __builtin_amdgcn_s_sleep(1); if (++sp > XB_SPIN_CAP) break; } }
        if (colocated) asm volatile("buffer_inv sc0" ::: "memory"); else __builtin_amdgcn_fence(__ATOMIC_ACQUIRE, "agent");
        asm volatile("s_waitcnt vmcnt(0)" ::: "memory");
    }
    __syncthreads();
}

__device__ __forceinline__ void xcd_stagger(unsigned xcc, unsigned ticks_per_step) {
    const unsigned long long t0 = __builtin_amdgcn_s_memrealtime(), want = (unsigned long long)((xcc & 3u) * ticks_per_step);
    while (__builtin_amdgcn_s_memrealtime() - t0 < want) __builtin_amdgcn_s_sleep(16);
}

struct Args {
    const float* in[25]; float* out; unsigned char* ws; int ph_lo, ph_hi;
};
typedef const __attribute__((address_space(4))) Args* KArgs;
__device__ __forceinline__ KArgs kargs_fresh() { KArgs p = (KArgs)__builtin_amdgcn_kernarg_segment_ptr(); asm volatile("" : "+s"(p)); return p; }
struct Frame {
    LAS unsigned char* lds; int tid, lane, wave;
    float* out; unsigned char* ws;
};
__device__ __forceinline__ float wave_sum(float v) {
#pragma unroll
    for (int o = 1; o < 64; o <<= 1) v += __shfl_xor(v, o);
    return v;
}

template <bool SIGMA, bool WTHRU = false>
__device__ __forceinline__ void p0_transpose_item(const float* W, int N, bf16_t* WT, int ldk, int koff, LAS float* scr, int item, int lane, unsigned char* WT8 = nullptr, int ldk8 = 0) {
    const int nblk = N / 32, kb = item / nblk, nb = item % nblk, k0 = 64 * kb, n0 = 32 * nb;
#pragma unroll 8
    for (int i = 0; i < 32; ++i) { const int kk = 2 * i + (lane >> 5); scr[kk * 33 + (lane & 31)] = W[(size_t)(k0 + kk) * N + n0 + (lane & 31)]; }
    asm volatile("s_waitcnt lgkmcnt(0)" ::: "memory");
    const int c = lane & 7;
#pragma unroll
    for (int j = 0; j < 4; ++j) { const int n = (lane >> 3) + 8 * j; const LAS float* s = scr + (8 * c) * 33 + n;
        const float sc = (SIGMA && n0 + n >= 4352) ? -LOG2E : 1.0f;
        u32x4 o; o.x = cvt_pk_bf16(s[0 * 33] * sc, s[1 * 33] * sc); o.y = cvt_pk_bf16(s[2 * 33] * sc, s[3 * 33] * sc); o.z = cvt_pk_bf16(s[4 * 33] * sc, s[5 * 33] * sc); o.w = cvt_pk_bf16(s[6 * 33] * sc, s[7 * 33] * sc);
        int nl = n0 + n;
        if (SIGMA) { if (nl >= 4352) { const int c_ = (nl - 4352) & 2047, gate_ = (nl - 4352) >> 11; nl = (17 + (c_ >> 7)) * 256 + 128 * gate_ + (c_ & 127); }
            else { const int lc = nl & 255, wcc = lc >> 6, bjj = (lc >> 5) & 1, jj = lc & 31; nl = (nl & ~255) + 128 * bjj + 32 * wcc + jj; } }
        st16_wt_early((char*)WT, (unsigned)(((size_t)nl * ldk + koff + k0 + 8 * c) * 2), o, WTHRU);
        if (SIGMA) { if (n0 >= 3328 || (n0 >= 1024 && n0 < 3072)) { const int nl8 = n0 >= 3072 ? nl - 3328 + 2048 : nl - 1024; u32x2 o8; o8.x = pk4_fp8(s[0 * 33] * (sc * F8_W), s[1 * 33] * (sc * F8_W), s[2 * 33] * (sc * F8_W), s[3 * 33] * (sc * F8_W)); o8.y = pk4_fp8(s[4 * 33] * (sc * F8_W), s[5 * 33] * (sc * F8_W), s[6 * 33] * (sc * F8_W), s[7 * 33] * (sc * F8_W));
            if (WTHRU) __hip_atomic_store((GAS1 unsigned long long*)(GAS1 unsigned char*)(WT8 + (size_t)nl8 * ldk8 + koff + k0 + 8 * c), ((unsigned long long)o8.y << 32) | o8.x, __ATOMIC_RELAXED, __HIP_MEMORY_SCOPE_AGENT); else *(u32x2*)(WT8 + (size_t)nl8 * ldk8 + koff + k0 + 8 * c) = o8; } }
        else if (WT8) { u32x2 o8; o8.x = pk4_fp8(s[0 * 33] * F8_W, s[1 * 33] * F8_W, s[2 * 33] * F8_W, s[3 * 33] * F8_W); o8.y = pk4_fp8(s[4 * 33] * F8_W, s[5 * 33] * F8_W, s[6 * 33] * F8_W, s[7 * 33] * F8_W);
            if (WTHRU) __hip_atomic_store((GAS1 unsigned long long*)(GAS1 unsigned char*)(WT8 + (size_t)nl * ldk8 + koff + k0 + 8 * c), ((unsigned long long)o8.y << 32) | o8.x, __ATOMIC_RELAXED, __HIP_MEMORY_SCOPE_AGENT); else *(u32x2*)(WT8 + (size_t)nl * ldk8 + koff + k0 + 8 * c) = o8; } }
    asm volatile("s_waitcnt lgkmcnt(0)" ::: "memory");
}
template <int NOST = 0>
__device__ __forceinline__ void p0_norm_row(const float* xrow, const f32x4 (&gv)[8], bf16_t* orow, unsigned char* orow8, float* rs, int lane, LAS unsigned char* rp) {
    const f32x4* xr = (const f32x4*)xrow + lane;
    f32x4 v[8]; float s = 0.f;
#pragma unroll
    for (int j = 0; j < 8; ++j) { v[j] = __builtin_nontemporal_load(xr + 64 * j); s += (v[j][0] * v[j][0] + v[j][1] * v[j][1]) + (v[j][2] * v[j][2] + v[j][3] * v[j][3]); }
    const float rms = sqrtf(wave_sum(s) * (1.0f / DM) + EPSN), rstd = 1.0f / rms;
    if (rs && lane == 0) *rs = rms;
#pragma unroll
    for (int j = 0; j < 8; ++j) { const f32x4 y = v[j] * rstd * gv[j]; u32x2 w; w.x = cvt_pk_bf16(y[0], y[1]); w.y = cvt_pk_bf16(y[2], y[3]); *(LAS u32x2*)(rp + 8 * lane + 512 * j) = w;
        if (orow8) *(LAS unsigned*)(rp + 4096 + 4 * lane + 256 * j) = pk4_fp8(y[0] * F8_X, y[1] * F8_X, y[2] * F8_X, y[3] * F8_X); }
    asm volatile("" ::: "memory");
    if (NOST != 1) {
#pragma unroll
        for (int i = 0; i < 4; ++i) { const u32x4 t = *(const LAS u32x4*)(rp + 16 * lane + 1024 * i); st16_wt_early((char*)orow, 16 * lane + 1024 * i, t, NOST == 2); } }
    if (orow8 && NOST == 0) {
#pragma unroll
        for (int i = 0; i < 2; ++i) { const u32x4 t = *(const LAS u32x4*)(rp + 4096 + 16 * lane + 1024 * i); *(u32x4*)(orow8 + 16 * lane + 1024 * i) = t; } }
    asm volatile("" ::: "memory");
}
template <int PARTS, bool LOC = false>
__device__ __forceinline__ void p0_prologue(Frame& F, unsigned* pubw = nullptr) {
    const KArgs ARp = kargs_fresh();
#define AR (*ARp)
    LAS float* scr = (LAS float*)(F.lds + F.wave * 16384);
    const float* w_in = ((const float*)(GAS1 const float*)AR.in[7]); const float* w_glu = ((const float*)(GAS1 const float*)AR.in[16]); const float* w_oa = ((const float*)(GAS1 const float*)AR.in[22]); const float* w_ob = ((const float*)(GAS1 const float*)AR.in[23]); const float* w_o = ((const float*)(GAS1 const float*)AR.in[24]);
    bf16_t* WIN = (bf16_t*)(F.ws + WS_WIN); bf16_t* WGLU = (bf16_t*)(F.ws + WS_WGLU); bf16_t* WOUT = (bf16_t*)(F.ws + WS_WOUT); bf16_t* WO = (bf16_t*)(F.ws + WS_WO);
    constexpr int I_IN = (DM / 64) * (NIN / 32), I_GLU = (1024 / 64) * (1024 / 32), I_OA = (1024 / 64) * (DM / 32), I_O = (DM / 64) * (DM / 32);
    (void)w_glu; (void)w_oa; (void)w_ob; (void)w_o; (void)WGLU; (void)WOUT; (void)WO; (void)I_GLU; (void)I_OA; (void)I_O;
    if (PARTS & 1) for (int it = ((int)blockIdx.x * 8 + F.wave); it < I_IN; it += ((int)gridDim.x * 8))
        p0_transpose_item<true, LOC>(w_in, NIN, WIN, LD2, 0, scr, it, F.lane, F.ws + WS_W8IN, LD8B);
    if (PARTS & 2) { f32x4 gv[8];
#pragma unroll
      for (int j = 0; j < 8; ++j) gv[j] = ((const f32x4*)((const float*)(GAS1 const float*)AR.in[6]))[F.lane + 64 * j];
      bf16_t* XN = (bf16_t*)(F.ws + WS_XN);
      const int wgl_ = (int)blockIdx.x * 8 + F.wave;
      for (int it_ = 0; it_ < (MROWS + (int)gridDim.x * 8 - 1) / ((int)gridDim.x * 8); ++it_) {
          const int m = (LOC && it_ < 16) ? 4096 * ((int)blockIdx.x & 7) + (((int)blockIdx.x >> 3) * 8 + F.wave) + 256 * it_ : wgl_ + (int)gridDim.x * 8 * it_;
          if (m >= MROWS) break;
          if (m < MP) p0_norm_row<(PARTS >> 3) & 3>(((const float*)(GAS1 const float*)AR.in[0]) + (size_t)m * DM, gv, XN + (size_t)m * LD2, F.ws + WS_XN8 + (size_t)m * LD8B, (float*)(F.ws + WS_CONST + C_RS) + m, F.lane, (LAS unsigned char*)scr);
          else if (m < MP + MS) p0_norm_row<LOC ? 2 : 0>(((const float*)(GAS1 const float*)AR.in[1]) + (size_t)(m - MP) * DM, gv, XN + (size_t)m * LD2, nullptr, nullptr, F.lane, (LAS unsigned char*)scr);
          else { u32x2* o8 = (u32x2*)(XN + (size_t)m * LD2) + F.lane;
#pragma unroll
              for (int j = 0; j < 8; ++j) { if (LOC) __hip_atomic_store((GAS1 unsigned long long*)(GAS1 u32x2*)(o8 + 64 * j), 0ull, __ATOMIC_RELAXED, __HIP_MEMORY_SCOPE_AGENT); else o8[64 * j] = (u32x2){0u, 0u}; } }
      } }
    const int gt = (PARTS & 4) ? (((int)gridDim.x == 256) ? ((int)blockIdx.x >> 3) * 512 + F.tid : (int)blockIdx.x * 512 + F.tid) : (1 << 30);
    if (gt < NGRP * NSTATE) {
        const int g = gt >> 6, p = gt & 63;
        const double are = (double)((const float*)(GAS1 const float*)AR.in[8])[gt], aim = (double)((const float*)(GAS1 const float*)AR.in[9])[gt], dt = exp((double)((const float*)(GAS1 const float*)AR.in[10])[g]);
        const double mag = exp(are * dt), ang = aim * dt, lre = mag * cos(ang), lim = mag * sin(ang);
        const double den = are * are + aim * aim, cr = ((lre - 1.0) * are + lim * aim) / den, ci = (lim * are - (lre - 1.0) * aim) / den;
        float* LAM = (float*)(F.ws + ctab_off() + C_LAM); float* LAM64 = (float*)(F.ws + ctab_off() + C_LAM64);
        ST_WT(float, &LAM[2 * gt], (float)lre, false); ST_WT(float, &LAM[2 * gt + 1], (float)lim, false);
        double pr = lre, pi = lim;
#pragma unroll 1
        for (int i = 0; i < 10; ++i) { const double nr = pr * pr - pi * pi, ni = 2.0 * pr * pi; pr = nr; pi = ni; }
        ST_WT(float, &LAM64[2 * gt], (float)pr, false); ST_WT(float, &LAM64[2 * gt + 1], (float)pi, false);
        bf16_t* BF = (bf16_t*)(F.ws + ctab_off() + C_BF); bf16_t* CF = (bf16_t*)(F.ws + ctab_off() + C_CF);
        const float* bre = ((const float*)(GAS1 const float*)AR.in[11]) + (size_t)gt * 16; const float* bim = ((const float*)(GAS1 const float*)AR.in[12]) + (size_t)gt * 16;
#pragma unroll
        for (int q = 0; q < 4; ++q) {
            float bbr[4], bbi[4];
#pragma unroll
            for (int jj = 0; jj < 4; ++jj) { const double br = (double)bre[4 * q + jj], bi = (double)bim[4 * q + jj]; bbr[jj] = (float)(cr * br - ci * bi); bbi[jj] = (float)(cr * bi + ci * br); }
            { const int row = p, pt = row >> 4, ps = row & 15; *(u32x2*)&BF[((size_t)(g * 8 + pt) * 64 + 16 * q + ps) * 4] = (u32x2){cvt_pk_bf16(bbr[0], bbr[1]), cvt_pk_bf16(bbr[2], bbr[3])}; }
            { const int row = 64 + p, pt = row >> 4, ps = row & 15; *(u32x2*)&BF[((size_t)(g * 8 + pt) * 64 + 16 * q + ps) * 4] = (u32x2){cvt_pk_bf16(bbi[0], bbi[1]), cvt_pk_bf16(bbi[2], bbi[3])}; }
        }
#pragma unroll
        for (int c = 0; c < 16; ++c) {
            const float cre = ((const float*)(GAS1 const float*)AR.in[13])[(size_t)(g * 16 + c) * 64 + p], cim = ((const float*)(GAS1 const float*)AR.in[14])[(size_t)(g * 16 + c) * 64 + p];
            const int ks = p >> 4, qq = (p >> 2) & 3, jb = 2 * (p & 3);
            *(unsigned*)&CF[((size_t)(g * 4 + ks) * 64 + 16 * qq + c) * 8 + jb] = cvt_pk_bf16(cre, -cim);
        }
    }
    if (gt < 16 * 256) {
        const int h = gt >> 8, idx = gt & 255; float v = 0.f;
        if (idx < 255) { const int rel = idx - 191; int n = -rel; const int ret = n < 0 ? 16 : 0; n = n < 0 ? -n : n;
            const int large = 8 + (n >= 12) + (n >= 16) + (n >= 23) + (n >= 32) + (n >= 46) + (n >= 64) + (n >= 91);
            const int bucket = ret + (n < 8 ? n : large); v = ((const float*)(GAS1 const float*)AR.in[21])[bucket * 16 + h] * LOG2E; }
        ST_WT(float, &((float*)(F.ws + ctab_off() + C_BT))[gt], v, false);
    }
}

#undef AR
__device__ __forceinline__ void p1_late_weights(Frame& F, int rank, int nrank) {
    const KArgs ARp = kargs_fresh();
    LAS float* scr = (LAS float*)(F.lds + F.wave * 16384);
    const float* w_glu = (const float*)(GAS1 const float*)ARp->in[16]; const float* w_oa = (const float*)(GAS1 const float*)ARp->in[22];
    const float* w_ob = (const float*)(GAS1 const float*)ARp->in[23]; const float* w_o = (const float*)(GAS1 const float*)ARp->in[24];
    bf16_t* WGLU = (bf16_t*)(F.ws + WS_WGLU); bf16_t* WOUT = (bf16_t*)(F.ws + WS_WOUT); bf16_t* WO = (bf16_t*)(F.ws + WS_WO);
    constexpr int I_GLU = (1024 / 64) * (1024 / 32), I_OA = (1024 / 64) * (DM / 32), I_O = (DM / 64) * (DM / 32);
    for (int it = rank * 8 + F.wave; it < I_GLU + 2 * I_OA + I_O; it += nrank * 8) {
        int r = it;
        if (r < I_GLU) { p0_transpose_item<false>(w_glu, 1024, WGLU, LD1, 0, scr, r, F.lane, F.ws + WS_W8GLU, LD8A); continue; } r -= I_GLU;
        if (r < I_OA) { p0_transpose_item<false>(w_oa, DM, WOUT, LD2, 0, scr, r, F.lane, F.ws + WS_W8OUT, LD8B); continue; } r -= I_OA;
        if (r < I_OA) { p0_transpose_item<false>(w_ob, DM, WOUT, LD2, 1024, scr, r, F.lane, F.ws + WS_W8OUT, LD8B); continue; } r -= I_OA;
        p0_transpose_item<false>(w_o, DM, WO, LD2, 0, scr, r, F.lane, F.ws + WS_W8O, LD8B);
    }
}

__device__ __forceinline__ void p24_map(int c, int G, int& b, int& seg, int& gs) {
    if (G == 256) { b = c & 7; const int r = c >> 3; seg = r >> 3; gs = r & 7; }
    else { gs = c & 7; const int bs = c >> 3; b = bs >> 2; seg = bs & 3; }
}
constexpr int SSM_UROW = 272, SSM_UT = 64 * SSM_UROW, SSM_BU = 128 * 80, SSM_HC = 16 * 272;
template <bool FULL>
__device__ __forceinline__ void ssm_unit(Frame& F, const float* ssm_d, const bf16_t* U, bf16_t* Uo, int rowbase, int T, int gs, const float* hin_re, const float* hin_im, float* hout_re, float* hout_im) {
    LAS unsigned char* ut = F.lds;
    LAS unsigned char* bu = F.lds + SSM_UT + F.wave * SSM_BU;
    LAS unsigned char* hc = F.lds + SSM_UT + 8 * SSM_BU + F.wave * SSM_HC;
    const int lane = F.lane, w = F.wave, fr = lane & 15, fq = lane >> 4, g = gs * 8 + w;
#pragma unroll
    for (int i = 0; i < 2; ++i) { const int idx = F.tid + 512 * i, row = idx >> 4, ch = idx & 15;
        u32x4 v = (u32x4){0u, 0u, 0u, 0u};
        if (row < T) v = *(const u32x4*)(U + (size_t)(rowbase + row) * LD1 + gs * 128 + ch * 8);
        *(LAS u32x4*)(ut + row * SSM_UROW + ch * 16) = v; }
    const f32x2 lam = ((const f32x2*)(F.ws + ctab_off() + C_LAM))[g * 64 + lane];
    u32x2 bfr[8];
#pragma unroll
    for (int pt = 0; pt < 8; ++pt) bfr[pt] = ((const u32x2*)(F.ws + ctab_off() + C_BF))[(size_t)(g * 8 + pt) * 64 + lane];
    u32x4 cfr[4]; float dsk = 0.f;
    if (FULL) {
#pragma unroll
        for (int ks = 0; ks < 4; ++ks) cfr[ks] = ((const u32x4*)(F.ws + ctab_off() + C_CF))[(size_t)(g * 4 + ks) * 64 + lane];
        dsk = ssm_d[g * 16 + fr];
    }
    float hre = 0.f, him = 0.f;
    if (FULL && hin_re) { hre = hin_re[lane]; him = hin_im[lane]; }
    __syncthreads();
    const int nsb = T >> 4;
    for (int sb = 0; sb < nsb; ++sb) {
        const s16x4 af = __builtin_bit_cast(s16x4, *(const LAS u32x2*)(ut + (16 * sb + fr) * SSM_UROW + w * 32 + fq * 8));
#pragma unroll
        for (int pt = 0; pt < 8; ++pt) {
            const f32x4 d = __builtin_amdgcn_mfma_f32_16x16x16bf16_1k(af, __builtin_bit_cast(s16x4, bfr[pt]), (f32x4){0.f, 0.f, 0.f, 0.f}, 0, 0, 0);
            *(LAS f32x4*)(bu + (16 * pt + fr) * 80 + fq * 16) = d;
        }
        asm volatile("s_waitcnt lgkmcnt(0)" ::: "memory");
        f32x4 br[4], bi[4];
#pragma unroll
        for (int k = 0; k < 4; ++k) { br[k] = *(const LAS f32x4*)(bu + lane * 80 + k * 16); bi[k] = *(const LAS f32x4*)(bu + (64 + lane) * 80 + k * 16); }
#pragma unroll
        for (int t = 0; t < 16; ++t) {
            const float nre = lam.x * hre - lam.y * him + br[t >> 2][t & 3];
            const float nim = lam.x * him + lam.y * hre + bi[t >> 2][t & 3];
            hre = nre; him = nim;
            if (FULL) *(LAS unsigned*)(hc + t * 272 + lane * 4) = cvt_pk_bf16(hre, him);
        }
        if (FULL) {
            asm volatile("s_waitcnt lgkmcnt(0)" ::: "memory");
            f32x4 y = (f32x4){0.f, 0.f, 0.f, 0.f};
#pragma unroll
            for (int ks = 0; ks < 4; ++ks) {
                const bf16x8 a = *(const LAS bf16x8*)(hc + fr * 272 + ks * 64 + fq * 16);
                y = __builtin_amdgcn_mfma_f32_16x16x32_bf16(a, __builtin_bit_cast(bf16x8, cfr[ks]), y, 0, 0, 0);
            }
#pragma unroll
            for (int r = 0; r < 4; ++r) {
                LAS unsigned short* up = (LAS unsigned short*)(ut + (16 * sb + 4 * fq + r) * SSM_UROW + w * 32 + fr * 2);
                const float uv = bf2f(*up);
                *up = (unsigned short)(cvt_pk_bf16(geluf_(y[r] + dsk * uv), 0.f) & 0xffffu);
            }
            asm volatile("s_waitcnt lgkmcnt(0)" ::: "memory");
        }
    }
    if (hout_re) { hout_re[lane] = hre; hout_im[lane] = him; }
    if (FULL) {
        __syncthreads();
#pragma unroll
        for (int i = 0; i < 2; ++i) { const int idx = F.tid + 512 * i, row = idx >> 4, ch = idx & 15;
            if (row < T) { const u32x4 t_ = *(const LAS u32x4*)(ut + row * SSM_UROW + ch * 16); GAS1 unsigned long long* d_ = (GAS1 unsigned long long*)(GAS1 bf16_t*)(Uo + (size_t)(rowbase + row) * LD1 + gs * 128 + ch * 8);
                __hip_atomic_store(d_, ((unsigned long long)t_.y << 32) | t_.x, __ATOMIC_RELAXED, __HIP_MEMORY_SCOPE_AGENT); __hip_atomic_store(d_ + 1, ((unsigned long long)t_.w << 32) | t_.z, __ATOMIC_RELAXED, __HIP_MEMORY_SCOPE_AGENT); } }
        asm volatile("s_waitcnt vmcnt(0)" ::: "memory");
    }
    __syncthreads();
}

template <bool FULL, int VAR = 0>
__device__ __forceinline__ void ssm_phase(Frame& F, const float* ssm_d, const bf16_t* U, bf16_t* Uo, float* Sseg, float* outre, float* outim, unsigned char* G8) {
    LAS unsigned char* ut = F.lds;
    LAS unsigned char* bu = F.lds + SSM_UT + F.wave * SSM_BU;
    LAS unsigned char* hc = F.lds + SSM_UT + 8 * SSM_BU + F.wave * SSM_HC;
    const int lane = F.lane, w = F.wave, fr = lane & 15, fq = lane >> 4;
    const int trow = F.tid >> 4, tch = F.tid & 15;
    for (int item = blockIdx.x; item < NBATCH * 4 * 8; item += ((int)gridDim.x)) {
        int gs, b, seg; p24_map(item, (int)gridDim.x, b, seg, gs); const int g = gs * 8 + w;
        if (!FULL && seg == 3) continue;
        const f32x2 lam = ((const f32x2*)(F.ws + ctab_off() + C_LAM))[g * 64 + lane];
        u32x2 bfr[8];
#pragma unroll
        for (int pt = 0; pt < 8; ++pt) bfr[pt] = ((const u32x2*)(F.ws + ctab_off() + C_BF))[(size_t)(g * 8 + pt) * 64 + lane];
        u32x4 cfr[4]; float dsk = 0.f;
        float hre = 0.f, him = 0.f;
        if (FULL) {
#pragma unroll
            for (int ks = 0; ks < 4; ++ks) cfr[ks] = ((const u32x4*)(F.ws + ctab_off() + C_CF))[(size_t)(g * 4 + ks) * 64 + lane];
            dsk = ssm_d[g * 16 + fr];
            const f32x2 lk = ((const f32x2*)(F.ws + ctab_off() + C_LAM64))[g * 64 + lane];
            float sre_[3], sim_[3];
#pragma unroll
            for (int sp = 0; sp < 3; ++sp) { const float* sp_ = Sseg + ((size_t)((b * 4 + (sp < seg ? sp : 0)) * NGRP + g)) * 128 + lane; sre_[sp] = sp_[0]; sim_[sp] = sp_[64]; }
#pragma unroll
            for (int sp = 0; sp < 3; ++sp) if (sp < seg) { const float nre = lk.x * hre - lk.y * him + sre_[sp], nim = lk.x * him + lk.y * hre + sim_[sp]; hre = nre; him = nim; }
        }
        f32x2 hh = {hre, him}; const f32x2 lrr = {lam.x, lam.x}, lix = {-lam.y, lam.y};
        const int bj0 = b * 64 + seg * 16;
        u32x4 pre0, pre1;
        { const bf16_t* up = U + (size_t)(bj0 * 64 + trow) * LD1 + gs * 128 + tch * 8; pre0 = *(const u32x4*)up; pre1 = *(const u32x4*)(up + (size_t)32 * LD1); }
        for (int k = 0; k < 16; ++k) {
            const int bj = bj0 + k;
            *(LAS u32x4*)(ut + trow * SSM_UROW + tch * 16) = pre0;
            *(LAS u32x4*)(ut + (trow + 32) * SSM_UROW + tch * 16) = pre1;
            __syncthreads();
            if (k < 15) { const bf16_t* up = U + (size_t)((bj + 1) * 64 + trow) * LD1 + gs * 128 + tch * 8; pre0 = *(const u32x4*)up; pre1 = *(const u32x4*)(up + (size_t)32 * LD1); }
            u32x4 za0 = (u32x4){0u, 0u, 0u, 0u}, za1 = za0;
            if (FULL) { const bf16_t* zp = U + (size_t)(WS_ZA - WS_U) / 2 + (size_t)(bj * 64 + trow) * LD1 + gs * 128 + tch * 8; za0 = *(const u32x4*)zp; za1 = *(const u32x4*)(zp + (size_t)32 * LD1); }
#define SSM_FENCE() asm volatile("" ::: "memory")
            f32x4 dA[8];
#define SSM_A_MFMA(sb_) do { const s16x4 af_ = __builtin_bit_cast(s16x4, *(const LAS u32x2*)(ut + (16 * (sb_) + fr) * SSM_UROW + w * 32 + fq * 8)); \
                _Pragma("unroll") for (int pt = 0; pt < 8; ++pt) dA[pt] = __builtin_amdgcn_mfma_f32_16x16x16bf16_1k(af_, __builtin_bit_cast(s16x4, bfr[pt]), (f32x4){0.f, 0.f, 0.f, 0.f}, 0, 0, 0); } while (0)
#define SSM_SWAP32(x_, y_) do { const auto r_ = __builtin_amdgcn_permlane32_swap(__float_as_uint(x_), __float_as_uint(y_), false, false); x_ = __uint_as_float(r_[0]); y_ = __uint_as_float(r_[1]); } while (0)
#define SSM_SWAP16(x_, y_) do { const auto r_ = __builtin_amdgcn_permlane16_swap(__float_as_uint(x_), __float_as_uint(y_), false, false); x_ = __uint_as_float(r_[0]); y_ = __uint_as_float(r_[1]); } while (0)
#define SSM_TRANSPOSE() do { _Pragma("unroll") for (int c_ = 0; c_ < 2; ++c_) _Pragma("unroll") for (int r_i = 0; r_i < 4; ++r_i) { \
                float x0 = dA[4 * c_][r_i], x1 = dA[4 * c_ + 1][r_i], x2 = dA[4 * c_ + 2][r_i], x3 = dA[4 * c_ + 3][r_i]; \
                SSM_SWAP32(x0, x2); SSM_SWAP32(x1, x3); SSM_SWAP16(x0, x1); SSM_SWAP16(x2, x3); \
                bN[4 * c_][r_i] = x0; bN[4 * c_ + 1][r_i] = x1; bN[4 * c_ + 2][r_i] = x2; bN[4 * c_ + 3][r_i] = x3; } } while (0)
            f32x4 bN[8];
            if (VAR != 5) {
            SSM_A_MFMA(0); SSM_TRANSPOSE();
            bf16x8 ca[4];
#pragma unroll
            for (int sb = 0; sb < 4; ++sb) {
                f32x4 bv[8];
#pragma unroll
                for (int kk = 0; kk < 8; ++kk) bv[kk] = bN[kk];
                if (FULL && sb > 0 && VAR != 6 && VAR != 7) {
#pragma unroll
                    for (int ks = 0; ks < 4; ++ks) ca[ks] = *(const LAS bf16x8*)(hc + fr * 272 + ks * 64 + fq * 16);
                }
                SSM_FENCE();
                if (sb < 3) SSM_A_MFMA(sb + 1);
                f32x4 y = (f32x4){0.f, 0.f, 0.f, 0.f};
                if (FULL && sb > 0 && VAR != 6 && VAR != 7) {
#pragma unroll
                    for (int ks = 0; ks < 4; ++ks) y = __builtin_amdgcn_mfma_f32_16x16x32_bf16(ca[ks], __builtin_bit_cast(bf16x8, cfr[ks]), y, 0, 0, 0);
                }
                SSM_FENCE();
#pragma unroll
                for (int t = 0; t < 16; ++t) {
                    const float bre_ = bv[t >> 2][t & 3], bim_ = bv[4 + (t >> 2)][t & 3];
                    if (VAR != 1) { const float nre_ = __builtin_fmaf(lrr.x, hh.x, __builtin_fmaf(lix.x, hh.y, bre_)), nim_ = __builtin_fmaf(lrr.x, hh.y, __builtin_fmaf(lix.y, hh.x, bim_));
                    hh.x = nre_; hh.y = nim_; } else { hh.x += bre_; hh.y += bim_ * 0.5f; }
                    if (FULL && VAR != 7) *(LAS unsigned*)(hc + t * 272 + lane * 4) = cvt_pk_bf16_nv(hh.x, hh.y);
                }
                SSM_FENCE();
                if (sb < 3) SSM_TRANSPOSE();
                if (FULL && sb > 0 && VAR != 6 && VAR != 7) {
#pragma unroll
                    for (int r = 0; r < 4; ++r) {
                        LAS unsigned short* up = (LAS unsigned short*)(ut + (16 * (sb - 1) + 4 * fq + r) * SSM_UROW + w * 32 + fr * 2);
                        const float uv = bf2f(*up);
                        *up = (unsigned short)(cvt_pk_bf16_nv((VAR == 2 ? (y[r] + dsk * uv) : geluf_(y[r] + dsk * uv)), 0.f) & 0xffffu);
                    }
                    SSM_FENCE();
                }
            }
            if (FULL && VAR != 6 && VAR != 7) {
                f32x4 y = (f32x4){0.f, 0.f, 0.f, 0.f};
#pragma unroll
                for (int ks = 0; ks < 4; ++ks) {
                    const bf16x8 a = *(const LAS bf16x8*)(hc + fr * 272 + ks * 64 + fq * 16);
                    y = __builtin_amdgcn_mfma_f32_16x16x32_bf16(a, __builtin_bit_cast(bf16x8, cfr[ks]), y, 0, 0, 0);
                }
#pragma unroll
                for (int r = 0; r < 4; ++r) {
                    LAS unsigned short* up = (LAS unsigned short*)(ut + (16 * 3 + 4 * fq + r) * SSM_UROW + w * 32 + fr * 2);
                    const float uv = bf2f(*up);
                    *up = (unsigned short)(cvt_pk_bf16_nv((VAR == 2 ? (y[r] + dsk * uv) : geluf_(y[r] + dsk * uv)), 0.f) & 0xffffu);
                }
                SSM_FENCE();
            }
            }
#undef SSM_A_MFMA
#undef SSM_TRANSPOSE
#undef SSM_SWAP32
#undef SSM_SWAP16
            if (FULL) {
                __syncthreads();
                bf16_t* op = Uo + (size_t)(bj * 64 + trow) * LD1 + gs * 128 + tch * 8;
                const u32x4 g0 = *(const LAS u32x4*)(ut + trow * SSM_UROW + tch * 16), g1 = *(const LAS u32x4*)(ut + (trow + 32) * SSM_UROW + tch * 16);
                { u32x4 z0, z1;
                  z0.x = cvt_pk_bf16(bflo(g0.x) * bflo(za0.x), bfhi(g0.x) * bfhi(za0.x)); z0.y = cvt_pk_bf16(bflo(g0.y) * bflo(za0.y), bfhi(g0.y) * bfhi(za0.y));
                  z0.z = cvt_pk_bf16(bflo(g0.z) * bflo(za0.z), bfhi(g0.z) * bfhi(za0.z)); z0.w = cvt_pk_bf16(bflo(g0.w) * bflo(za0.w), bfhi(g0.w) * bfhi(za0.w));
                  z1.x = cvt_pk_bf16(bflo(g1.x) * bflo(za1.x), bfhi(g1.x) * bfhi(za1.x)); z1.y = cvt_pk_bf16(bflo(g1.y) * bflo(za1.y), bfhi(g1.y) * bfhi(za1.y));
                  z1.z = cvt_pk_bf16(bflo(g1.z) * bflo(za1.z), bfhi(g1.z) * bfhi(za1.z)); z1.w = cvt_pk_bf16(bflo(g1.w) * bflo(za1.w), bfhi(g1.w) * bfhi(za1.w));
                  *(u32x4*)op = z0; *(u32x4*)(op + (size_t)32 * LD1) = z1; }
                unsigned char* o8 = G8 + (size_t)(bj * 64 + trow) * LD8A + gs * 128 + tch * 8;
                u32x2 e0, e1;
                e0.x = pk4_fp8(bflo(g0.x) * F8_G, bfhi(g0.x) * F8_G, bflo(g0.y) * F8_G, bfhi(g0.y) * F8_G); e0.y = pk4_fp8(bflo(g0.z) * F8_G, bfhi(g0.z) * F8_G, bflo(g0.w) * F8_G, bfhi(g0.w) * F8_G);
                e1.x = pk4_fp8(bflo(g1.x) * F8_G, bfhi(g1.x) * F8_G, bflo(g1.y) * F8_G, bfhi(g1.y) * F8_G); e1.y = pk4_fp8(bflo(g1.z) * F8_G, bfhi(g1.z) * F8_G, bflo(g1.w) * F8_G, bfhi(g1.w) * F8_G);
                *(u32x2*)o8 = e0; *(u32x2*)(o8 + (size_t)32 * LD8A) = e1;
            }
            __syncthreads();
        }
        if (!FULL) { GAS1 float* so = (GAS1 float*)(Sseg + ((size_t)((b * 4 + seg) * NGRP + g)) * 128 + lane);
            __hip_atomic_store(so, hh.x, __ATOMIC_RELAXED, __HIP_MEMORY_SCOPE_AGENT); __hip_atomic_store(so + 64, hh.y, __ATOMIC_RELAXED, __HIP_MEMORY_SCOPE_AGENT); }
        if (FULL && seg == 3) { outre[(size_t)(b * 64 + g) * 64 + lane] = hh.x; outim[(size_t)(b * 64 + g) * 64 + lane] = hh.y; }
    }
}

constexpr int AT_K = 0, AT_V = 24576, AT_BT = 49152, AT_BTC = 8192 + 64, AT_OST = AT_BT + 4 * AT_BTC;
__device__ __forceinline__ int crow(int r, int hi) { return (r & 3) + 8 * (r >> 2) + 4 * hi; }
struct AttnUnit {
    int kvrow[3];
    const float* ck; const float* cv;
    int nkeys[3];
    int qrow0, nq, kvh;
};
struct AttnCarry { int kvh; float mref, sink; bool qready; };
__device__ __forceinline__ void attn_unit(Frame& F, const float* sinks, const float* qgain, const float* kgain, const AttnUnit& A, bf16_t* Q, unsigned char* BR8, const bf16_t* Kb, const bf16_t* Vb, const bf16_t* ZB, AttnCarry& C, bf16x8 (&qr)[4], bool hasn, int nqrow0) {
    const int lane = F.lane, w = F.wave, r32 = lane & 31, hi = lane >> 5, h = A.kvh * 8 + w;
    LAS unsigned char* lds = F.lds;
    if (!C.qready) { const bf16_t* Qw = Q + (size_t)(A.qrow0 + r32) * LD1 + h * 64;
#pragma unroll
      for (int d0 = 0; d0 < 4; ++d0) qr[d0] = *(const bf16x8*)(Qw + d0 * 16 + hi * 8); }
#pragma unroll
    for (int s = 0; s < 3; ++s) {
        if (A.nkeys[s] == 0) continue;
        u32x4 kw = (u32x4){0u, 0u, 0u, 0u}, vw = (u32x4){0u, 0u, 0u, 0u};
        const int vrow = 16 * (w & 3) + (lane >> 2);
        if (A.kvrow[s] >= 0) {
            const size_t krow = (size_t)A.kvrow[s];
            if (lane < A.nkeys[s]) kw = *(const u32x4*)(Kb + (krow + lane) * 128 + A.kvh * 64 + w * 8);
            if (vrow < A.nkeys[s]) vw = *(const u32x4*)(Vb + (krow + vrow) * 128 + A.kvh * 64 + (w >> 2) * 32 + (lane & 3) * 8);
        } else {
            const float* kp = A.ck + ((size_t)(64 * s + lane) * 2 + A.kvh) * 64 + w * 8;
            const f32x4 k0 = *(const f32x4*)kp, k1 = *(const f32x4*)(kp + 4); kw = pack8(k0, k1);
            const float* vp = A.cv + ((size_t)(64 * s + vrow) * 2 + A.kvh) * 64 + (w >> 2) * 32 + (lane & 3) * 8;
            const f32x4 v0 = *(const f32x4*)vp, v1 = *(const f32x4*)(vp + 4); vw = pack8(v0, v1);
        }
        *(LAS u32x4*)(lds + AT_K + s * 8192 + w * 1024 + lane * 16) = kw;
        *(LAS u32x4*)(lds + AT_V + s * 8192 + w * 1024 + lane * 16) = vw;
    }
    const bool newtab = (A.kvh != C.kvh);
    if (newtab) {
#pragma unroll
        for (int i = 0; i < 4; ++i) { const int idx = F.tid + 512 * i; ((LAS float*)(lds + AT_BT))[idx] = ((const float*)(F.ws + ctab_off() + C_BT))[A.kvh * 2048 + idx]; }
    }
    __syncthreads();
    LAS float* btw = (LAS float*)(lds + AT_BT) + w * 256;
    if (newtab) {
        const float sink_ = sinks[h] * LOG2E;
        float gq = fabsf(qgain[lane]), gk = fabsf(kgain[lane]), bm = fmaxf(fmaxf(btw[lane], btw[lane + 64]), fmaxf(btw[lane + 128], lane + 192 < 255 ? btw[lane + 192] : -INFINITY));
#pragma unroll
        for (int o_ = 1; o_ < 64; o_ <<= 1) { gq = fmaxf(gq, __shfl_xor(gq, o_)); gk = fmaxf(gk, __shfl_xor(gk, o_)); bm = fmaxf(bm, __shfl_xor(bm, o_)); }
        const float mref_ = fmaxf(sink_, 8.0f * LOG2E * gq * gk * 1.0001f + bm);
        asm volatile("s_waitcnt lgkmcnt(0)" ::: "memory");
        float tv[4];
#pragma unroll
        for (int i = 0; i < 4; ++i) tv[i] = btw[lane + 64 * i] - mref_;
        asm volatile("" ::: "memory");
#pragma unroll
        for (int i = 0; i < 4; ++i)
#pragma unroll
            for (int j = 0; j < 4; ++j) { const int pos = lane + 64 * i - j; if (pos >= 0) ((LAS float*)((LAS unsigned char*)btw + j * AT_BTC))[pos] = tv[i]; }
        asm volatile("s_waitcnt lgkmcnt(0)" ::: "memory");
        C.kvh = A.kvh; C.mref = mref_; C.sink = sink_;
    }
    const float mref = C.mref, sink = C.sink;
    const int sft = (3 - r32) & 3;
    const LAS float* bt = (const LAS float*)((const LAS unsigned char*)btw + sft * AT_BTC) + (63 - r32 + 4 * hi - sft);
    const float esink = __builtin_amdgcn_exp2f(sink - mref), oscale = (A.nq == 16) ? 1.0f : F8_BR;
    const int nqt = (A.nq + 31) >> 5;
    for (int qt = 0; qt < nqt; ++qt) {
        f32x16 p[6];
        const int qoff = 32 * qt + r32;
#pragma unroll
        for (int kt = 0; kt < 6; ++kt) {
            const int s = kt >> 1, nk = A.nkeys[s] - 32 * (kt & 1);
            if (nk <= 0) {
#pragma unroll
                for (int r = 0; r < 16; ++r) p[kt][r] = -INFINITY;
                continue;
            }
            f32x16 c;
#pragma unroll
            for (int g4 = 0; g4 < 4; ++g4) { const f32x4 bv4 = *(const LAS f32x4*)(bt + 32 * kt + 8 * g4 - 32 * qt);
                c[4 * g4] = bv4[0]; c[4 * g4 + 1] = bv4[1]; c[4 * g4 + 2] = bv4[2]; c[4 * g4 + 3] = bv4[3]; }
            const LAS unsigned char* kb = lds + AT_K + s * 8192 + hi * 1024 + r32 * 16 + (kt & 1) * 512;
#pragma unroll
            for (int d0 = 0; d0 < 4; ++d0) c = __builtin_amdgcn_mfma_f32_32x32x16_bf16(*(const LAS bf16x8*)(kb + d0 * 2048), qr[d0], c, 0, 0, 0);
            if (nk < 32) {
#pragma unroll
                for (int r = 0; r < 16; ++r) if (crow(r, hi) >= nk) c[r] = -INFINITY;
            }
            p[kt] = c;
        }
        if (qt + 1 < nqt || hasn) { const bf16_t* Qw = Q + (size_t)((qt + 1 < nqt ? A.qrow0 + 32 * (qt + 1) : nqrow0) + r32) * LD1 + h * 64;
#pragma unroll
            for (int d0 = 0; d0 < 4; ++d0) qr[d0] = *(const bf16x8*)(Qw + d0 * 16 + hi * 8); }
        u32x4 zbv[4];
#pragma unroll
        for (int kt = 0; kt < 6; ++kt)
#pragma unroll
            for (int r = 0; r < 16; ++r) p[kt][r] = __builtin_amdgcn_exp2f(p[kt][r]);
        f32x16 o[2]; o[0] = (f32x16){}; o[1] = (f32x16){};
        f32x16 ls;
#pragma unroll
        for (int r = 0; r < 16; ++r) ls[r] = esink;
        const bf16x8 ones8 = (bf16x8){(short)0x3F80, (short)0x3F80, (short)0x3F80, (short)0x3F80, (short)0x3F80, (short)0x3F80, (short)0x3F80, (short)0x3F80};
        const int vb0 = ((lane >> 4) & 1) * 32 + (lane & 3) * 8 + (4 * hi + ((lane & 15) >> 2)) * 64;
#pragma unroll
        for (int kt = 0; kt < 6; ++kt) {
            const int s = kt >> 1;
            if (kt == 4) {
#pragma unroll
                for (int i = 0; i < 4; ++i) zbv[i] = *(const u32x4*)(ZB + (size_t)(A.qrow0 + 32 * qt + i * 8 + (lane >> 3)) * LD1 + h * 64 + (lane & 7) * 8); }
            if (A.nkeys[s] - 32 * (kt & 1) <= 0) continue;
#pragma unroll
            for (int ss = 0; ss < 2; ++ss) {
                u32x4 pw; pw.x = cvt_pk_bf16_b(p[kt][8 * ss + 0], p[kt][8 * ss + 1]); pw.y = cvt_pk_bf16_b(p[kt][8 * ss + 2], p[kt][8 * ss + 3]);
                pw.z = cvt_pk_bf16_b(p[kt][8 * ss + 4], p[kt][8 * ss + 5]); pw.w = cvt_pk_bf16_b(p[kt][8 * ss + 6], p[kt][8 * ss + 7]);
                const int ks = 2 * (kt & 1) + ss;
                ls = __builtin_amdgcn_mfma_f32_32x32x16_bf16(__builtin_bit_cast(bf16x8, pw), ones8, ls, 0, 0, 0);
#pragma unroll
                for (int d0 = 0; d0 < 2; ++d0) {
                    const LAS unsigned char* vp = lds + AT_V + s * 8192 + d0 * 4096 + ks * 1024 + vb0;
                    const s16x4 lo = __builtin_bit_cast(s16x4, __builtin_amdgcn_ds_read_tr16_b64_v4i16((LAS s16x4*)vp));
                    const s16x4 hi4 = __builtin_bit_cast(s16x4, __builtin_amdgcn_ds_read_tr16_b64_v4i16((LAS s16x4*)(vp + 512)));
                    const bf16x8 vf = (bf16x8){lo[0], lo[1], lo[2], lo[3], hi4[0], hi4[1], hi4[2], hi4[3]};
                    o[d0] = __builtin_amdgcn_mfma_f32_32x32x16_bf16(__builtin_bit_cast(bf16x8, pw), vf, o[d0], 0, 0, 0);
                }
            }
        }
        asm volatile("" ::: "memory");
        LAS bf16_t* stg = (LAS bf16_t*)(lds + AT_OST) + w * 2048;
#pragma unroll
        for (int r = 0; r < 16; ++r) { const int orow = crow(r, hi); const float rl = __builtin_amdgcn_rcpf(ls[r]) * oscale;
            const unsigned pk = cvt_pk_bf16(o[0][r] * rl, o[1][r] * rl);
            stg[orow * 64 + r32] = (bf16_t)(pk & 0xffffu); stg[orow * 64 + 32 + r32] = (bf16_t)(pk >> 16); }
        asm volatile("s_waitcnt lgkmcnt(0)" ::: "memory");
#pragma unroll
        for (int i = 0; i < 4; ++i) { const int row = i * 8 + (lane >> 3), ch = lane & 7;
            if (32 * qt + row < A.nq) {
                const size_t off = (size_t)(A.qrow0 + 32 * qt + row) * LD1 + h * 64 + ch * 8;
                const u32x4 ov = *(const LAS u32x4*)(stg + row * 64 + ch * 8), zv = zbv[i];
                if (A.nq == 16) {
                    u32x4 res; res.x = cvt_pk_bf16(bflo(ov.x) * bflo(zv.x), bfhi(ov.x) * bfhi(zv.x)); res.y = cvt_pk_bf16(bflo(ov.y) * bflo(zv.y), bfhi(ov.y) * bfhi(zv.y));
                    res.z = cvt_pk_bf16(bflo(ov.z) * bflo(zv.z), bfhi(ov.z) * bfhi(zv.z)); res.w = cvt_pk_bf16(bflo(ov.w) * bflo(zv.w), bfhi(ov.w) * bfhi(zv.w));
                    { GAS1 unsigned long long* d_ = (GAS1 unsigned long long*)(GAS1 bf16_t*)(Q + off);
                      __hip_atomic_store(d_, ((unsigned long long)res.y << 32) | res.x, __ATOMIC_RELAXED, __HIP_MEMORY_SCOPE_AGENT); __hip_atomic_store(d_ + 1, ((unsigned long long)res.w << 32) | res.z, __ATOMIC_RELAXED, __HIP_MEMORY_SCOPE_AGENT); }
                } else {
                    u32x2 e; e.x = pk4_fp8(bflo(ov.x) * bflo(zv.x), bfhi(ov.x) * bfhi(zv.x), bflo(ov.y) * bflo(zv.y), bfhi(ov.y) * bfhi(zv.y));
                    e.y = pk4_fp8(bflo(ov.z) * bflo(zv.z), bfhi(ov.z) * bfhi(zv.z), bflo(ov.w) * bflo(zv.w), bfhi(ov.w) * bfhi(zv.w));
                    *(u32x2*)(BR8 + (size_t)(A.qrow0 + 32 * qt + row) * LD8B + 1024 + h * 64 + ch * 8) = e; } } }
        asm volatile("s_waitcnt lgkmcnt(0)" ::: "memory");
    }
    C.qready = hasn;
    if (A.nq == 16) asm volatile("s_waitcnt vmcnt(0)" ::: "memory");
    __syncthreads();
}

template <int MODE>
__device__ __forceinline__ void sample_gemm(Frame& F, const bf16_t* A, const bf16_t* A2, int lda, const bf16_t* Wt, int ldb, int K, int N,
                                            const bf16_t* P0, const bf16_t* P1, const float* PF, void* OUT, int it0, int itstep, unsigned* scnt) {
    const int lane = F.lane, w = F.wave, fr = lane & 15, fq = lane >> 4;
    LAS float* red = (LAS float*)F.lds;
    const int kper = K / 8, nks = kper / 32;
    if (it0 >= N / 16) return;
    if (MODE == 0) {
        if (w == 0 && lane == 0) { unsigned sp_ = 0; while (xb_ld(scnt + 32) < 80u) { __builtin_amdgcn_s_sleep(4); if (++sp_ > (1u << 18)) break; }
            __builtin_amdgcn_fence(__ATOMIC_ACQUIRE, "agent"); }
        __syncthreads();
    }
    if (MODE > 0) {
        if (w == 0 && lane == 0) { const unsigned want = (MODE == 1) ? 64u : 128u; unsigned sp_ = 0; while (xb_ld(scnt + 16 * (MODE - 1)) < want) { __builtin_amdgcn_s_sleep(4); if (++sp_ > (1u << 18)) break; }
            __builtin_amdgcn_fence(__ATOMIC_ACQUIRE, "agent"); }
        __syncthreads();
    }
    unsigned ndone = 0;
    for (int it = it0; it < N / 16; it += itstep) {
        const int k0 = w * kper;
        const bf16_t* Ab = (MODE == 1 && w >= 4) ? A2 + (size_t)MP * lda + (k0 - 1024) : A + (size_t)MP * lda + k0;
        const bf16_t* Bb = Wt + (size_t)(16 * it + fr) * ldb + k0 + 8 * fq;
        f32x4 acc[8];
#pragma unroll
        for (int mt = 0; mt < 8; ++mt) acc[mt] = (f32x4){0.f, 0.f, 0.f, 0.f};
        for (int ks0 = 0; ks0 < nks; ks0 += 4) {
            bf16x8 bq[4], aq[4][8];
#pragma unroll
            for (int kk = 0; kk < 4; ++kk) { bq[kk] = *(const bf16x8*)(Bb + (ks0 + kk) * 32);
#pragma unroll
                for (int mt = 0; mt < 8; ++mt) aq[kk][mt] = *(const bf16x8*)(Ab + (size_t)(16 * mt + fr) * lda + (ks0 + kk) * 32 + 8 * fq); }
#pragma unroll
            for (int kk = 0; kk < 4; ++kk)
#pragma unroll
                for (int mt = 0; mt < 8; ++mt) acc[mt] = __builtin_amdgcn_mfma_f32_16x16x32_bf16(aq[kk][mt], bq[kk], acc[mt], 0, 0, 0);
        }
#pragma unroll
        for (int mt = 0; mt < 8; ++mt)
#pragma unroll
            for (int r = 0; r < 4; ++r) red[((w * 8 + mt) * 4 + r) * 64 + lane] = acc[mt][r];
        __syncthreads();
#pragma unroll
        for (int r = 0; r < 4; ++r) {
            float sa = 0.f, sb = 0.f;
#pragma unroll
            for (int ww = 0; ww < 8; ++ww) { const float v = red[((ww * 8 + w) * 4 + r) * 64 + lane]; if (MODE == 1 && ww >= 4) sb += v; else sa += v; }
            const int row = 16 * w + 4 * fq + r, col = 16 * it + fr;
            if (MODE == 0) {
                const size_t o = (size_t)(MP + row) * LD1 + col;
                const float val = sa + PF[col];
                __hip_atomic_store((GAS1 unsigned short*)(GAS1 bf16_t*)((bf16_t*)OUT + o), (unsigned short)(cvt_pk_bf16(bf2f(P0[o]) * sigmoidf_(val) * bf2f(((const bf16_t*)OUT)[o]), 0.f) & 0xffffu), __ATOMIC_RELAXED, __HIP_MEMORY_SCOPE_AGENT);
            } else if (MODE == 1) {
                const size_t o = (size_t)(MP + row) * LD2 + col;
                const float v = (sa * bf2f(P0[o]) + sb) * bf2f(P1[o]);
                __hip_atomic_store((GAS1 unsigned short*)(GAS1 bf16_t*)((bf16_t*)OUT + o), (unsigned short)(cvt_pk_bf16(v, 0.f) & 0xffffu), __ATOMIC_RELAXED, __HIP_MEMORY_SCOPE_AGENT);
            } else {
                ((float*)OUT)[(size_t)row * DM + col] = PF[(size_t)row * DM + col] + sa;
            }
        }
        __syncthreads();
        ++ndone;
    }
    if (MODE < 2 && ndone) { asm volatile("s_waitcnt vmcnt(0)" ::: "memory"); __syncthreads(); if (w == 0 && lane == 0) (void)xb_add(scnt + 16 * MODE, ndone); }
}

__global__ void __launch_bounds__(512, 2) mk_fwd(Args args) {
    extern __shared__ __attribute__((aligned(16))) unsigned char lds_raw[];
    Frame F;
    F.lds = (LAS unsigned char*)lds_raw;
    F.wave = __builtin_amdgcn_readfirstlane((int)threadIdx.x >> 6); F.lane = lane_id_fresh(); F.tid = F.wave * 64 + F.lane;
#define LEADER (F.wave == 0 && lane_id_fresh() == 0)
#define REFRESH() do { F.lane = lane_id_fresh(); F.tid = F.wave * 64 + F.lane; } while (0)
    { const KArgs ka_ = kargs_fresh(); F.out = (float*)(GAS1 float*)ka_->out; F.ws = (unsigned char*)(GAS1 unsigned char*)ka_->ws; }
#if USE_CG_SYNC
    cg::grid_group grid = cg::this_grid();
#endif
#define WSB(off) (ws_fresh(F.ws) + (off))
#define XN ((bf16_t*)WSB(WS_XN))
#define U ((bf16_t*)WSB(WS_U))
#define ZA ((bf16_t*)WSB(WS_ZA))
#define Qb ((bf16_t*)WSB(WS_Q))
#define ZB ((bf16_t*)WSB(WS_ZB))
#define Kb ((bf16_t*)WSB(WS_K))
#define Vb ((bf16_t*)WSB(WS_V))
#define GA ((bf16_t*)WSB(WS_GA))
#define GB ((bf16_t*)WSB(WS_GB))
#define Sst ((float*)WSB(WS_S))
#define DUMMY ((bf16_t*)WSB(WS_DUMMY))
    int lo, hi; { const KArgs ka_ = kargs_fresh(); lo = ka_->ph_lo; hi = ka_->ph_hi; }
    volatile LAS unsigned* misc = (volatile LAS unsigned*)(F.lds + MISC_OFF);
    if (F.tid < 16) misc[F.tid] = 0u;
    __syncthreads();
#define X_BAR (XcdBarrier{(unsigned*)(WSB(WS_CTL)), xb_xcc_id(), misc, (unsigned)gridDim.x})
    if (hi - lo > 1) (void)xcd_barrier_post((unsigned*)(WSB(WS_CTL)), misc, (unsigned)gridDim.x, LEADER);
#ifndef PH_MASK
#define PH_MASK 0xff
#endif
#define IN(k) (((PH_MASK >> (k)) & 1) && lo <= (k) && (k) < hi)
    const bool DF24 = ((int)gridDim.x == 256) && IN(2) && IN(4);
    const bool GLOC = ((int)gridDim.x == 256) && IN(0) && IN(1) && IN(2) && IN(4) && IN(5) && IN(6) && IN(7);
    unsigned* const xw_ = (unsigned*)(WSB(WS_CTL)) + 3 * XCD_BAR_WORDS + 1024;
    if (GLOC && LEADER) (void)xb_add(xw_ + ((blockIdx.x & 7u) * 16u + xb_xcc_id()), 1u);
#if USE_CG_SYNC
#define SEAM(k) do { if (IN(k) && IN((k) + 1)) { if ((k) == 0) grid.sync(); else xcd_barrier((unsigned*)(WSB(WS_CTL)), xb_xcc_id(), misc, (unsigned)gridDim.x, LEADER); } } while (0)
#else
#define SEAM(k) do { if (IN(k) && IN((k) + 1)) xcd_barrier((unsigned*)(WSB(WS_CTL)), xb_xcc_id(), misc, (unsigned)gridDim.x, LEADER); } while (0)
#endif

    if (IN(0) && PROBE == 20) { p0_prologue<7>(F); __syncthreads(); }
    if (IN(0) && PROBE == 23) { p0_prologue<1>(F); __syncthreads(); }
    if (IN(0) && PROBE == 26) { p0_prologue<2>(F); __syncthreads(); }
    if (IN(0) && PROBE == 27) { p0_prologue<2 + 8>(F); __syncthreads(); }
    if (IN(0) && PROBE == 28) { p0_prologue<2 + 16>(F); __syncthreads(); }
    if (IN(0)) { if (GLOC) p0_prologue<7, true>(F); else p0_prologue<7>(F); }
    if (GLOC && PROBE == 40) {
        asm volatile("s_waitcnt vmcnt(0)" ::: "memory");
        __syncthreads();
        if (LEADER) {
            const bool col_ = xb_ld(xw_ + ((blockIdx.x & 7u) * 16u + xb_xcc_id())) == 32u;
            if (!col_) { __builtin_amdgcn_fence(__ATOMIC_RELEASE, "agent"); asm volatile("s_waitcnt vmcnt(0)" ::: "memory"); }
            (void)xb_add(xw_ + 464 + (blockIdx.x & 7u), 1u);
            for (unsigned sp_ = 0;;) {
                unsigned d_[8]; bool ok_ = true;
#pragma unroll
                for (int j = 0; j < 8; ++j) d_[j] = xb_ld(xw_ + 464 + j);
#pragma unroll
                for (int j = 0; j < 8; ++j) ok_ = ok_ && d_[j] >= 32u;
                if (ok_) break;
                __builtin_amdgcn_s_sleep(1);
                if (++sp_ > XB_SPIN_CAP) break;
            }
            __builtin_amdgcn_fence(__ATOMIC_ACQUIRE, "agent");
            asm volatile("s_waitcnt vmcnt(0)" ::: "memory");
        }
        __syncthreads();
    } else SEAM(0);
    if (IN(1)) {
        {
            pg8::Gemm g{XN, XN, (const bf16_t*)(WSB(WS_WIN)), LD2, LD2, DM, 1 << 20, MROWS / 256, INB_TILES, 0, 0, 0};
            pg8::StaticOrder S; S.init(MP / 256, g.nN, ((int)gridDim.x), (int)blockIdx.x, IN8_TILES + INB_TILES, MP / 256, 1, 0, WGM_IN16);
            EpiIn E{U, ZA, Qb, ZB, Kb, Vb, GA, GB, ((const float*)(GAS1 const float*)(kargs_fresh()->in[18])), ((const float*)(GAS1 const float*)(kargs_fresh()->in[19])), F.out, false, 0};
            pg8::gemm_phase<EpiIn, true>(F.lds, g, S, E, F.wave);
            {
                unsigned nex_ = 0; for (int L_ = (int)blockIdx.x; L_ < (MP / 256) * INB_TILES + IN8_TILES + INB_TILES; L_ += (int)gridDim.x) nex_ += (L_ >= (MP / 256) * INB_TILES) ? 1u : 0u;
                if (nex_ && LEADER) (void)xb_add(xw_ + 384 + 48, nex_);
            }
        }
        {
            pg8::Gemm g{(const bf16_t*)(WSB(WS_XN8)), (const bf16_t*)(WSB(WS_XN8)), (const bf16_t*)(WSB(WS_W8IN)), LD8B / 2, LD8B / 2, 1024, 1 << 20, MP / 256, IN8_TILES, 0, 0, 0};
            pg8::StaticOrder S; S.init(g.nM, g.nN, ((int)gridDim.x), (int)blockIdx.x, 0, 0, 0, 0, WGM_IN8);
            EpiIn E{U, ZA, Qb, ZB, Kb, Vb, GA, GB, ((const float*)(GAS1 const float*)(kargs_fresh()->in[18])), ((const float*)(GAS1 const float*)(kargs_fresh()->in[19])), F.out, false, 17};
            pg8::gemm_phase8<EpiIn, true, E8_X, E8_W>(F.lds, g, S, E, F.wave);
        }
        {
            const int nunits = (MROWS / 256) * INB_TILES + IN8_TILES, G_ = (int)gridDim.x, full = nunits / G_, rem = nunits - full * G_;
            REFRESH();
            const bool lw_ = (rem == 0) || ((int)blockIdx.x >= rem);
            if (rem == 0) p1_late_weights(F, (int)blockIdx.x, G_);
            else if ((int)blockIdx.x >= rem) p1_late_weights(F, (int)blockIdx.x - rem, G_ - rem);
            asm volatile("s_waitcnt vmcnt(0)" ::: "memory");
            __syncthreads();
            if (lw_ && LEADER) { __builtin_amdgcn_fence(__ATOMIC_RELEASE, "agent"); asm volatile("s_waitcnt vmcnt(0)" ::: "memory"); (void)xb_add(xw_ + 384 + 64, 1u); }
        }
    }
    if (IN(1) && PROBE == 9) {
        pg8::Gemm g{XN, XN, (const bf16_t*)(WSB(WS_WIN)), LD2, LD2, DM, 1 << 20, MROWS / 256, NIN / 256, 0, 0, 0};
        pg8::StaticOrder S; S.init(g.nM, g.nN, ((int)gridDim.x), (int)blockIdx.x);
        EpiNull E{(float*)DUMMY};
        pg8::gemm_phase<EpiNull, true>(F.lds, g, S, E, F.wave);
    }
    if (GLOC) { const bool col_ = __builtin_amdgcn_readfirstlane((int)xb_ld(xw_ + ((blockIdx.x & 7u) * 16u + xb_xcc_id()))) == 32; grp_barrier(xw_ + 128 + (blockIdx.x & 7u) * 32u, 1u, col_, LEADER); }
    else SEAM(1);
    if (IN(2)) {
        REFRESH();
        if (PROBE == 21) ssm_phase<false>(F, ((const float*)(GAS1 const float*)(kargs_fresh()->in[15])), U, U, Sst, nullptr, nullptr, nullptr);
        ssm_phase<false>(F, ((const float*)(GAS1 const float*)(kargs_fresh()->in[15])), U, U, Sst, nullptr, nullptr, nullptr);
        if (DF24) {
            int b_, seg_, gs_; p24_map((int)blockIdx.x, 256, b_, seg_, gs_);
            if (seg_ != 3) {
                asm volatile("s_waitcnt vmcnt(0)" ::: "memory");
                __syncthreads();
                if (LEADER) {
                    (void)xb_add((unsigned*)(WSB(WS_CTL)) + 3 * XCD_BAR_WORDS + ((b_ << 3) | gs_) * 16, 1u); }
            }
        }
        for (int c2 = blockIdx.x; c2 < 256; c2 += ((int)gridDim.x)) { int b, seg_, gs; p24_map(c2, (int)gridDim.x, b, seg_, gs);
            if ((int)gridDim.x == 256) { const int r_ = c2 >> 3; if (r_ < 2 || r_ > 9) continue; gs = r_ - 2; }
            else if (seg_ != 3) continue;
            if (LEADER) { unsigned sp_ = 0; while (xb_ld(xw_ + 384 + 48) < (unsigned)(IN8_TILES + INB_TILES)) { __builtin_amdgcn_s_sleep(4); if (++sp_ > (1u << 18)) break; } __builtin_amdgcn_fence(__ATOMIC_ACQUIRE, "agent"); }
            __syncthreads();
            const size_t so = (size_t)(b * 64 + gs * 8 + F.wave) * 64;
            ssm_unit<true>(F, ((const float*)(GAS1 const float*)(kargs_fresh()->in[15])), U, U, MP + 16 * b, 16, gs, ((const float*)(GAS1 const float*)(kargs_fresh()->in[4])) + so, ((const float*)(GAS1 const float*)(kargs_fresh()->in[5])) + so, F.out + O_SRE + so, F.out + O_SIM + so);
            if (LEADER) (void)xb_add(xw_ + 384 + 32, 1u);
        }
        constexpr int NAU = NBATCH * NCHUNK * 2 + NBATCH * 2;
        int au0, austep, aulim;
        AttnCarry acarry; acarry.kvh = -1; acarry.mref = 0.f; acarry.sink = 0.f; acarry.qready = false;
        bf16x8 aqr[4] = {};
        int auext = -1;
        if (((int)gridDim.x) == 256) { const int c = blockIdx.x, b = c & 7, r = c >> 3;
            if ((r >> 3) == 3) { au0 = b * 128 + (r - 24); austep = 8; aulim = b * 128 + 56; }
            else { au0 = b * 128 + 56 + r; austep = 24; aulim = b * 128 + 128; if (r < 2) auext = NBATCH * NCHUNK * 2 + 2 * b + r; } }
        else { au0 = blockIdx.x; austep = ((int)gridDim.x); aulim = NAU; }
        for (int it = au0; it < aulim || auext >= 0; it += austep) {
            if (it >= aulim) { it = auext; auext = -1; }
            AttnUnit A;
            if (it < NBATCH * NCHUNK * 2) {
                const int kvh = it & 1, bc = it >> 1, c = bc & 63;
#pragma unroll
                for (int s = 0; s < 3; ++s) { const int cc = c - 2 + s; A.nkeys[s] = cc >= 0 ? 64 : 0; A.kvrow[s] = cc >= 0 ? (bc - 2 + s) * 64 : 0; }
                A.ck = nullptr; A.cv = nullptr; A.qrow0 = bc * 64; A.nq = 64; A.kvh = kvh;
            } else {
                const int r = it - NBATCH * NCHUNK * 2, kvh = r & 1, b = r >> 1;
                A.nkeys[0] = 64; A.nkeys[1] = 64; A.nkeys[2] = 16; A.kvrow[0] = -1; A.kvrow[1] = -1; A.kvrow[2] = MP + 16 * b;
                A.ck = ((const float*)(GAS1 const float*)(kargs_fresh()->in[2])) + (size_t)b * 128 * 128; A.cv = ((const float*)(GAS1 const float*)(kargs_fresh()->in[3])) + (size_t)b * 128 * 128; A.qrow0 = MP + 16 * b; A.nq = 16; A.kvh = kvh;
            }
            const bool anext = (it < aulim) && (it + austep < aulim) && (it + austep < NBATCH * NCHUNK * 2) && (((it + austep) ^ it) & 1) == 0;
            if (A.nq == 16) { if (LEADER) { unsigned sp_ = 0; while (xb_ld(xw_ + 384 + 48) < (unsigned)(IN8_TILES + INB_TILES)) { __builtin_amdgcn_s_sleep(4); if (++sp_ > (1u << 18)) break; } __builtin_amdgcn_fence(__ATOMIC_ACQUIRE, "agent"); } __syncthreads(); }
            attn_unit(F, ((const float*)(GAS1 const float*)(kargs_fresh()->in[20])), ((const float*)(GAS1 const float*)(kargs_fresh()->in[18])), ((const float*)(GAS1 const float*)(kargs_fresh()->in[19])), A, Qb, WSB(WS_BR8), Kb, Vb, ZB, acarry, aqr, anext, ((it + austep) >> 1) * 64);
            if (A.nq == 16) { if (LEADER) (void)xb_add(xw_ + 384 + 32, 1u); if (((int)gridDim.x) == 256) break; }
        }
    }
    do { if (IN(2) && IN(4) && !DF24) xcd_barrier((unsigned*)(WSB(WS_CTL)), xb_xcc_id(), misc, (unsigned)gridDim.x, LEADER); } while (0);
    if (IN(4)) {
        REFRESH();
        if (DF24) {
            int b_, seg_, gs_; p24_map((int)blockIdx.x, 256, b_, seg_, gs_);
            if (seg_ != 0) {
                if (LEADER) { unsigned* c_ = (unsigned*)(WSB(WS_CTL)) + 3 * XCD_BAR_WORDS + ((b_ << 3) | gs_) * 16;
                    unsigned sp_ = 0; while (xb_ld(c_) < 3u) { __builtin_amdgcn_s_sleep(4); if (++sp_ > (1u << 18)) break; }
                    __builtin_amdgcn_fence(__ATOMIC_ACQUIRE, "agent"); }
                __syncthreads();
            }
        }
        if (PROBE == 225) ssm_phase<true, 5>(F, ((const float*)(GAS1 const float*)(kargs_fresh()->in[15])), U, (bf16_t*)WSB(WS_MX8), Sst, F.out + O_PRE, F.out + O_PIM, WSB(WS_G8));
        if (PROBE == 226) ssm_phase<true, 6>(F, ((const float*)(GAS1 const float*)(kargs_fresh()->in[15])), U, (bf16_t*)WSB(WS_MX8), Sst, F.out + O_PRE, F.out + O_PIM, WSB(WS_G8));
        if (PROBE == 227) ssm_phase<true, 7>(F, ((const float*)(GAS1 const float*)(kargs_fresh()->in[15])), U, (bf16_t*)WSB(WS_MX8), Sst, F.out + O_PRE, F.out + O_PIM, WSB(WS_G8));
        if (PROBE == 228) ssm_phase<true, 8>(F, ((const float*)(GAS1 const float*)(kargs_fresh()->in[15])), U, (bf16_t*)WSB(WS_MX8), Sst, F.out + O_PRE, F.out + O_PIM, WSB(WS_G8));
        if (PROBE == 221) ssm_phase<true, 1>(F, ((const float*)(GAS1 const float*)(kargs_fresh()->in[15])), U, (bf16_t*)WSB(WS_MX8), Sst, F.out + O_PRE, F.out + O_PIM, WSB(WS_G8));
        if (PROBE == 222) ssm_phase<true, 2>(F, ((const float*)(GAS1 const float*)(kargs_fresh()->in[15])), U, (bf16_t*)WSB(WS_MX8), Sst, F.out + O_PRE, F.out + O_PIM, WSB(WS_G8));
        if (PROBE == 22) ssm_phase<true>(F, ((const float*)(GAS1 const float*)(kargs_fresh()->in[15])), U, (bf16_t*)WSB(WS_MX8), Sst, F.out + O_PRE, F.out + O_PIM, WSB(WS_G8));
        ssm_phase<true>(F, ((const float*)(GAS1 const float*)(kargs_fresh()->in[15])), U, U, Sst, F.out + O_PRE, F.out + O_PIM, WSB(WS_G8));
    }
    if (GLOC) { const bool col_ = __builtin_amdgcn_readfirstlane((int)xb_ld(xw_ + ((blockIdx.x & 7u) * 16u + xb_xcc_id()))) == 32; grp_barrier(xw_ + 128 + (blockIdx.x & 7u) * 32u, 2u, col_, LEADER); }
    else SEAM(4);
#define GSEAM(k) do { if (IN(k) && IN((k) + 1)) xcd_barrier((unsigned*)(WSB(WS_CTL)) + (1 + G_GRP) * XCD_BAR_WORDS, xb_xcc_id(), misc + 2, (unsigned)G_SIZE, LEADER); } while (0)
    const bool G_TWO = false;
    const int G_GRP = __builtin_amdgcn_readfirstlane(G_TWO ? ((int)(blockIdx.x >> 3) & 1) : 0), G_SIZE = __builtin_amdgcn_readfirstlane(G_TWO ? (int)(gridDim.x >> 1) : (int)gridDim.x);
    const int G_RANK = __builtin_amdgcn_readfirstlane(G_TWO ? (int)(((blockIdx.x >> 4) << 3) | (blockIdx.x & 7)) : (int)blockIdx.x);
    const int G_PM0 = __builtin_amdgcn_readfirstlane(G_TWO ? G_GRP * (MP / 512) : 0), G_NM = __builtin_amdgcn_readfirstlane(G_TWO ? MP / 512 : MP / 256);
    if (IN(5)) {
        REFRESH();
        {
            const int nunits_ = (MROWS / 256) * INB_TILES + IN8_TILES, G_ = (int)gridDim.x, rem_ = nunits_ % G_; const unsigned want_ = (unsigned)(rem_ == 0 ? G_ : G_ - rem_);
            if (LEADER) { unsigned sp_ = 0; while (xb_ld(xw_ + 384 + 64) < want_) { __builtin_amdgcn_s_sleep(4); if (++sp_ > (1u << 18)) break; } __builtin_amdgcn_fence(__ATOMIC_ACQUIRE, "agent"); }
            __syncthreads();
        }
        if (IN(6)) (void)xcd_barrier_post((unsigned*)(WSB(WS_CTL)) + (1 + G_GRP) * XCD_BAR_WORDS, misc + 2, (unsigned)G_SIZE, LEADER);
        if (G_TWO && G_GRP == 1 && IN(4)) { const unsigned long long t0 = __builtin_amdgcn_s_memrealtime(); while (__builtin_amdgcn_s_memrealtime() - t0 < 0ull) __builtin_amdgcn_s_sleep(16); }
        if (G_GRP == 0) sample_gemm<0>(F, U, U, LD1, (const bf16_t*)(WSB(WS_WGLU)), LD1, 1024, 1024, U, nullptr, ((const float*)(GAS1 const float*)(kargs_fresh()->in[17])), ZA, G_RANK, G_SIZE, xw_ + 384);
        pg8::Gemm g{(const bf16_t*)(WSB(WS_G8)), (const bf16_t*)(WSB(WS_G8)), (const bf16_t*)(WSB(WS_W8GLU)), LD8A / 2, LD8A / 2, 512, 1 << 20, G_NM, 4, 0, E8_G, E8_W};
        pg8::StaticOrder S; S.init(g.nM, g.nN, G_SIZE, G_RANK, 0, 0, 0, G_PM0, WGM_P5);
        EpiGlu E{WSB(0), ((const float*)(GAS1 const float*)(kargs_fresh()->in[17]))};
        pg8::gemm_phase8<EpiGlu, true, E8_G, E8_W>(F.lds, g, S, E, F.wave);
    }
    if (GLOC) { if (IN(5) && IN(6)) { const bool col_ = __builtin_amdgcn_readfirstlane((int)xb_ld(xw_ + ((blockIdx.x & 7u) * 16u + xb_xcc_id()))) == 32; grp_barrier(xw_ + 128 + (blockIdx.x & 7u) * 32u, 3u, col_, LEADER); } }
    else GSEAM(5);
    if (IN(6)) {
        REFRESH();
        if (G_GRP == 0) sample_gemm<1>(F, ZA, Qb, LD1, (const bf16_t*)(WSB(WS_WOUT)), LD2, 2048, 2048, GA, GB, nullptr, XN, G_RANK, G_SIZE, xw_ + 384);
        pg8::Gemm g{(const bf16_t*)(WSB(WS_BR8)), (const bf16_t*)(WSB(WS_BR8)) + 512, (const bf16_t*)(WSB(WS_W8OUT)), LD8B / 2, LD8B / 2, 1024, 8, G_NM, 8, 0, E8_BR, E8_W};
        pg8::StaticOrder S; S.init(g.nM, g.nN, G_SIZE, G_RANK, 0, 0, 0, G_PM0, WGM_P67);
        EpiOut E{WSB(0)};
        pg8::gemm_phase8<EpiOut, true, E8_BR, E8_W>(F.lds, g, S, E, F.wave);
    }
    if (GLOC) { if (IN(6) && IN(7)) { const bool col_ = __builtin_amdgcn_readfirstlane((int)xb_ld(xw_ + ((blockIdx.x & 7u) * 16u + xb_xcc_id()))) == 32; grp_barrier(xw_ + 128 + (blockIdx.x & 7u) * 32u, 4u, col_, LEADER); } }
    else GSEAM(6);
    if (IN(7)) {
        REFRESH();
        if (G_GRP == 0) sample_gemm<2>(F, XN, XN, LD2, (const bf16_t*)(WSB(WS_WO)), LD2, 2048, 2048, nullptr, nullptr, ((const float*)(GAS1 const float*)(kargs_fresh()->in[1])), F.out + O_YS, G_RANK, G_SIZE, xw_ + 384);
        pg8::Gemm g{(const bf16_t*)(WSB(WS_MX8)), (const bf16_t*)(WSB(WS_MX8)), (const bf16_t*)(WSB(WS_W8O)), LD8B / 2, LD8B / 2, 1024, 1 << 20, G_NM, 8, 0, E8_MX, E8_W};
        pg8::StaticOrder S; S.init(g.nM, g.nN, G_SIZE, G_RANK, 0, 0, 0, G_PM0, WGM_P67);
        EpiRes E{WSB(0), ((const float*)(GAS1 const float*)(kargs_fresh()->in[6])), F.out};
        pg8::gemm_phase8<EpiRes, true, E8_MX, E8_W>(F.lds, g, S, E, F.wave);
    }
#undef GSEAM
#undef X_BAR
#undef LEADER
#undef REFRESH
#undef IN
#undef SEAM
#undef WSB
#undef XN
#undef U
#undef ZA
#undef Qb
#undef ZB
#undef Kb
#undef Vb
#undef GA
#undef GB
#undef Sst
#undef DUMMY
}

extern "C" void kernel_launch(void* const* d_in, const int* in_sizes, int n_in, void* d_out, int out_size, void* d_ws, size_t ws_size, hipStream_t stream) {
    static int grid = 0;
    if (grid == 0) {
        if (n_in != 25 || ws_size < WS_END) { fprintf(stderr, "kernel_launch: unexpected n_in %d / ws %zu\n", n_in, ws_size); grid = -1; return; }
        int dev = 0, cus = 0, per_cu = 0;
        hipGetDevice(&dev); hipDeviceGetAttribute(&cus, hipDeviceAttributeMultiprocessorCount, dev);
        hipFuncSetAttribute((const void*)mk_fwd, hipFuncAttributeMaxDynamicSharedMemorySize, LDS_BYTES);
        hipOccupancyMaxActiveBlocksPerMultiprocessor(&per_cu, (const void*)mk_fwd, 512, LDS_BYTES);
        if (per_cu < 1) { fprintf(stderr, "kernel_launch: occupancy query says %d blocks/CU\n", per_cu); per_cu = 1; }
        (void)hipGetLastError();
        grid = cus;
    }
    if (grid < 0) return;
    if (hipMemsetAsync((char*)d_ws + WS_CTL, 0, 65536, stream) != hipSuccess) { fprintf(stderr, "kernel_launch: memset of the barrier words failed\n"); return; }
    Args a{};
    for (int i = 0; i < 25; ++i) a.in[i] = (const float*)d_in[i];
    a.out = (float*)d_out; a.ws = (unsigned char*)d_ws;
    constexpr int NPH = 8;
    if (MK_N_LAUNCHES == 1) {
        a.ph_lo = 0; a.ph_hi = NPH;
        void* kargs[] = {&a};
        hipError_t e = hipLaunchCooperativeKernel((const void*)mk_fwd, dim3(grid), dim3(512), kargs, LDS_BYTES, stream);
        if (e != hipSuccess) fprintf(stderr, "cooperative launch failed: %s (grid %d)\n", hipGetErrorString(e), grid);
    } else {
        for (int p = 0; p < NPH; ++p) { a.ph_lo = p; a.ph_hi = p + 1; hipLaunchKernelGGL(mk_fwd, dim3(grid), dim3(512), LDS_BYTES, stream, a); }
    }
}
```
